# Optimizing an MI355X kernel written in HIP

```python
import math
import jax, jax.numpy as jnp
from jax import lax
import numpy as np

D_MODEL = 2048
BATCH = 2
SEQ = 8192
DEPTH = 1
DEC_BATCH = 8
DEC_SEQ = 4096
PAST_LEN = 128

N_MEM = 256
MLA_HEADS = 12
Q_LORA = 512
KV_LORA = 512
QK_NOPE = 128
QK_ROPE = 64
V_HEAD = 128
ROPE_THETA = 10000.0
DIL_PAIRS = ((128, 1), (512, 4), (2048, 16))
DIL_GROUPS = 3
DIL_HEADS_PER_GROUP = 4
DIL_HEADS = DIL_GROUPS * DIL_HEADS_PER_GROUP
DIL_HEAD_DIM = 128
X_HEADS = 4
X_HEAD_DIM = 256
NUM_BUCKETS = 32
MAX_DISTANCE = 1024
D_FF = 4 * D_MODEL
N_BRANCH = 3
Q_BLOCK = 128
EPS = 1e-6
NEG_INF = -1e30

SPLIT_SIZES = (Q_LORA, KV_LORA, QK_ROPE, 3 * DIL_HEADS * DIL_HEAD_DIM, X_HEADS * X_HEAD_DIM, N_BRANCH * D_MODEL)
D_IN = Q_LORA + KV_LORA + QK_ROPE + 3 * DIL_HEADS * DIL_HEAD_DIM + X_HEADS * X_HEAD_DIM + N_BRANCH * D_MODEL

kernel_name = "hybrid_mla_dilated_memory_encoder"


def rms_norm(x, g):
    x32 = x.astype(jnp.float32)
    y = x32 * lax.rsqrt(jnp.mean(x32 * x32, axis=-1, keepdims=True) + EPS)
    return (y * g.astype(jnp.float32)).astype(x.dtype)


def apply_rope(x, pos):
    half = QK_ROPE // 2
    inv = 1.0 / (ROPE_THETA ** (jnp.arange(half, dtype=jnp.float32) / half))
    ang = pos.astype(jnp.float32)[:, None] * inv[None, :]
    cos = jnp.cos(ang)[:, None, :]
    sin = jnp.sin(ang)[:, None, :]
    x32 = x.astype(jnp.float32)
    x1, x2 = x32[..., :half], x32[..., half:]
    return jnp.concatenate([x1 * cos - x2 * sin, x2 * cos + x1 * sin], axis=-1).astype(x.dtype)


def t5_bucket(rel):
    nb = NUM_BUCKETS // 2
    ret = (rel > 0).astype(np.int32) * nb
    n = np.abs(rel)
    max_exact = nb // 2
    large = max_exact + (np.log(np.maximum(n, 1) / max_exact) / np.log(MAX_DISTANCE / max_exact)
                         * (nb - max_exact)).astype(np.int32)
    large = np.minimum(large, nb - 1)
    return (ret + np.where(n < max_exact, n, large)).astype(np.int32)


def mla_attention(c_q, c_kv, k_rope, pos, g_qn, w_uq, g_kvn, w_ukv):
    B, S, _ = c_q.shape
    q = (rms_norm(c_q, g_qn) @ w_uq).reshape(B, S, MLA_HEADS, QK_NOPE + QK_ROPE)
    q = jnp.concatenate([q[..., :QK_NOPE], apply_rope(q[..., QK_NOPE:], pos)], axis=-1)
    kv = (rms_norm(c_kv, g_kvn) @ w_ukv).reshape(B, S, MLA_HEADS, QK_NOPE + V_HEAD)
    k_nope, v = kv[..., :QK_NOPE], kv[..., QK_NOPE:]
    k_pe = jnp.broadcast_to(apply_rope(k_rope[:, :, None, :], pos), (B, S, MLA_HEADS, QK_ROPE))
    k = jnp.concatenate([k_nope, k_pe], axis=-1)
    scale = (QK_NOPE + QK_ROPE) ** -0.5

    def block(q0):
        qb = lax.dynamic_slice_in_dim(q, q0, Q_BLOCK, axis=1)
        logits = jnp.einsum('bqhd,bkhd->bhqk', qb, k).astype(jnp.float32) * scale
        p = jax.nn.softmax(logits, axis=-1)
        return jnp.einsum('bhqk,bkhd->bqhd', p.astype(v.dtype), v)

    out = lax.map(block, jnp.arange(S // Q_BLOCK) * Q_BLOCK)
    return out.transpose(1, 0, 2, 3, 4).reshape(B, S, MLA_HEADS * V_HEAD)


def dilated_attention(q, k, v, rel_bias):
    B, S = q.shape[0], q.shape[1]
    scale = DIL_HEAD_DIM ** -0.5
    groups = []
    for g, (w, r) in enumerate(DIL_PAIRS):
        n_side = (w // 2) // r
        offs = np.arange(-n_side, n_side + 1, dtype=np.int32) * r
        pad = n_side * r
        kp = jnp.pad(k[:, :, g], ((0, 0), (pad, pad), (0, 0), (0, 0)))
        vp = jnp.pad(v[:, :, g], ((0, 0), (pad, pad), (0, 0), (0, 0)))
        bias = rel_bias[t5_bucket(offs)][:, g * DIL_HEADS_PER_GROUP:(g + 1) * DIL_HEADS_PER_GROUP].T
        groups.append((offs, pad, q[:, :, g], kp, vp, bias.astype(jnp.float32)))

    def block(q0):
        i = q0 + jnp.arange(Q_BLOCK)
        outs, lses = [], []
        for offs, pad, qg, kp, vp, bias in groups:
            kpos = i[:, None] + offs[None, :]
            kb = jnp.take(kp, kpos + pad, axis=1)
            vb = jnp.take(vp, kpos + pad, axis=1)
            qb = lax.dynamic_slice_in_dim(qg, q0, Q_BLOCK, axis=1)
            logits = jnp.einsum('bqhd,bqkhd->bhqk', qb, kb).astype(jnp.float32) * scale
            logits = logits + bias[None, :, None, :]
            valid = (kpos >= 0) & (kpos < S)
            logits = jnp.where(valid[None, None], logits, NEG_INF)
            m = jnp.max(logits, axis=-1, keepdims=True)
            p = jnp.exp(logits - m)
            s = jnp.sum(p, axis=-1, keepdims=True)
            outs.append(jnp.einsum('bhqk,bqkhd->bqhd', (p / s).astype(vb.dtype), vb))
            lses.append((m + jnp.log(s))[..., 0])
        alpha = jax.nn.softmax(jnp.stack(lses, axis=-1), axis=-1).transpose(0, 2, 1, 3)
        out = sum(alpha[..., gi, None].astype(outs[gi].dtype) * outs[gi] for gi in range(DIL_GROUPS))
        return out

    out = lax.map(block, jnp.arange(S // Q_BLOCK) * Q_BLOCK)
    return out.transpose(1, 0, 2, 3, 4).reshape(B, S, DIL_HEADS_PER_GROUP * DIL_HEAD_DIM)


def memory_cross_attention(q, mem_n, w_mkv):
    B, S = q.shape[0], q.shape[1]
    kv = (mem_n @ w_mkv).reshape(B, mem_n.shape[1], 2, X_HEADS, X_HEAD_DIM)
    k, v = kv[:, :, 0], kv[:, :, 1]
    logits = jnp.einsum('bshd,bmhd->bhsm', q, k).astype(jnp.float32) * (X_HEAD_DIM ** -0.5)
    p = jax.nn.softmax(logits, axis=-1)
    out = jnp.einsum('bhsm,bmhd->bshd', p.astype(v.dtype), v)
    return out.reshape(B, S, X_HEADS * X_HEAD_DIM)


def encoder_layer(x, mem, pos, rel_bias, g_attn, w_in, g_qn, w_uq, g_kvn, w_ukv, g_mem, w_mkv,
                  w_b_mla, w_b_dil, w_b_mem, w_out, g_mlp, w_up, w_down):
    B, S, _ = x.shape
    h = rms_norm(x, g_attn)
    proj = h @ w_in
    cuts = np.cumsum(SPLIT_SIZES)[:-1].tolist()
    c_q, c_kv, k_rope, dil_qkv, x_q, gate_logits = jnp.split(proj, cuts, axis=-1)

    o_mla = mla_attention(c_q, c_kv, k_rope, pos, g_qn, w_uq, g_kvn, w_ukv)
    dil = dil_qkv.reshape(B, S, 3, DIL_GROUPS, DIL_HEADS_PER_GROUP, DIL_HEAD_DIM)
    o_dil = dilated_attention(dil[:, :, 0], dil[:, :, 1], dil[:, :, 2], rel_bias)
    o_mem = memory_cross_attention(x_q.reshape(B, S, X_HEADS, X_HEAD_DIM), rms_norm(mem, g_mem), w_mkv)

    gates = jax.nn.sigmoid(gate_logits.astype(jnp.float32)).astype(x.dtype).reshape(B, S, N_BRANCH, D_MODEL)
    merged = (gates[:, :, 0] * (o_mla @ w_b_mla)
              + gates[:, :, 1] * (o_dil @ w_b_dil)
              + gates[:, :, 2] * (o_mem @ w_b_mem))
    x = x + merged @ w_out
    h = rms_norm(x, g_mlp)
    x = x + jnp.square(jax.nn.relu(h @ w_up)) @ w_down
    return x


def encoder_trunk(x, mem, rel_bias, g_attn, w_in, g_qn, w_uq, g_kvn, w_ukv, g_mem, w_mkv,
                  w_b_mla, w_b_dil, w_b_mem, w_out, g_mlp, w_up, w_down, g_final):
    pos = jnp.arange(x.shape[1])
    for l in range(DEPTH):
        x = encoder_layer(x, mem, pos, rel_bias, g_attn[l], w_in[l], g_qn[l], w_uq[l], g_kvn[l], w_ukv[l],
                          g_mem[l], w_mkv[l], w_b_mla[l], w_b_dil[l], w_b_mem[l], w_out[l],
                          g_mlp[l], w_up[l], w_down[l])
    return rms_norm(x, g_final)


def setup_inputs(seed: int = 0) -> dict:
    key = jax.random.key(seed)
    ks = jax.random.split(key, 32)
    f32 = jnp.float32

    def w(k, fan_in, shape):
        return jax.random.normal(k, shape, f32) * (fan_in ** -0.5)

    def gain(k, shape):
        return 1.0 + 0.02 * jax.random.normal(k, shape, f32)

    L = DEPTH
    return {
        "x_prompt": jax.random.normal(ks[0], (BATCH, SEQ, D_MODEL), f32),
        "x_sample": jax.random.normal(ks[1], (DEC_BATCH, DEC_SEQ, D_MODEL), f32),
        "mem_prompt": jax.random.normal(ks[2], (BATCH, N_MEM, D_MODEL), f32),
        "mem_sample": jax.random.normal(ks[3], (DEC_BATCH, N_MEM, D_MODEL), f32),
        "rel_bias": 0.5 * jax.random.normal(ks[4], (NUM_BUCKETS, DIL_HEADS), f32),
        "g_attn": gain(ks[5], (L, D_MODEL)),
        "w_in": w(ks[6], D_MODEL, (L, D_MODEL, D_IN)),
        "g_q_norm": gain(ks[7], (L, Q_LORA)),
        "w_uq": w(ks[8], Q_LORA, (L, Q_LORA, MLA_HEADS * (QK_NOPE + QK_ROPE))),
        "g_kv_norm": gain(ks[9], (L, KV_LORA)),
        "w_ukv": w(ks[10], KV_LORA, (L, KV_LORA, MLA_HEADS * (QK_NOPE + V_HEAD))),
        "g_mem": gain(ks[11], (L, D_MODEL)),
        "w_mem_kv": w(ks[12], D_MODEL, (L, D_MODEL, 2 * X_HEADS * X_HEAD_DIM)),
        "w_b_mla": w(ks[13], MLA_HEADS * V_HEAD, (L, MLA_HEADS * V_HEAD, D_MODEL)),
        "w_b_dil": w(ks[14], DIL_HEADS_PER_GROUP * DIL_HEAD_DIM, (L, DIL_HEADS_PER_GROUP * DIL_HEAD_DIM, D_MODEL)),
        "w_b_mem": w(ks[15], X_HEADS * X_HEAD_DIM, (L, X_HEADS * X_HEAD_DIM, D_MODEL)),
        "w_out": w(ks[16], D_MODEL, (L, D_MODEL, D_MODEL)),
        "g_mlp": gain(ks[17], (L, D_MODEL)),
        "w_up": w(ks[18], D_MODEL, (L, D_MODEL, D_FF)),
        "w_down": w(ks[19], D_FF, (L, D_FF, D_MODEL)),
        "g_final": gain(ks[20], (D_MODEL,)),
    }


def reference(x_prompt, x_sample, mem_prompt, mem_sample, rel_bias, g_attn, w_in, g_q_norm, w_uq,
              g_kv_norm, w_ukv, g_mem, w_mem_kv, w_b_mla, w_b_dil, w_b_mem, w_out, g_mlp, w_up, w_down,
              g_final):
    y_prompt = encoder_trunk(x_prompt, mem_prompt, rel_bias, g_attn, w_in, g_q_norm, w_uq, g_kv_norm, w_ukv,
                             g_mem, w_mem_kv, w_b_mla, w_b_dil, w_b_mem, w_out, g_mlp, w_up, w_down, g_final)
    y_sample = encoder_trunk(x_sample, mem_sample, rel_bias, g_attn, w_in, g_q_norm, w_uq, g_kv_norm, w_ukv,
                             g_mem, w_mem_kv, w_b_mla, w_b_dil, w_b_mem, w_out, g_mlp, w_up, w_down, g_final)
    return (y_prompt, y_sample)
```

```cpp
#include <hip/hip_runtime.h>
#include <hip/hip_cooperative_groups.h>
#include <cstdio>
#include <cstdint>
#include <cmath>
namespace cg = cooperative_groups;
#ifndef PH
#define PH 0xffff
#endif

#define LAS __attribute__((address_space(3)))
typedef unsigned short bf16_t;
typedef short bf16x8 __attribute__((ext_vector_type(8)));
typedef short s16x4 __attribute__((ext_vector_type(4)));
typedef float f32x4 __attribute__((ext_vector_type(4)));
typedef float f32x2 __attribute__((ext_vector_type(2)));
typedef float f32x16 __attribute__((ext_vector_type(16)));
typedef unsigned u32x4 __attribute__((ext_vector_type(4)));
typedef unsigned u32x2 __attribute__((ext_vector_type(2)));

constexpr int DM = 2048, MC = 8192, NCHUNK = 6, DFF = 8192;
constexpr int NPROJ = 13056;
constexpr int OFF_CQ = 0, OFF_CKV = 512, OFF_KR = 1024, OFF_DIL = 1280, OFF_XQ = 5888, OFF_GATE = 6912;
constexpr int NQ = 2304, NKV = 3072;
constexpr int NMEMROWS = 2560;
constexpr float EPS = 1e-6f;

constexpr size_t WS_CTL  = 0;
constexpr size_t WS_ROPE = 4096;
constexpr size_t WS_BIAS = WS_ROPE + (size_t)8192 * 32 * 8;
constexpr size_t WS_WIN  = WS_BIAS + 8192;
constexpr size_t WS_WUQ  = WS_WIN  + (size_t)NPROJ * 2048 * 2;
constexpr size_t WS_WUKV = WS_WUQ  + (size_t)NQ * 512 * 2;
constexpr size_t WS_WMKV = WS_WUKV + (size_t)NKV * 512 * 2;
constexpr size_t WS_WBM  = WS_WMKV + (size_t)2048 * 2048 * 2;
constexpr size_t WS_WBD  = WS_WBM  + (size_t)2048 * 1536 * 2;
constexpr size_t WS_WBX  = WS_WBD  + (size_t)2048 * 512 * 2;
constexpr size_t WS_WOUT = WS_WBX  + (size_t)2048 * 1024 * 2;
constexpr size_t WS_WUP  = WS_WOUT + (size_t)2048 * 2048 * 2;
constexpr size_t WS_WDN  = WS_WUP  + (size_t)8192 * 2048 * 2;
constexpr size_t WS_MEMN = WS_WDN  + (size_t)2048 * 8192 * 2;
constexpr size_t WS_MEMKV= WS_MEMN + (size_t)NMEMROWS * 2048 * 2;
constexpr size_t WS_H    = WS_MEMKV+ (size_t)NMEMROWS * 2048 * 2;
constexpr size_t WS_PROJ = WS_H    + (size_t)MC * 2048 * 2;
constexpr size_t WS_CQ   = WS_PROJ + (size_t)MC * NPROJ * 2;
constexpr size_t WS_CKV  = WS_CQ   + (size_t)MC * 512 * 2;
constexpr size_t WS_KPE  = WS_CKV  + (size_t)MC * 512 * 2;
constexpr size_t WS_Q    = WS_KPE  + (size_t)MC * 64 * 2;
constexpr size_t WS_KV   = WS_Q    + (size_t)MC * NQ * 2;
constexpr size_t WS_OMLA = WS_KV   + (size_t)MC * NKV * 2;
constexpr size_t WS_ODG  = WS_OMLA + (size_t)MC * 1536 * 2;
constexpr size_t WS_LSE  = WS_ODG  + (size_t)3 * MC * 512 * 4;
constexpr size_t WS_ODIL = WS_LSE  + (size_t)3 * MC * 4 * 4;
constexpr size_t WS_OMEM = WS_ODIL + (size_t)MC * 512 * 2;
constexpr size_t WS_TMP  = WS_OMEM + (size_t)MC * 1024 * 2;
constexpr size_t WS_MERG = WS_TMP  + (size_t)MC * 2048 * 4;
constexpr size_t WS_END  = WS_MERG + (size_t)MC * 2048 * 2;

constexpr int LDS_BYTES = 131072 + 1024;
constexpr int LDS_BIAS_OFF = 126976;

struct Params {
    const float* in[21]; float* out; unsigned char* ws;
    float inv[32];
    unsigned char bkt[3][132];
    int pad;
};

namespace pg8 {
constexpr int BM = 256, BK = 64, HALF = 128, HTB = HALF * BK * 2, STAGE_BYTES = 8 * HTB, NXCD = 8, WGM = 8;
__host__ __device__ __forceinline__ int lds_byte(int r, int c) { const int st = (r >> 4) * 2 + (c >> 5), rr = r & 15, cc = c & 31, ob = rr * 64 + cc * 2; return st * 1024 + (ob ^ (((ob >> 9) & 1) << 5)); }
__host__ __device__ __forceinline__ void stage_rc(int b, int& R, int& C) { const int st = b / 1024, sb = b % 1024, swz = sb ^ (((sb >> 9) & 1) << 5); R = (st >> 1) * 16 + swz / 64; C = (st & 1) * 32 + (swz % 64) / 2; }
__host__ __device__ __forceinline__ int perm32(int rho) { const int n = rho >> 4, i = rho & 15; return 8 * (i >> 2) + 4 * n + (i & 3); }
struct Unit { int pm, pn; };
struct Gemm { const bf16_t* A; const bf16_t* Bt; int M, N, K; };
struct StaticOrder {
    int nM, nN, nwg, G, c;
    __host__ __device__ void init(int M, int N, int G_, int c_) { nM = M / BM; nN = N / BM; nwg = nM * nN; G = G_; c = c_; }
    __host__ __device__ bool next(int i, Unit& u) const {
        const long L = (long)i * G + c; if (L >= nwg) return false;
        int wgid = (int)L; { const int q = nwg / NXCD, r = nwg % NXCD, xcd = wgid % NXCD, off = wgid / NXCD; wgid = (xcd < r ? xcd * (q + 1) : r * (q + 1) + (xcd - r) * q) + off; }
        const int nig = WGM * nN, gid = wgid / nig, fm = gid * WGM, gsz = (nM - fm) < WGM ? (nM - fm) : WGM;
        u.pm = fm + ((wgid % nig) % gsz); u.pn = (wgid % nig) / gsz; return true;
    }
};
__device__ __forceinline__ unsigned cvt_pk_bf16(float lo, float hi) { unsigned r; asm volatile("v_cvt_pk_bf16_f32 %0, %1, %2" : "=v"(r) : "v"(lo), "v"(hi)); return r; }
__device__ __forceinline__ u32x4 pack8(f32x4 v0, f32x4 v1) { u32x4 w; w.x = cvt_pk_bf16(v0[0], v0[1]); w.y = cvt_pk_bf16(v0[2], v0[3]); w.z = cvt_pk_bf16(v1[0], v1[1]); w.w = cvt_pk_bf16(v1[2], v1[3]); return w; }
__device__ __forceinline__ float bf2f(unsigned short h) { return __uint_as_float(((unsigned)h) << 16); }

template <int ACT  > struct EpiStore {
    static constexpr bool PERM = true;
    bf16_t* O; int ldc;
    __device__ __forceinline__ void operator()(const f32x4 (&acc)[2][2][4][2], const Unit& u, int wr, int wc, int fr, int fq) const {
        const int row0 = u.pm * BM + wr * 64 + fr, col0 = u.pn * BM + wc * 32 + 8 * fq;
#pragma unroll
        for (int ai = 0; ai < 2; ++ai)
#pragma unroll
            for (int m = 0; m < 4; ++m) { bf16_t* rowp = O + (size_t)(row0 + ai * HALF + m * 16) * ldc + col0;
#pragma unroll
                for (int bj = 0; bj < 2; ++bj) { f32x4 v0 = acc[ai][bj][m][0], v1 = acc[ai][bj][m][1];
                    if (ACT == 1) {
#pragma unroll
                        for (int e = 0; e < 4; ++e) { float a = fmaxf(v0[e], 0.f), b = fmaxf(v1[e], 0.f); v0[e] = a * a; v1[e] = b * b; } }
                    *(u32x4*)(rowp + bj * HALF) = pack8(v0, v1); } }
    }
};
struct EpiQRope {
    static constexpr bool PERM = true;
    bf16_t* Q; const f32x2* rope; int posmask;
    __device__ __forceinline__ void operator()(const f32x4 (&acc)[2][2][4][2], const Unit& u, int wr, int wc, int fr, int fq) const {
        const int row0 = u.pm * BM + wr * 64 + fr, col0 = u.pn * BM + wc * 32 + 8 * fq;
#pragma unroll
        for (int ai = 0; ai < 2; ++ai)
#pragma unroll
            for (int m = 0; m < 4; ++m) { const int row = row0 + ai * HALF + m * 16; const int pos = row & posmask;
#pragma unroll
                for (int bj = 0; bj < 2; ++bj) { const int c = col0 + bj * HALF; f32x4 v0 = acc[ai][bj][m][0], v1 = acc[ai][bj][m][1];
                    if (u.pn < 6) { const int h = c >> 7, d = c & 127; *(u32x4*)(Q + (size_t)row * NQ + h * 192 + d) = pack8(v0, v1); }
                    else { const int cc = c - 1536, h = cc >> 6, p = cc & 63, j = p >> 3; f32x4 o1, o2;
                        const f32x2* rp = rope + (size_t)pos * 32 + 4 * j;
#pragma unroll
                        for (int e = 0; e < 4; ++e) { const f32x2 cs = rp[e]; o1[e] = v0[e] * cs.x - v1[e] * cs.y; o2[e] = v1[e] * cs.x + v0[e] * cs.y; }
                        *(u32x4*)(Q + (size_t)row * NQ + h * 192 + 128 + p) = pack8(o1, o2); } } }
    }
};
template <int MODE  > struct EpiGate {
    static constexpr bool PERM = true;
    const bf16_t* gate; float* tmp; bf16_t* merged;
    __device__ __forceinline__ void operator()(const f32x4 (&acc)[2][2][4][2], const Unit& u, int wr, int wc, int fr, int fq) const {
        const int row0 = u.pm * BM + wr * 64 + fr, col0 = u.pn * BM + wc * 32 + 8 * fq;
#pragma unroll
        for (int ai = 0; ai < 2; ++ai)
#pragma unroll
            for (int m = 0; m < 4; ++m) { const int row = row0 + ai * HALF + m * 16;
#pragma unroll
                for (int bj = 0; bj < 2; ++bj) { const int c = col0 + bj * HALF;
                    const u32x4 gw = *(const u32x4*)(gate + (size_t)row * NPROJ + c);
                    f32x4 v0 = acc[ai][bj][m][0], v1 = acc[ai][bj][m][1];
#pragma unroll
                    for (int e = 0; e < 4; ++e) {
                        const unsigned w0 = gw[e >> 1], w1 = gw[2 + (e >> 1)];
                        const float g0 = __uint_as_float((e & 1) ? (w0 & 0xffff0000u) : (w0 << 16)), g1 = __uint_as_float((e & 1) ? (w1 & 0xffff0000u) : (w1 << 16));
                        v0[e] *= 1.f / (1.f + __expf(-g0)); v1[e] *= 1.f / (1.f + __expf(-g1)); }
                    float* tp = tmp + (size_t)row * DM + c;
                    if (MODE == 0) { *(f32x4*)tp = v0; *(f32x4*)(tp + 4) = v1; }
                    else { const f32x4 t0 = *(const f32x4*)tp, t1 = *(const f32x4*)(tp + 4); v0 += t0; v1 += t1;
                        if (MODE == 1) { *(f32x4*)tp = v0; *(f32x4*)(tp + 4) = v1; }
                        else *(u32x4*)(merged + (size_t)row * DM + c) = pack8(v0, v1); } } }
    }
};
struct EpiResid {
    static constexpr bool PERM = true;
    const float* base; float* out;
    __device__ __forceinline__ void operator()(const f32x4 (&acc)[2][2][4][2], const Unit& u, int wr, int wc, int fr, int fq) const {
        const int row0 = u.pm * BM + wr * 64 + fr, col0 = u.pn * BM + wc * 32 + 8 * fq;
#pragma unroll
        for (int ai = 0; ai < 2; ++ai)
#pragma unroll
            for (int m = 0; m < 4; ++m) { const size_t off = (size_t)(row0 + ai * HALF + m * 16) * DM + col0;
#pragma unroll
                for (int bj = 0; bj < 2; ++bj) { const f32x4 b0 = *(const f32x4*)(base + off + bj * HALF), b1 = *(const f32x4*)(base + off + bj * HALF + 4);
                    *(f32x4*)(out + off + bj * HALF) = b0 + acc[ai][bj][m][0]; *(f32x4*)(out + off + bj * HALF + 4) = b1 + acc[ai][bj][m][1]; } }
    }
};

template <class Epi>
__device__ __forceinline__ void gemm_phase(LAS unsigned char* lds, const Gemm g, const StaticOrder& S, const Epi& E) {
    int tid_ = threadIdx.x; asm volatile("" : "+v"(tid_));
    const int tid = tid_, wid = __builtin_amdgcn_readfirstlane(tid >> 6), lane = tid & 63, wr = wid >> 2, wc = wid & 3, fr = lane & 15, fq = lane >> 4;
    const int K = g.K, nt = K / BK;
    unsigned voffA[2], voffB[2];
#pragma unroll
    for (int i = 0; i < 2; ++i) { int R, C; stage_rc(tid * 16 + i * 8192, R, C); const int Rb = Epi::PERM ? ((R & ~31) + perm32(R & 31)) : R;
        voffA[i] = (unsigned)(R * K + C) * 2u; voffB[i] = (unsigned)(Rb * K + C) * 2u; }
    const size_t kstep = (size_t)(BK * 2);
    const size_t hstep = (size_t)HALF * K * 2;
    const size_t tstep = 2 * hstep;
    const unsigned ldsw = (unsigned)wid * 1024u;
    const int aoff = lds_byte(wr * 64 + fr, fq * 8), boff = lds_byte(wc * 32 + fr, fq * 8);
#define PG8_SA(b, h) (((b) * 2 + (h)) * HTB)
#define PG8_SB(b, h) ((4 + (b) * 2 + (h)) * HTB)
#define PG8_STAGE(bufoff, gbase, voff) do { _Pragma("unroll") for (int _i = 0; _i < 2; ++_i) \
        __builtin_amdgcn_global_load_lds((const unsigned*)((const char*)(gbase) + (voff)[_i]), (LAS unsigned*)(lds + (bufoff) + ldsw + _i * 8192), 16, 0, 0); } while (0)
#define PG8_LDA(dst, b, h) do { _Pragma("unroll") for (int m = 0; m < 4; ++m) _Pragma("unroll") for (int k = 0; k < 2; ++k) dst[m][k] = *(const LAS bf16x8*)(lds + PG8_SA(b, h) + aoff + m * 2048 + k * 1024); } while (0)
#define PG8_LDB(dst, b, h) do { _Pragma("unroll") for (int n = 0; n < 2; ++n) _Pragma("unroll") for (int k = 0; k < 2; ++k) dst[n][k] = *(const LAS bf16x8*)(lds + PG8_SB(b, h) + boff + n * 2048 + k * 1024); } while (0)
#define PG8_MMA(ai, bj, At, Bt) do { __builtin_amdgcn_s_setprio(1); _Pragma("unroll") for (int m = 0; m < 4; ++m) _Pragma("unroll") for (int n = 0; n < 2; ++n) _Pragma("unroll") for (int k = 0; k < 2; ++k) \
        acc[ai][bj][m][n] = __builtin_amdgcn_mfma_f32_16x16x32_bf16(Bt[n][k], At[m][k], acc[ai][bj][m][n], 0, 0, 0); __builtin_amdgcn_s_setprio(0); } while (0)
#define PG8_WAIT_V(n) asm volatile("s_waitcnt vmcnt(" #n ")" ::: "memory")
#define PG8_WAIT_L(n) asm volatile("s_waitcnt lgkmcnt(" #n ")" ::: "memory")
#define PG8_BAR __builtin_amdgcn_s_barrier()
#define PG8_SCHED __builtin_amdgcn_sched_barrier(0)
    Unit cur, nxt; int ui = 0;
    if (!S.next(0, cur)) return;
    f32x4 acc[2][2][4][2];
#pragma unroll
    for (int a = 0; a < 2; ++a)
#pragma unroll
        for (int b = 0; b < 2; ++b)
#pragma unroll
            for (int m = 0; m < 4; ++m)
#pragma unroll
                for (int n = 0; n < 2; ++n) acc[a][b][m][n] = (f32x4){0.f, 0.f, 0.f, 0.f};
    bf16x8 At[4][2], B0[2][2], B1[2][2];
    const char* cA = (const char*)g.A + (size_t)cur.pm * tstep; const char* cB = (const char*)g.Bt + (size_t)cur.pn * tstep;
    PG8_STAGE(PG8_SB(0, 0), cB, voffB); PG8_STAGE(PG8_SB(0, 1), cB + hstep, voffB); PG8_STAGE(PG8_SA(0, 0), cA, voffA); PG8_STAGE(PG8_SA(0, 1), cA + hstep, voffA);
    if (wr == 1) PG8_BAR;
    PG8_WAIT_V(2); PG8_BAR;
    PG8_STAGE(PG8_SB(1, 0), cB + kstep, voffB); PG8_STAGE(PG8_SA(1, 0), cA + kstep, voffA); PG8_STAGE(PG8_SB(1, 1), cB + hstep + kstep, voffB);
    PG8_WAIT_V(6); PG8_BAR;
    for (;;) {
        const bool has_next = S.next(ui + 1, nxt);
        const char* nA = has_next ? (const char*)g.A + (size_t)nxt.pm * tstep : cA; const char* nB = has_next ? (const char*)g.Bt + (size_t)nxt.pn * tstep : cB;
        for (int t = 0; t < nt; t += 2) {
            const bool last = (t == nt - 2);
            const char* a1 = cA + (size_t)(t + 1) * kstep;
            const char* a2 = last ? nA : cA + (size_t)(t + 2) * kstep; const char* b2 = last ? nB : cB + (size_t)(t + 2) * kstep;
            const char* a3 = a2 + kstep; const char* b3 = b2 + kstep;
            PG8_LDB(B0, 0, 0); PG8_LDB(B1, 0, 1); PG8_SCHED; PG8_LDA(At, 0, 0); PG8_STAGE(PG8_SA(1, 1), a1 + hstep, voffA);
            PG8_WAIT_V(8); PG8_WAIT_L(0); PG8_BAR; PG8_MMA(0, 0, At, B0); PG8_MMA(0, 1, At, B1); PG8_BAR; PG8_SCHED;
            PG8_LDA(At, 0, 1); PG8_STAGE(PG8_SB(0, 0), b2, voffB); PG8_STAGE(PG8_SB(0, 1), b2 + hstep, voffB); PG8_STAGE(PG8_SA(0, 0), a2, voffA);
            PG8_WAIT_V(8); PG8_WAIT_L(0); PG8_BAR; PG8_MMA(1, 0, At, B0); PG8_MMA(1, 1, At, B1); PG8_BAR; PG8_SCHED;
            PG8_LDB(B0, 1, 0); PG8_LDB(B1, 1, 1); PG8_SCHED; PG8_LDA(At, 1, 0); PG8_STAGE(PG8_SA(0, 1), a2 + hstep, voffA);
            PG8_WAIT_V(8); PG8_WAIT_L(0); PG8_BAR; PG8_MMA(0, 0, At, B0); PG8_MMA(0, 1, At, B1); PG8_BAR; PG8_SCHED;
            PG8_LDA(At, 1, 1); PG8_STAGE(PG8_SB(1, 0), b3, voffB); PG8_STAGE(PG8_SB(1, 1), b3 + hstep, voffB); PG8_STAGE(PG8_SA(1, 0), a3, voffA);
            PG8_WAIT_V(8); PG8_WAIT_L(0); PG8_BAR; PG8_MMA(1, 0, At, B0); PG8_MMA(1, 1, At, B1); PG8_BAR; PG8_SCHED;
        }
        if (wr == 0) PG8_BAR;
        E(acc, cur, wr, wc, fr, fq);
        if (!has_next) break;
#pragma unroll
        for (int a = 0; a < 2; ++a)
#pragma unroll
            for (int b = 0; b < 2; ++b)
#pragma unroll
                for (int m = 0; m < 4; ++m)
#pragma unroll
                    for (int n = 0; n < 2; ++n) acc[a][b][m][n] = (f32x4){0.f, 0.f, 0.f, 0.f};
        cur = nxt; cA = nA; cB = nB; ++ui;
        if (wr == 1) PG8_BAR;
    }
    PG8_WAIT_V(0);
    PG8_BAR;
#undef PG8_SA
#undef PG8_SB
#undef PG8_STAGE
#undef PG8_LDA
#undef PG8_LDB
#undef PG8_MMA
#undef PG8_WAIT_V
#undef PG8_WAIT_L
#undef PG8_BAR
#undef PG8_SCHED
}
}

namespace att {
#define KSWZ(row, colB) ((row) * 256 + ((colB) ^ (((row) & 7) << 4)))
#define XSWZ(row, colB) ((row) * 128 + ((colB) ^ ((((row) >> 1) & 7) << 4)))
#define SBAR() __builtin_amdgcn_sched_barrier(0)
__device__ __forceinline__ int crow(int r, int hi) { return (r & 3) + 8 * (r >> 2) + 4 * hi; }
__device__ __forceinline__ unsigned cvtpk(float lo, float hi) { unsigned r; asm volatile("v_cvt_pk_bf16_f32 %0, %1, %2" : "=v"(r) : "v"(lo), "v"(hi)); return r; }
__device__ __forceinline__ bf16x8 ld8(const bf16_t* p) { return *reinterpret_cast<const bf16x8*>(p); }

__device__ __forceinline__ void partialSM(f32x16& p0, f32x16& p1, float& m_reg, float& mn, float& alpha, const float C, const float thr) {
    float pmax = p0[0];
#pragma unroll
    for (int r = 1; r < 16; ++r) pmax = fmaxf(pmax, p0[r]);
#pragma unroll
    for (int r = 0; r < 16; ++r) pmax = fmaxf(pmax, p1[r]);
    { auto rr = __builtin_amdgcn_permlane32_swap(__float_as_uint(pmax), __float_as_uint(pmax), false, false);
      pmax = fmaxf(__uint_as_float(rr[0]), __uint_as_float(rr[1])); }
    if (__builtin_expect(__all(pmax - m_reg <= thr), 1)) { mn = m_reg; alpha = 1.f; }
    else { mn = fmaxf(m_reg, pmax); alpha = __builtin_amdgcn_exp2f((m_reg - mn) * C); m_reg = mn; }
    const float mnC = -mn * C;
#pragma unroll
    for (int r = 0; r < 16; ++r) p0[r] = fmaf(p0[r], C, mnC);
#pragma unroll
    for (int r = 0; r < 16; ++r) p1[r] = fmaf(p1[r], C, mnC);
#pragma unroll
    for (int r = 0; r < 16; ++r) p0[r] = __builtin_amdgcn_exp2f(p0[r]);
}
__device__ __forceinline__ void finishSM(f32x16& p0, f32x16& p1, float alpha, float& l_reg, bf16x8& pa0, bf16x8& pa1, bf16x8& pa2, bf16x8& pa3) {
#pragma unroll
    for (int r = 0; r < 16; ++r) p1[r] = __builtin_amdgcn_exp2f(p1[r]);
    float ps = 0;
#pragma unroll
    for (int r = 0; r < 16; ++r) ps += p0[r];
#pragma unroll
    for (int r = 0; r < 16; ++r) ps += p1[r];
    { auto rr = __builtin_amdgcn_permlane32_swap(__float_as_uint(ps), __float_as_uint(ps), false, false);
      ps = __uint_as_float(rr[0]) + __uint_as_float(rr[1]); }
    l_reg = l_reg * alpha + ps;
#define PK4(P, BASE, OUT) do { unsigned a0 = cvtpk(P[BASE + 0], P[BASE + 1]), a1 = cvtpk(P[BASE + 2], P[BASE + 3]);   \
    unsigned b0 = cvtpk(P[BASE + 4], P[BASE + 5]), b1 = cvtpk(P[BASE + 6], P[BASE + 7]);                              \
    auto r0 = __builtin_amdgcn_permlane32_swap(a0, b0, false, false); auto r1 = __builtin_amdgcn_permlane32_swap(a1, b1, false, false); \
    u32x4 w = {r0[0], r1[0], r0[1], r1[1]}; OUT = *reinterpret_cast<bf16x8*>(&w); } while (0)
    PK4(p0, 0, pa0); PK4(p0, 8, pa1); PK4(p1, 0, pa2); PK4(p1, 8, pa3);
#undef PK4
}
__device__ __forceinline__ int v_st(int k, int c) { const int kk = (k & ~0xC) | ((k & 4) << 1) | ((k & 8) >> 1); return ((kk >> 3) * 4 + (c >> 5)) * 512 + ((kk & 7) * 32 + (c & 31)) * 2; }
__device__ __forceinline__ int v_rd_base(int lane) { return ((lane & 3) << 3) | (((lane >> 2) & 3) << 6) | (((lane >> 4) & 1) << 5) | (((lane >> 5) & 1) << 8); }
constexpr int v_rd_off(int d0, int ks, int half) { return d0 * 512 + ks * 4096 + half * 2048; }
template <int OFF> __device__ __forceinline__ s16x4 tr_read(int vb) {
    s16x4 r; asm volatile("ds_read_b64_tr_b16 %0, %1 offset:%2" : "=&v"(r) : "v"(vb), "i"(OFF) : "memory"); return r;
}
template <int D0> __device__ __forceinline__ void pv_one(f32x16& od, int vb, bf16x8 pa0, bf16x8 pa1, bf16x8 pa2, bf16x8 pa3) {
    const s16x4 l0 = tr_read<v_rd_off(D0, 0, 0)>(vb), h0 = tr_read<v_rd_off(D0, 0, 1)>(vb), l1 = tr_read<v_rd_off(D0, 1, 0)>(vb), h1 = tr_read<v_rd_off(D0, 1, 1)>(vb);
    const s16x4 l2 = tr_read<v_rd_off(D0, 2, 0)>(vb), h2 = tr_read<v_rd_off(D0, 2, 1)>(vb), l3 = tr_read<v_rd_off(D0, 3, 0)>(vb), h3 = tr_read<v_rd_off(D0, 3, 1)>(vb);
    asm volatile("s_waitcnt lgkmcnt(0)" ::: "memory"); SBAR();
#define PK(L, H) (bf16x8){L[0], L[1], L[2], L[3], H[0], H[1], H[2], H[3]}
    od = __builtin_amdgcn_mfma_f32_32x32x16_bf16(pa0, PK(l0, h0), od, 0, 0, 0);
    od = __builtin_amdgcn_mfma_f32_32x32x16_bf16(pa1, PK(l1, h1), od, 0, 0, 0);
    od = __builtin_amdgcn_mfma_f32_32x32x16_bf16(pa2, PK(l2, h2), od, 0, 0, 0);
    od = __builtin_amdgcn_mfma_f32_32x32x16_bf16(pa3, PK(l3, h3), od, 0, 0, 0);
#undef PK
}
__device__ __forceinline__ void pv_d0(f32x16* o, int vb, bf16x8 pa0, bf16x8 pa1, bf16x8 pa2, bf16x8 pa3) {
    pv_one<0>(o[0], vb, pa0, pa1, pa2, pa3); pv_one<1>(o[1], vb, pa0, pa1, pa2, pa3); pv_one<2>(o[2], vb, pa0, pa1, pa2, pa3); pv_one<3>(o[3], vb, pa0, pa1, pa2, pa3);
}

template <int RX, bool HOLDX, bool DIL>
__device__ __forceinline__ void attn_unit(const bf16_t* __restrict__ Qb, long ldq,
                                          const bf16_t* __restrict__ Kh, const bf16_t* __restrict__ Vh, long ldk,
                                          const bf16_t* __restrict__ Kx, long ldkx,
                                          const int NT, const float SCALE,
                                          bf16_t* Ob, long ldo, float* Of, long ldof, float* Lse, long ldl,
                                          const int q0, const int ssub, const float* biasL, char* lds) {
    constexpr int NX = RX / 16, NQH = 8 + (HOLDX ? NX : 0);
    constexpr int SHM_V = 64 * 128 * 2, SHM_K = 64 * 128 * 2, SHM_X = 64 * (RX ? RX : 8) * 2;
    int tid_ = threadIdx.x; asm volatile("" : "+v"(tid_));
    const int tid = tid_, wid = tid >> 6, lane = tid & 63, r32 = lane & 31, hi = lane >> 5;
    char* V_lds = lds; char* K_lds = lds + 2 * SHM_V; char* X_lds = lds + 2 * SHM_V + 2 * SHM_K;
    float* ws = (float*)(lds + 2 * SHM_V + 2 * SHM_K + 2 * SHM_X) + wid * 64; float* li_l = ws; float* al_l = ws + 32;
    const float C = SCALE * 1.4426950408889634f, thr = 8.f / SCALE;
    float m_reg = DIL ? -1e29f : -1e30f, l_reg = 0; f32x16 o[4] = {}; bf16x8 qr[NQH];
    const bf16_t* Qw = Qb + (long)(wid * 32 + r32) * ldq + hi * 8;
#pragma unroll
    for (int d0 = 0; d0 < NQH; ++d0) qr[d0] = ld8(Qw + d0 * 16);
    const int sr = tid >> 4, sc = (tid & 15) * 8, vst0 = v_st(sr, sc), vst1 = v_st(32 + sr, sc);
    const int xr = tid >> 3, xc = (tid & 7) * 8;
    const int vb0 = (int)(uintptr_t)V_lds + v_rd_base(lane);
    const int kbase = DIL ? q0 - 64 : 0;
    bf16x8 vs0, vs1, ks0, ks1, xs0, xs1;
#define ROWK(k) (DIL ? (long)min(max((k), 0), ssub - 1) : (long)(k))
#define SLOAD(k0) do { const long ra_ = ROWK(kbase + (k0) + sr), rb_ = ROWK(kbase + (k0) + 32 + sr); \
        vs0 = ld8(Vh + ra_ * ldk + sc); vs1 = ld8(Vh + rb_ * ldk + sc); ks0 = ld8(Kh + ra_ * ldk + sc); ks1 = ld8(Kh + rb_ * ldk + sc); \
        if constexpr (RX == 64) { xs0 = ld8(Kx + (long)((k0) + xr) * ldkx + xc); } \
        if constexpr (RX == 128) { xs0 = ld8(Kx + ra_ * ldkx + sc); xs1 = ld8(Kx + rb_ * ldkx + sc); } } while (0)
#define SWRITE(b) do { *(bf16x8*)(V_lds + (b) * SHM_V + vst0) = vs0; *(bf16x8*)(V_lds + (b) * SHM_V + vst1) = vs1; const int kc = sc * 2; \
        *(bf16x8*)(K_lds + (b) * SHM_K + KSWZ(sr, kc)) = ks0; *(bf16x8*)(K_lds + (b) * SHM_K + KSWZ(32 + sr, kc)) = ks1; \
        if constexpr (RX == 64) { *(bf16x8*)(X_lds + (b) * SHM_X + XSWZ(xr, xc * 2)) = xs0; } \
        if constexpr (RX == 128) { *(bf16x8*)(X_lds + (b) * SHM_X + KSWZ(sr, kc)) = xs0; *(bf16x8*)(X_lds + (b) * SHM_X + KSWZ(32 + sr, kc)) = xs1; } } while (0)
#define SWAIT() asm volatile("s_waitcnt vmcnt(0)" ::: "memory")
#define RESC(a) do { if (__any((a) < 1.f)) { if (hi == 0) al_l[r32] = (a); asm volatile("s_waitcnt lgkmcnt(0)" ::: "memory"); \
        _Pragma("unroll") for (int d = 0; d < 4; ++d) _Pragma("unroll") for (int r = 0; r < 16; ++r) o[d][r] *= al_l[crow(r, hi)]; } } while (0)
#define QKT(P0, P1, b) do { P0 = f32x16{}; P1 = f32x16{}; const char* Kb_ = K_lds + (b) * SHM_K; const char* Xb_ = X_lds + (b) * SHM_X; \
        _Pragma("unroll") for (int d0 = 0; d0 < 8; ++d0) { const int cb = (d0 * 16 + hi * 8) * 2; \
            const bf16x8 b0 = *reinterpret_cast<const bf16x8*>(Kb_ + KSWZ(r32, cb)); const bf16x8 b1 = *reinterpret_cast<const bf16x8*>(Kb_ + KSWZ(32 + r32, cb)); \
            P0 = __builtin_amdgcn_mfma_f32_32x32x16_bf16(b0, qr[d0], P0, 0, 0, 0); P1 = __builtin_amdgcn_mfma_f32_32x32x16_bf16(b1, qr[d0], P1, 0, 0, 0); } \
        _Pragma("unroll") for (int x = 0; x < NX; ++x) { const int cb = (x * 16 + hi * 8) * 2; bf16x8 b0, b1; \
            if constexpr (RX == 64) { b0 = *reinterpret_cast<const bf16x8*>(Xb_ + XSWZ(r32, cb)); b1 = *reinterpret_cast<const bf16x8*>(Xb_ + XSWZ(32 + r32, cb)); } \
            else { b0 = *reinterpret_cast<const bf16x8*>(Xb_ + KSWZ(r32, cb)); b1 = *reinterpret_cast<const bf16x8*>(Xb_ + KSWZ(32 + r32, cb)); } \
            bf16x8 qx; if constexpr (HOLDX) qx = qr[(8 + x) < NQH ? (8 + x) : 0]; else qx = ld8(Qw + (8 + x) * 16); \
            P0 = __builtin_amdgcn_mfma_f32_32x32x16_bf16(b0, qx, P0, 0, 0, 0); P1 = __builtin_amdgcn_mfma_f32_32x32x16_bf16(b1, qx, P1, 0, 0, 0); } } while (0)
#define MASK(P0, P1, t) do { if constexpr (DIL) { const int qq_ = q0 + wid * 32 + r32; const int kt_ = q0 - 64 + (t) * 64 + 4 * hi; \
        _Pragma("unroll") for (int r = 0; r < 16; ++r) { const int kk_ = kt_ + (r & 3) + 8 * (r >> 2); const int rel_ = kk_ - qq_; \
            { const bool ok_ = (rel_ >= -64) & (rel_ <= 64) & (kk_ >= 0) & (kk_ < ssub); const float b_ = biasL[min(max(rel_ + 64, 0), 128)]; P0[r] = ok_ ? P0[r] + b_ : -1e30f; } \
            { const int k2_ = kk_ + 32, r2_ = rel_ + 32; const bool ok_ = (r2_ >= -64) & (r2_ <= 64) & (k2_ >= 0) & (k2_ < ssub); const float b_ = biasL[min(max(r2_ + 64, 0), 128)]; P1[r] = ok_ ? P1[r] + b_ : -1e30f; } } } } while (0)
    f32x16 pA0, pA1, pB0, pB1; float mnA, mnB, alA, alB; bf16x8 pa0, pa1, pa2, pa3;
    SLOAD(0); SWAIT(); SWRITE(0); __syncthreads();
    QKT(pA0, pA1, 0); MASK(pA0, pA1, 0); partialSM(pA0, pA1, m_reg, mnA, alA, C, thr);
    SLOAD(64);
    SWAIT(); SWRITE(1); __syncthreads();
    for (int j = 1; j + 1 < NT; j += 2) {
        SBAR(); QKT(pB0, pB1, 1); MASK(pB0, pB1, j);
        finishSM(pA0, pA1, alA, l_reg, pa0, pa1, pa2, pa3); SBAR();
        SLOAD((j + 1) * 64); SBAR();
        pv_d0(o, vb0, pa0, pa1, pa2, pa3); partialSM(pB0, pB1, m_reg, mnB, alB, C, thr);
        __syncthreads(); SWAIT(); SWRITE(0);
        RESC(alB); __syncthreads();
        SBAR(); QKT(pA0, pA1, 0); MASK(pA0, pA1, j + 1);
        finishSM(pB0, pB1, alB, l_reg, pa0, pa1, pa2, pa3); SBAR();
        SLOAD((j + 2) * 64); SBAR();
        pv_d0(o, vb0 + SHM_V, pa0, pa1, pa2, pa3); partialSM(pA0, pA1, m_reg, mnA, alA, C, thr);
        __syncthreads(); SWAIT(); SWRITE(1);
        RESC(alA); __syncthreads();
    }
    SBAR(); QKT(pB0, pB1, 1); MASK(pB0, pB1, NT - 1);
    finishSM(pA0, pA1, alA, l_reg, pa0, pa1, pa2, pa3); SBAR();
    pv_d0(o, vb0, pa0, pa1, pa2, pa3); partialSM(pB0, pB1, m_reg, mnB, alB, C, thr);
    __syncthreads(); RESC(alB);
    finishSM(pB0, pB1, alB, l_reg, pa0, pa1, pa2, pa3); SBAR();
    pv_d0(o, vb0 + SHM_V, pa0, pa1, pa2, pa3);
    if (hi == 0) li_l[r32] = l_reg; asm volatile("s_waitcnt lgkmcnt(0)" ::: "memory");
    float rli[16];
#pragma unroll
    for (int r = 0; r < 16; ++r) rli[r] = __builtin_amdgcn_rcpf(li_l[crow(r, hi)]);
    if constexpr (DIL) {
        float* Ow = Of + (long)(wid * 32) * ldof;
#pragma unroll
        for (int r = 0; r < 16; ++r) { const int orow = crow(r, hi);
#pragma unroll
            for (int d0 = 0; d0 < 4; ++d0) Ow[(long)orow * ldof + d0 * 32 + r32] = o[d0][r] * rli[r]; }
        if (hi == 0) Lse[(long)(wid * 32 + r32) * ldl] = m_reg * SCALE + __logf(l_reg);
    } else {
        bf16_t* Ow = Ob + (long)(wid * 32) * ldo;
#pragma unroll
        for (int r = 0; r < 16; ++r) { const int orow = crow(r, hi);
#pragma unroll
            for (int d0 = 0; d0 < 4; ++d0) Ow[(long)orow * ldo + d0 * 32 + r32] = (bf16_t)(cvtpk(o[d0][r] * rli[r], 0.f) & 0xffffu); }
    }
    __syncthreads();
#undef ROWK
#undef SLOAD
#undef SWRITE
#undef SWAIT
#undef RESC
#undef QKT
#undef MASK
}
}

__device__ __forceinline__ float wave_sum(float v) {
#pragma unroll
    for (int o = 1; o < 64; o <<= 1) v += __shfl_xor(v, o);
    return v;
}
__device__ __forceinline__ unsigned f2bf(float f) { unsigned u = __float_as_uint(f); return (u + 0x7fffu + ((u >> 16) & 1u)) >> 16; }
__device__ __forceinline__ unsigned pk2(float lo, float hi) { return f2bf(lo) | (f2bf(hi) << 16); }
__device__ __forceinline__ float bfbits2f(unsigned h) { return __uint_as_float(h << 16); }

__device__ __forceinline__ int src_col(int mat, int n) {
    if (mat == 0) return n < 1088 ? n : (n < 1280 ? -1 : n - 192);
    if (mat == 1) { if (n < 1536) { return (n >> 7) * 192 + (n & 127); }
        const int cc = n - 1536, h = cc >> 6, p = cc & 63, j = p >> 3, e = p & 7; const int orig = (e < 4) ? (4 * j + e) : (32 + 4 * j + (e - 4)); return h * 192 + 128 + orig; }
    return n;
}
__device__ __forceinline__ void transpose_item(const float* W, int K, int Nsrc, int Ndst, bf16_t* WT, int mat, LAS float* scr, int item, int lane) {
    const int nblk = Ndst / 32, kb = item / nblk, nb = item % nblk, k0 = 64 * kb, n0 = 32 * nb;
    const int sc = src_col(mat, n0 + (lane & 31));
#pragma unroll 8
    for (int i = 0; i < 32; ++i) { const int kk = 2 * i + (lane >> 5); scr[kk * 33 + (lane & 31)] = (sc >= 0) ? W[(size_t)(k0 + kk) * Nsrc + sc] : 0.f; }
    asm volatile("s_waitcnt lgkmcnt(0)" ::: "memory");
    const int c = lane & 7;
#pragma unroll
    for (int j = 0; j < 4; ++j) { const int n = (lane >> 3) + 8 * j; const LAS float* s = scr + (8 * c) * 33 + n;
        u32x4 o; o.x = pk2(s[0 * 33], s[1 * 33]); o.y = pk2(s[2 * 33], s[3 * 33]); o.z = pk2(s[4 * 33], s[5 * 33]); o.w = pk2(s[6 * 33], s[7 * 33]);
        *(u32x4*)(WT + (size_t)(n0 + n) * K + k0 + 8 * c) = o; }
    asm volatile("s_waitcnt lgkmcnt(0)" ::: "memory");
}
__device__ __forceinline__ void norm_row_bf16(const float* xrow, const float* g, bf16_t* orow, int lane) {
    const f32x4* xr = (const f32x4*)xrow + lane; f32x4 v[8]; float s = 0.f;
#pragma unroll
    for (int j = 0; j < 8; ++j) { v[j] = xr[64 * j]; s += (v[j].x * v[j].x + v[j].y * v[j].y) + (v[j].z * v[j].z + v[j].w * v[j].w); }
    const float rstd = rsqrtf(wave_sum(s) * (1.f / 2048.f) + EPS);
    const f32x4* gr = (const f32x4*)g + lane; u32x2* o8 = (u32x2*)orow + lane;
#pragma unroll
    for (int j = 0; j < 8; ++j) { const f32x4 gg = gr[64 * j]; u32x2 w; w.x = pk2(v[j].x * rstd * gg.x, v[j].y * rstd * gg.y); w.y = pk2(v[j].z * rstd * gg.z, v[j].w * rstd * gg.w); o8[64 * j] = w; }
}
__device__ __forceinline__ void norm_row_f32(float* xrow, const float* g, int lane) {
    f32x4* xr = (f32x4*)xrow + lane; f32x4 v[8]; float s = 0.f;
#pragma unroll
    for (int j = 0; j < 8; ++j) { v[j] = xr[64 * j]; s += (v[j].x * v[j].x + v[j].y * v[j].y) + (v[j].z * v[j].z + v[j].w * v[j].w); }
    const float rstd = rsqrtf(wave_sum(s) * (1.f / 2048.f) + EPS);
    const f32x4* gr = (const f32x4*)g + lane;
#pragma unroll
    for (int j = 0; j < 8; ++j) { const f32x4 gg = gr[64 * j]; xr[64 * j] = v[j] * rstd * gg; }
}

__global__ void __launch_bounds__(512, 2) fwd_megakernel(Params P) {
    extern __shared__ __attribute__((aligned(16))) unsigned char lds[];
    cg::grid_group grid = cg::this_grid();
    const int G = gridDim.x, bx = blockIdx.x, NGW = G * 8;
#define OPQ() int tid_ = threadIdx.x; asm volatile("" : "+v"(tid_)); const int tid = tid_, lane = tid & 63, wave = __builtin_amdgcn_readfirstlane(tid >> 6), gw = bx * 8 + wave; (void)tid; (void)lane; (void)gw; WSP()
    LAS unsigned char* ldsl = (LAS unsigned char*)lds;
#define WSP() unsigned char* ws = P.ws; asm volatile("" : "+s"(ws))
#define ROPE ((const f32x2*)(ws + WS_ROPE))
#define BIAS ((float*)(ws + WS_BIAS))
#define WIN ((bf16_t*)(ws + WS_WIN))
#define WUQ ((bf16_t*)(ws + WS_WUQ))
#define WUKV ((bf16_t*)(ws + WS_WUKV))
#define WMKV ((bf16_t*)(ws + WS_WMKV))
#define WBM ((bf16_t*)(ws + WS_WBM))
#define WBD ((bf16_t*)(ws + WS_WBD))
#define WBX ((bf16_t*)(ws + WS_WBX))
#define WOUT ((bf16_t*)(ws + WS_WOUT))
#define WUP ((bf16_t*)(ws + WS_WUP))
#define WDN ((bf16_t*)(ws + WS_WDN))
#define MEMN ((bf16_t*)(ws + WS_MEMN))
#define MEMKV ((bf16_t*)(ws + WS_MEMKV))
#define H ((bf16_t*)(ws + WS_H))
#define PROJ ((bf16_t*)(ws + WS_PROJ))
#define UPACT ((bf16_t*)(ws + WS_PROJ))
#define CQ ((bf16_t*)(ws + WS_CQ))
#define CKV ((bf16_t*)(ws + WS_CKV))
#define KPE ((bf16_t*)(ws + WS_KPE))
#define QB ((bf16_t*)(ws + WS_Q))
#define KVB ((bf16_t*)(ws + WS_KV))
#define OMLA ((bf16_t*)(ws + WS_OMLA))
#define ODG ((float*)(ws + WS_ODG))
#define LSEB ((float*)(ws + WS_LSE))
#define ODIL ((bf16_t*)(ws + WS_ODIL))
#define OMEM ((bf16_t*)(ws + WS_OMEM))
#define TMP ((float*)(ws + WS_TMP))
#define MERG ((bf16_t*)(ws + WS_MERG))

    {
        OPQ();
        LAS float* scr = (LAS float*)(ldsl + wave * 16384);
        constexpr int I0 = 32 * (NPROJ / 32), I1 = 8 * (NQ / 32), I2 = 8 * (NKV / 32), I3 = 32 * 64, I4 = 24 * 64, I5 = 8 * 64, I6 = 16 * 64, I7 = 32 * 64, I8 = 32 * 256, I9 = 128 * 64;
        constexpr int NITEMS = I0 + I1 + I2 + I3 + I4 + I5 + I6 + I7 + I8 + I9;
        for (int it = gw; it < NITEMS; it += NGW) {
            int r = it;
            if (r < I0) { transpose_item(P.in[6], 2048, 12864, NPROJ, WIN, 0, scr, r, lane); continue; } r -= I0;
            if (r < I1) { transpose_item(P.in[8], 512, NQ, NQ, WUQ, 1, scr, r, lane); continue; } r -= I1;
            if (r < I2) { transpose_item(P.in[10], 512, NKV, NKV, WUKV, 2, scr, r, lane); continue; } r -= I2;
            if (r < I3) { transpose_item(P.in[12], 2048, 2048, 2048, WMKV, 2, scr, r, lane); continue; } r -= I3;
            if (r < I4) { transpose_item(P.in[13], 1536, 2048, 2048, WBM, 2, scr, r, lane); continue; } r -= I4;
            if (r < I5) { transpose_item(P.in[14], 512, 2048, 2048, WBD, 2, scr, r, lane); continue; } r -= I5;
            if (r < I6) { transpose_item(P.in[15], 1024, 2048, 2048, WBX, 2, scr, r, lane); continue; } r -= I6;
            if (r < I7) { transpose_item(P.in[16], 2048, 2048, 2048, WOUT, 2, scr, r, lane); continue; } r -= I7;
            if (r < I8) { transpose_item(P.in[18], 2048, 8192, 8192, WUP, 2, scr, r, lane); continue; } r -= I8;
            transpose_item(P.in[19], 8192, 2048, 2048, WDN, 2, scr, r, lane);
        }
        for (int idx = bx * 512 + tid; idx < 8192 * 32; idx += G * 512) {
            const int pos = idx >> 5, i = idx & 31; const float ang = (float)pos * P.inv[i];
            float t = ang * 0.15915494309189535f; t = t - floorf(t);
            const float rr = (t > 0.5f ? t - 1.f : t) * 6.283185307179586f;
            ((f32x2*)(ws + WS_ROPE))[idx] = (f32x2){__cosf(rr), __sinf(rr)};
        }
        for (int idx = bx * 512 + tid; idx < 12 * 129; idx += G * 512) {
            const int gh = idx / 129, k = idx % 129, g = gh >> 2;
            BIAS[idx] = P.in[4][(int)P.bkt[g][k] * 12 + gh] * 11.313708498984761f;
        }
        for (int m = gw; m < NMEMROWS; m += NGW) {
            const float* src = (m < 512) ? P.in[2] + (size_t)m * DM : P.in[3] + (size_t)(m - 512) * DM;
            norm_row_bf16(src, P.in[11], MEMN + (size_t)m * DM, lane);
        }
    }
    grid.sync();

    for (int ch = 0; ch < NCHUNK; ++ch) {
        const float* xin = (ch < 2) ? P.in[0] + (size_t)ch * MC * DM : P.in[1] + (size_t)(ch - 2) * MC * DM;
        float* xout = P.out + (size_t)ch * MC * DM;
        const int S = (ch < 2) ? 8192 : 4096;
        { OPQ(); for (int m = gw; m < MC; m += NGW) norm_row_bf16(xin + (size_t)m * DM, P.in[5], H + (size_t)m * DM, lane); }
        grid.sync();
        if ((PH & 8) && ch == 0) { WSP(); pg8::Gemm g{MEMN, WMKV, NMEMROWS, 2048, 2048}; pg8::StaticOrder So; So.init(NMEMROWS, 2048, G, G - 1 - bx);
            pg8::EpiStore<0> E{MEMKV, 2048}; pg8::gemm_phase(ldsl, g, So, E); }
        if (PH & 8) { WSP(); pg8::Gemm g{H, WIN, MC, NPROJ, 2048}; pg8::StaticOrder So; So.init(MC, NPROJ, G, bx);
          pg8::EpiStore<0> E{PROJ, NPROJ}; pg8::gemm_phase(ldsl, g, So, E); }
        grid.sync();
        { OPQ();
        for (int m = gw; m < MC; m += NGW) {
            const bf16_t* pr = PROJ + (size_t)m * NPROJ;
            {   const u32x4 w = *((const u32x4*)(pr + OFF_CQ) + lane); float v[8]; float s = 0.f;
#pragma unroll
                for (int e = 0; e < 4; ++e) { v[2 * e] = __uint_as_float(w[e] << 16); v[2 * e + 1] = __uint_as_float(w[e] & 0xffff0000u); s += v[2 * e] * v[2 * e] + v[2 * e + 1] * v[2 * e + 1]; }
                const float rstd = rsqrtf(wave_sum(s) * (1.f / 512.f) + EPS); const f32x4* gp = (const f32x4*)(P.in[7]) + 2 * lane; const f32x4 g0 = gp[0], g1 = gp[1];
                u32x4 o; o.x = pk2(v[0] * rstd * g0.x, v[1] * rstd * g0.y); o.y = pk2(v[2] * rstd * g0.z, v[3] * rstd * g0.w); o.z = pk2(v[4] * rstd * g1.x, v[5] * rstd * g1.y); o.w = pk2(v[6] * rstd * g1.z, v[7] * rstd * g1.w);
                *((u32x4*)(CQ + (size_t)m * 512) + lane) = o; }
            {   const u32x4 w = *((const u32x4*)(pr + OFF_CKV) + lane); float v[8]; float s = 0.f;
#pragma unroll
                for (int e = 0; e < 4; ++e) { v[2 * e] = __uint_as_float(w[e] << 16); v[2 * e + 1] = __uint_as_float(w[e] & 0xffff0000u); s += v[2 * e] * v[2 * e] + v[2 * e + 1] * v[2 * e + 1]; }
                const float rstd = rsqrtf(wave_sum(s) * (1.f / 512.f) + EPS); const f32x4* gp = (const f32x4*)(P.in[9]) + 2 * lane; const f32x4 g0 = gp[0], g1 = gp[1];
                u32x4 o; o.x = pk2(v[0] * rstd * g0.x, v[1] * rstd * g0.y); o.y = pk2(v[2] * rstd * g0.z, v[3] * rstd * g0.w); o.z = pk2(v[4] * rstd * g1.x, v[5] * rstd * g1.y); o.w = pk2(v[6] * rstd * g1.z, v[7] * rstd * g1.w);
                *((u32x4*)(CKV + (size_t)m * 512) + lane) = o; }
            if (lane < 32) { const float x1 = bfbits2f(pr[OFF_KR + lane]), x2 = bfbits2f(pr[OFF_KR + 32 + lane]); const int pos = m & (S - 1);
                const f32x2 cs = ROPE[(size_t)pos * 32 + lane]; const int j = lane >> 2, e = lane & 3;
                KPE[(size_t)m * 64 + 8 * j + e] = (bf16_t)f2bf(x1 * cs.x - x2 * cs.y); KPE[(size_t)m * 64 + 8 * j + 4 + e] = (bf16_t)f2bf(x2 * cs.x + x1 * cs.y); }
        } }
        grid.sync();
        if (PH & 16) { WSP(); pg8::Gemm g{CQ, WUQ, MC, NQ, 512}; pg8::StaticOrder So; So.init(MC, NQ, G, bx);
          pg8::EpiQRope E{QB, ROPE, S - 1}; pg8::gemm_phase(ldsl, g, So, E); }
        if (PH & 32) { WSP(); pg8::Gemm g{CKV, WUKV, MC, NKV, 512}; pg8::StaticOrder So; So.init(MC, NKV, G, (bx + 128) % G);
          pg8::EpiStore<0> E{KVB, NKV}; pg8::gemm_phase(ldsl, g, So, E); }
        grid.sync();
        for (int u = bx; u < 1024; u += G) {
            OPQ();
            if ((PH & 1) && u < 384) {
                const int h = u >> 5, qb = u & 31, rowq = qb * 256, seqbase = (rowq / S) * S;
                att::attn_unit<64, true, false>(QB + (size_t)rowq * NQ + h * 192, NQ, KVB + (size_t)seqbase * NKV + h * 256, KVB + (size_t)seqbase * NKV + h * 256 + 128, NKV,
                    KPE + (size_t)seqbase * 64, 64, S / 64, 0.07216878364870322f, OMLA + (size_t)rowq * 1536 + h * 128, 1536, nullptr, 0, nullptr, 0, 0, 0, nullptr, (char*)lds);
            } else if ((PH & 2) && u >= 384 && u < 768) {
                const int v = u - 384, g = v >> 7, w = v & 127, hh = w >> 5, x = w & 31;
                const int per = S / 256, sq = x / per, y = x % per, r = (g == 0) ? 1 : (g == 1 ? 4 : 16), nblk = per / r, c = y / nblk, qb = y % nblk;
                const int seqbase = sq * S, ssub = S / r, q0 = qb * 256;
                float* bl = (float*)(lds + LDS_BIAS_OFF);
                if (tid < 129) bl[tid] = BIAS[(g * 4 + hh) * 129 + tid];
                __syncthreads();
                const size_t tok0 = (size_t)seqbase + c;
                const bf16_t* kb = PROJ + tok0 * NPROJ + OFF_DIL + 1536 + g * 512 + hh * 128;
                att::attn_unit<0, false, true>(PROJ + (tok0 + (size_t)r * q0) * NPROJ + OFF_DIL + g * 512 + hh * 128, (long)r * NPROJ, kb, kb + 1536, (long)r * NPROJ,
                    nullptr, 0, 6, 0.08838834764831845f, nullptr, 0, ODG + ((size_t)g * MC + tok0 + (size_t)r * q0) * 512 + hh * 128, (long)r * 512,
                    LSEB + ((size_t)g * MC + tok0 + (size_t)r * q0) * 4 + hh, (long)r * 4, q0, ssub, bl, (char*)lds);
            } else if ((PH & 4) && u >= 768) {
                const int v = u - 768, vh = v & 1, w = v >> 1, h = w >> 5, qb = w & 31, rowq = qb * 256;
                const int bg = (ch < 2) ? ch : 2 + (ch - 2) * 2 + rowq / 4096;
                const bf16_t* kb = MEMKV + (size_t)bg * 256 * 2048 + h * 256;
                att::attn_unit<128, false, false>(PROJ + (size_t)rowq * NPROJ + OFF_XQ + h * 256, NPROJ, kb, kb + 1024 + vh * 128, 2048, kb + 128, 2048, 4, 0.0625f,
                    OMEM + (size_t)rowq * 1024 + h * 256 + vh * 128, 1024, nullptr, 0, nullptr, 0, 0, 0, nullptr, (char*)lds);
            }
        }
        grid.sync();
        { OPQ();
        for (int m = gw; m < MC; m += NGW) {
            const int hh = lane >> 4; float l[3], wgt[3];
#pragma unroll
            for (int g = 0; g < 3; ++g) l[g] = LSEB[((size_t)g * MC + m) * 4 + hh];
            const float mx = fmaxf(l[0], fmaxf(l[1], l[2])); float sum = 0.f;
#pragma unroll
            for (int g = 0; g < 3; ++g) { wgt[g] = __expf(l[g] - mx); sum += wgt[g]; }
            const float inv = 1.f / sum; f32x4 a0 = {0.f, 0.f, 0.f, 0.f}, a1 = {0.f, 0.f, 0.f, 0.f};
#pragma unroll
            for (int g = 0; g < 3; ++g) { const f32x4* op = (const f32x4*)(ODG + ((size_t)g * MC + m) * 512) + 2 * lane; a0 += op[0] * (wgt[g] * inv); a1 += op[1] * (wgt[g] * inv); }
            u32x4 o; o.x = pk2(a0.x, a0.y); o.y = pk2(a0.z, a0.w); o.z = pk2(a1.x, a1.y); o.w = pk2(a1.z, a1.w);
            *((u32x4*)(ODIL + (size_t)m * 512) + lane) = o;
        } }
        if (PH & 64) { WSP(); pg8::Gemm g{OMLA, WBM, MC, 2048, 1536}; pg8::StaticOrder So; So.init(MC, 2048, G, bx);
          pg8::EpiGate<0> E{PROJ + OFF_GATE, TMP, MERG}; pg8::gemm_phase(ldsl, g, So, E); }
        grid.sync();
        if (PH & 128) { WSP(); pg8::Gemm g{ODIL, WBD, MC, 2048, 512}; pg8::StaticOrder So; So.init(MC, 2048, G, bx);
          pg8::EpiGate<1> E{PROJ + OFF_GATE + 2048, TMP, MERG}; pg8::gemm_phase(ldsl, g, So, E); }
        if (PH & 256) { WSP(); pg8::Gemm g{OMEM, WBX, MC, 2048, 1024}; pg8::StaticOrder So; So.init(MC, 2048, G, bx);
          pg8::EpiGate<2> E{PROJ + OFF_GATE + 4096, TMP, MERG}; pg8::gemm_phase(ldsl, g, So, E); }
        grid.sync();
        if (PH & 512) { WSP(); pg8::Gemm g{MERG, WOUT, MC, 2048, 2048}; pg8::StaticOrder So; So.init(MC, 2048, G, bx);
          pg8::EpiResid E{xin, xout}; pg8::gemm_phase(ldsl, g, So, E); }
        grid.sync();
        { OPQ(); for (int m = gw; m < MC; m += NGW) norm_row_bf16(xout + (size_t)m * DM, P.in[17], H + (size_t)m * DM, lane); }
        grid.sync();
        if (PH & 1024) { WSP(); pg8::Gemm g{H, WUP, MC, DFF, 2048}; pg8::StaticOrder So; So.init(MC, DFF, G, bx);
          pg8::EpiStore<1> E{UPACT, DFF}; pg8::gemm_phase(ldsl, g, So, E); }
        grid.sync();
        if (PH & 2048) { WSP(); pg8::Gemm g{UPACT, WDN, MC, 2048, DFF}; pg8::StaticOrder So; So.init(MC, 2048, G, bx);
          pg8::EpiResid E{xout, xout}; pg8::gemm_phase(ldsl, g, So, E); }
        grid.sync();
        { OPQ(); for (int m = gw; m < MC; m += NGW) norm_row_f32(xout + (size_t)m * DM, P.in[20], lane); }
    }
}

static int t5_bucket_host(int rel) {
    const int nb = 16; int ret = (rel > 0) ? nb : 0; const int n = rel < 0 ? -rel : rel; const int max_exact = nb / 2;
    int large = max_exact + (int)(std::log((double)(n > 1 ? n : 1) / max_exact) / std::log(1024.0 / max_exact) * (nb - max_exact));
    if (large > nb - 1) large = nb - 1;
    return ret + (n < max_exact ? n : large);
}
extern "C" void kernel_launch(void* const* d_in, const int* in_sizes, int n_in, void* d_out, int out_size, void* d_ws, size_t ws_size, hipStream_t stream) {
    static int grid = 0;
    if (grid == 0) {
        if (n_in != 21 || ws_size < WS_END) { fprintf(stderr, "kernel_launch: n_in %d ws %zu (need %zu)\n", n_in, ws_size, (size_t)WS_END); grid = -1; return; }
        int dev = 0, cus = 0, per_cu = 0;
        hipGetDevice(&dev); hipDeviceGetAttribute(&cus, hipDeviceAttributeMultiprocessorCount, dev);
        hipFuncSetAttribute((const void*)fwd_megakernel, hipFuncAttributeMaxDynamicSharedMemorySize, LDS_BYTES);
        hipOccupancyMaxActiveBlocksPerMultiprocessor(&per_cu, (const void*)fwd_megakernel, 512, LDS_BYTES);
        if (per_cu < 1) per_cu = 1;
        grid = cus * 1;
        (void)hipGetLastError();
    }
    if (grid < 0) return;
    Params p{};
    for (int i = 0; i < 21; ++i) p.in[i] = (const float*)d_in[i];
    p.out = (float*)d_out; p.ws = (unsigned char*)d_ws;
    for (int i = 0; i < 32; ++i) p.inv[i] = 1.0f / powf(10000.0f, (float)i / 32.0f);
    const int dil[3] = {1, 4, 16};
    for (int g = 0; g < 3; ++g) for (int k = 0; k < 129; ++k) p.bkt[g][k] = (unsigned char)t5_bucket_host((k - 64) * dil[g]);
    void* args[] = {&p};
    hipError_t e = hipLaunchCooperativeKernel((const void*)fwd_megakernel, dim3(grid), dim3(512), args, LDS_BYTES, stream);
    if (e != hipSuccess) fprintf(stderr, "cooperative launch failed: %s (grid %d)\n", hipGetErrorString(e), grid);
}
```

```cpp
#include <hip/hip_runtime.h>
#include <hip/hip_cooperative_groups.h>
#include <cstdio>
#include <cstdint>
#include <cmath>
namespace cg = cooperative_groups;
#ifndef PH
#define PH 0xffff
#endif

#define LAS __attribute__((address_space(3)))
#define GAS __attribute__((address_space(1)))
typedef unsigned short bf16_t;
typedef short bf16x8 __attribute__((ext_vector_type(8)));
typedef short s16x4 __attribute__((ext_vector_type(4)));
typedef float f32x4 __attribute__((ext_vector_type(4)));
typedef float f32x2 __attribute__((ext_vector_type(2)));
typedef float f32x16 __attribute__((ext_vector_type(16)));
typedef unsigned u32x4 __attribute__((ext_vector_type(4)));
typedef unsigned u32x2 __attribute__((ext_vector_type(2)));

__device__ __forceinline__ float shx(float v, int lane, int mask) { return __int_as_float(__builtin_amdgcn_ds_bpermute((lane ^ mask) << 2, __float_as_int(v))); }
__device__ __forceinline__ int opaque_tid(int wv) { int l; asm volatile("v_mbcnt_lo_u32_b32 %0, -1, 0\n\tv_mbcnt_hi_u32_b32 %0, -1, %0" : "=v"(l)); return wv * 64 + l; }
constexpr int DM = 2048, MC = 8192, NCHUNK = 6, DFF = 8192;
constexpr int NPROJ = 13056;
constexpr int OFF_CQ = 0, OFF_CKV = 512, OFF_KR = 1024, OFF_DIL = 1280, OFF_XQ = 5888, OFF_GATE = 6912;
constexpr int NQ = 2304, NKV = 3072;
constexpr int NMEMROWS = 2560;
constexpr float EPS = 1e-6f;

constexpr size_t WS_CTL  = 0;
constexpr size_t WS_ROPE = 4096;
constexpr size_t WS_BIAS = WS_ROPE + (size_t)8192 * 32 * 8;
constexpr size_t WS_WIN  = WS_BIAS + 8192;
constexpr size_t WS_WUQ  = WS_WIN  + (size_t)NPROJ * 2048 * 2;
constexpr size_t WS_WUKV = WS_WUQ  + (size_t)NQ * 512 * 2;
constexpr size_t WS_WMKV = WS_WUKV + (size_t)NKV * 512 * 2;
constexpr size_t WS_WBM  = WS_WMKV + (size_t)2048 * 2048 * 2;
constexpr size_t WS_WBD  = WS_WBM  + (size_t)2048 * 1536 * 2;
constexpr size_t WS_WBX  = WS_WBD  + (size_t)2048 * 512 * 2;
constexpr size_t WS_WOUT = WS_WBX  + (size_t)2048 * 1024 * 2;
constexpr size_t WS_WUP  = WS_WOUT + (size_t)2048 * 2048 * 2;
constexpr size_t WS_WDN  = WS_WUP  + (size_t)8192 * 2048 * 2;
constexpr size_t WS_MEMN = WS_WDN  + (size_t)2048 * 8192 * 2;
constexpr size_t WS_MEMKV= WS_MEMN + (size_t)NMEMROWS * 2048 * 2;
constexpr size_t WS_H    = WS_MEMKV+ (size_t)NMEMROWS * 2048 * 2;
constexpr size_t WS_PROJ = WS_H    + (size_t)MC * 2048 * 2;
constexpr size_t WS_CQ   = WS_PROJ + (size_t)MC * NPROJ * 2;
constexpr size_t WS_CKV  = WS_CQ   + (size_t)MC * 512 * 2;
constexpr size_t WS_KPE  = WS_CKV  + (size_t)MC * 512 * 2;
constexpr size_t WS_Q    = WS_KPE  + (size_t)MC * 64 * 2;
constexpr size_t WS_KV   = WS_Q    + (size_t)MC * NQ * 2;
constexpr size_t WS_OMLA = WS_KV   + (size_t)MC * NKV * 2;
constexpr size_t WS_ODG  = WS_OMLA + (size_t)MC * 1536 * 2;
constexpr size_t WS_LSE  = WS_ODG  + (size_t)3 * MC * 512 * 4;
constexpr size_t WS_ODIL = WS_LSE  + (size_t)3 * MC * 4 * 4;
constexpr size_t WS_OMEM = WS_ODIL + (size_t)MC * 512 * 2;
constexpr size_t WS_TMP  = WS_OMEM + (size_t)MC * 1024 * 2;
constexpr size_t WS_MERG = WS_TMP  + (size_t)MC * 2048 * 4;
constexpr size_t WS_SSQ  = WS_MERG + (size_t)MC * 2048 * 2;
constexpr size_t WS_SSQ2 = WS_SSQ  + (size_t)MC * 2 * 4;
constexpr size_t WS_MLP  = WS_SSQ2 + (size_t)MC * 4;
constexpr size_t WS_MLSE = WS_MLP  + (size_t)2 * MC * 512 * 4;
constexpr size_t WS_END  = WS_MLSE + (size_t)2 * MC * 4 * 4;

constexpr int LDS_BYTES = 131072 + 1024;
constexpr int LDS_BIAS_OFF = 126976;

struct Params {
    const float* in[21]; float* out; unsigned char* ws;
    float inv[32];
    unsigned char bkt[3][132];
    int pad;
};

namespace pg8 {
constexpr int BM = 256, BK = 64, HALF = 128, HTB = HALF * BK * 2, STAGE_BYTES = 8 * HTB, NXCD = 8, WGM = 8;
__host__ __device__ __forceinline__ int lds_byte(int r, int c) { const int st = (r >> 4) * 2 + (c >> 5), rr = r & 15, cc = c & 31, ob = rr * 64 + cc * 2; return st * 1024 + (ob ^ (((ob >> 9) & 1) << 5)); }
__host__ __device__ __forceinline__ void stage_rc(int b, int& R, int& C) { const int st = b / 1024, sb = b % 1024, swz = sb ^ (((sb >> 9) & 1) << 5); R = (st >> 1) * 16 + swz / 64; C = (st & 1) * 32 + (swz % 64) / 2; }
__host__ __device__ __forceinline__ int perm32(int rho) { const int n = rho >> 4, i = rho & 15; return 8 * (i >> 2) + 4 * n + (i & 3); }
struct Unit { int pm, pn; };
struct Gemm { const bf16_t* A; const bf16_t* Bt; int M, N, K, lda; };
struct StaticOrder {
    int nM, nN, nwg, G, c;
    __host__ __device__ void init(int M, int N, int G_, int c_) { nM = M / BM; nN = N / BM; nwg = nM * nN; G = G_; c = c_; }
    __host__ __device__ bool next(int i, Unit& u) const {
        const long L = (long)i * G + c; if (L >= nwg) return false;
        int wgid = (int)L; { const int q = nwg / NXCD, r = nwg % NXCD, xcd = wgid % NXCD, off = wgid / NXCD; wgid = (xcd < r ? xcd * (q + 1) : r * (q + 1) + (xcd - r) * q) + off; }
        const int nig = WGM * nN, gid = wgid / nig, fm = gid * WGM, gsz = (nM - fm) < WGM ? (nM - fm) : WGM;
        u.pm = fm + ((wgid % nig) % gsz); u.pn = (wgid % nig) / gsz; return true;
    }
};
__device__ __forceinline__ unsigned cvt_pk_bf16(float lo, float hi) { unsigned r; asm volatile("v_cvt_pk_bf16_f32 %0, %1, %2" : "=v"(r) : "v"(lo), "v"(hi)); return r; }
__device__ __forceinline__ u32x4 pack8(f32x4 v0, f32x4 v1) { u32x4 w; w.x = cvt_pk_bf16(v0[0], v0[1]); w.y = cvt_pk_bf16(v0[2], v0[3]); w.z = cvt_pk_bf16(v1[0], v1[1]); w.w = cvt_pk_bf16(v1[2], v1[3]); return w; }
__device__ __forceinline__ float bf2f(unsigned short h) { return __uint_as_float(((unsigned)h) << 16); }

__device__ __forceinline__ void st16(bf16_t* p, u32x4 v) { *(GAS u32x4*)p = v; }
__device__ __forceinline__ void stf4(float* p, f32x4 v) { *(GAS f32x4*)p = v; }
__device__ __forceinline__ f32x4 ldf4(const float* p) { return *(const GAS f32x4*)p; }
__device__ __forceinline__ float sq8(f32x4 a, f32x4 b) { return (a[0] * a[0] + a[1] * a[1]) + (a[2] * a[2] + a[3] * a[3]) + (b[0] * b[0] + b[1] * b[1]) + (b[2] * b[2] + b[3] * b[3]); }
template <int ACT  , bool RS> struct EpiStore {
    static constexpr bool PERM = true;
    bf16_t* O; int ldc; const float* rs; int rss; float invdim;
    __device__ __forceinline__ void operator()(const f32x4 (&acc)[2][2][4][2], const Unit& u, int wr, int wc, int fr, int fq) const {
        const int row0 = u.pm * BM + wr * 64 + fr, col0 = u.pn * BM + wc * 32 + 8 * fq;
#pragma unroll
        for (int ai = 0; ai < 2; ++ai)
#pragma unroll
            for (int m = 0; m < 4; ++m) { const int row = row0 + ai * HALF + m * 16; bf16_t* rowp = O + (size_t)row * ldc + col0;
                float sc = 1.f; if (RS) sc = rsqrtf(*(const GAS float*)(rs + (size_t)row * rss) * invdim + EPS);
#pragma unroll
                for (int bj = 0; bj < 2; ++bj) { f32x4 v0 = acc[ai][bj][m][0], v1 = acc[ai][bj][m][1];
                    if (RS) { v0 *= sc; v1 *= sc; }
                    if (ACT == 1) {
#pragma unroll
                        for (int e = 0; e < 4; ++e) { float a = fmaxf(v0[e], 0.f), b = fmaxf(v1[e], 0.f); v0[e] = a * a; v1[e] = b * b; } }
                    st16(rowp + bj * HALF, pack8(v0, v1)); } }
    }
};
struct EpiProj {
    static constexpr bool PERM = true;
    bf16_t* O; float* ssq; bf16_t* kpe; const f32x2* rope; int posmask;
    __device__ __forceinline__ void operator()(const f32x4 (&acc)[2][2][4][2], const Unit& u, int wr, int wc, int fr, int fq) const {
        const int row0 = u.pm * BM + wr * 64 + fr, col0 = u.pn * BM + wc * 32 + 8 * fq;
        if (u.pn == 4) {
            if (wc < 2) {
                const int p = wc * 32 + 8 * fq, j = p >> 3;
#pragma unroll
                for (int ai = 0; ai < 2; ++ai)
#pragma unroll
                    for (int m = 0; m < 4; ++m) { const int row = row0 + ai * HALF + m * 16; const int pos = row & posmask;
                        const f32x4 v0 = acc[ai][0][m][0], v1 = acc[ai][0][m][1]; f32x4 o1, o2; const f32x2* rp = rope + (size_t)pos * 32 + 4 * j;
#pragma unroll
                        for (int e = 0; e < 4; ++e) { const f32x2 cs = *(const GAS f32x2*)(rp + e); o1[e] = v0[e] * cs.x - v1[e] * cs.y; o2[e] = v1[e] * cs.x + v0[e] * cs.y; }
                        st16(kpe + (size_t)row * 64 + p, pack8(o1, o2)); }
            }
            return;
        }
#pragma unroll
        for (int ai = 0; ai < 2; ++ai)
#pragma unroll
            for (int m = 0; m < 4; ++m) { const int row = row0 + ai * HALF + m * 16; bf16_t* rowp = O + (size_t)row * NPROJ + col0;
                st16(rowp, pack8(acc[ai][0][m][0], acc[ai][0][m][1])); st16(rowp + HALF, pack8(acc[ai][1][m][0], acc[ai][1][m][1]));
                if (u.pn < 4) { float s = sq8(acc[ai][0][m][0], acc[ai][0][m][1]) + sq8(acc[ai][1][m][0], acc[ai][1][m][1]);
                    { const int ln_ = fq * 16 + fr; s += shx(s, ln_, 16); s += shx(s, ln_, 32); }
                    if (fq == 0) __hip_atomic_fetch_add(ssq + (size_t)row * 2 + (u.pn >> 1), s, __ATOMIC_RELAXED, __HIP_MEMORY_SCOPE_AGENT); } }
    }
};
struct EpiQRope {
    static constexpr bool PERM = true;
    bf16_t* Q; const f32x2* rope; int posmask; const float* ssq;
    __device__ __forceinline__ void operator()(const f32x4 (&acc)[2][2][4][2], const Unit& u, int wr, int wc, int fr, int fq) const {
        const int row0 = u.pm * BM + wr * 64 + fr, col0 = u.pn * BM + wc * 32 + 8 * fq;
#pragma unroll
        for (int ai = 0; ai < 2; ++ai)
#pragma unroll
            for (int m = 0; m < 4; ++m) { const int row = row0 + ai * HALF + m * 16; const int pos = row & posmask;
                const float sc = rsqrtf(*(const GAS float*)(ssq + (size_t)row * 2) * (1.f / 512.f) + EPS);
#pragma unroll
                for (int bj = 0; bj < 2; ++bj) { const int c = col0 + bj * HALF; const f32x4 v0 = acc[ai][bj][m][0] * sc, v1 = acc[ai][bj][m][1] * sc;
                    if (u.pn < 6) { const int h = c >> 7, d = c & 127; st16(Q + (size_t)row * NQ + h * 192 + d, pack8(v0, v1)); }
                    else { const int cc = c - 1536, h = cc >> 6, p = cc & 63, j = p >> 3; f32x4 o1, o2;
                        const f32x2* rp = rope + (size_t)pos * 32 + 4 * j;
#pragma unroll
                        for (int e = 0; e < 4; ++e) { const f32x2 cs = *(const GAS f32x2*)(rp + e); o1[e] = v0[e] * cs.x - v1[e] * cs.y; o2[e] = v1[e] * cs.x + v0[e] * cs.y; }
                        st16(Q + (size_t)row * NQ + h * 192 + 128 + p, pack8(o1, o2)); } } }
    }
};
template <int MODE  > struct EpiGate {
    static constexpr bool PERM = true;
    const bf16_t* gate; float* tmp; bf16_t* merged;
    __device__ __forceinline__ void operator()(const f32x4 (&acc)[2][2][4][2], const Unit& u, int wr, int wc, int fr, int fq) const {
        const int row0 = u.pm * BM + wr * 64 + fr, col0 = u.pn * BM + wc * 32 + 8 * fq;
#pragma unroll
        for (int ai = 0; ai < 2; ++ai)
#pragma unroll
            for (int m = 0; m < 4; ++m) { const int row = row0 + ai * HALF + m * 16;
#pragma unroll
                for (int bj = 0; bj < 2; ++bj) { const int c = col0 + bj * HALF;
                    const u32x4 gw = *(const GAS u32x4*)(gate + (size_t)row * NPROJ + c);
                    f32x4 v0 = acc[ai][bj][m][0], v1 = acc[ai][bj][m][1];
#pragma unroll
                    for (int e = 0; e < 4; ++e) {
                        const unsigned w0 = gw[e >> 1], w1 = gw[2 + (e >> 1)];
                        const float g0 = __uint_as_float((e & 1) ? (w0 & 0xffff0000u) : (w0 << 16)), g1 = __uint_as_float((e & 1) ? (w1 & 0xffff0000u) : (w1 << 16));
                        v0[e] *= 1.f / (1.f + __expf(-g0)); v1[e] *= 1.f / (1.f + __expf(-g1)); }
                    float* tp = tmp + (size_t)row * DM + c;
                    if (MODE == 0) { stf4(tp, v0); stf4(tp + 4, v1); }
                    else { v0 += ldf4(tp); v1 += ldf4(tp + 4);
                        if (MODE == 1) { stf4(tp, v0); stf4(tp + 4, v1); }
                        else st16(merged + (size_t)row * DM + c, pack8(v0, v1)); } } }
    }
};
template <bool NRM> struct EpiResid {
    static constexpr bool PERM = true;
    const float* base; float* out; bf16_t* hb; float* ssq2;
    __device__ __forceinline__ void operator()(const f32x4 (&acc)[2][2][4][2], const Unit& u, int wr, int wc, int fr, int fq) const {
        const int row0 = u.pm * BM + wr * 64 + fr, col0 = u.pn * BM + wc * 32 + 8 * fq;
#pragma unroll
        for (int ai = 0; ai < 2; ++ai)
#pragma unroll
            for (int m = 0; m < 4; ++m) { const int row = row0 + ai * HALF + m * 16; const size_t off = (size_t)row * DM + col0; float s = 0.f;
#pragma unroll
                for (int bj = 0; bj < 2; ++bj) { const f32x4 o0 = ldf4(base + off + bj * HALF) + acc[ai][bj][m][0], o1 = ldf4(base + off + bj * HALF + 4) + acc[ai][bj][m][1];
                    stf4(out + off + bj * HALF, o0); stf4(out + off + bj * HALF + 4, o1);
                    if (NRM) { st16(hb + off + bj * HALF, pack8(o0, o1)); s += sq8(o0, o1); } }
                if (NRM) { { const int ln_ = fq * 16 + fr; s += shx(s, ln_, 16); s += shx(s, ln_, 32); }
                    if (fq == 0) __hip_atomic_fetch_add(ssq2 + row, s, __ATOMIC_RELAXED, __HIP_MEMORY_SCOPE_AGENT); } }
    }
};

template <class Epi>
__device__ __forceinline__ void gemm_phase(LAS unsigned char* lds, const Gemm g, const StaticOrder& S, const Epi& E, const int wv) {
    const int tid_ = opaque_tid(wv);
    const int tid = tid_, wid = __builtin_amdgcn_readfirstlane(tid >> 6), lane = tid & 63, wr = wid >> 2, wc = wid & 3, fr = lane & 15, fq = lane >> 4;
    const int K = g.K, nt = K / BK;
    unsigned voffA[2], voffB[2];
#pragma unroll
    for (int i = 0; i < 2; ++i) { int R, C; stage_rc(tid * 16 + i * 8192, R, C); const int Rb = Epi::PERM ? ((R & ~31) + perm32(R & 31)) : R;
        voffA[i] = (unsigned)(R * g.lda + C) * 2u; voffB[i] = (unsigned)(Rb * K + C) * 2u; }
    const size_t kstep = (size_t)(BK * 2);
    const size_t hstep = (size_t)HALF * K * 2;
    const size_t tstep = 2 * hstep;
    const size_t hstepA = (size_t)HALF * g.lda * 2, tstepA = 2 * hstepA;
    const unsigned ldsw = (unsigned)wid * 1024u;
    const int aoff = lds_byte(wr * 64 + fr, fq * 8), boff = lds_byte(wc * 32 + fr, fq * 8);
#define PG8_SA(b, h) (((b) * 2 + (h)) * HTB)
#define PG8_SB(b, h) ((4 + (b) * 2 + (h)) * HTB)
#define PG8_STAGE(bufoff, gbase, voff) do { _Pragma("unroll") for (int _i = 0; _i < 2; ++_i) \
        __builtin_amdgcn_global_load_lds((const unsigned*)((const char*)(gbase) + (voff)[_i]), (LAS unsigned*)(lds + (bufoff) + ldsw + _i * 8192), 16, 0, 0); } while (0)
#define PG8_LDA(dst, b, h) do { _Pragma("unroll") for (int m = 0; m < 4; ++m) _Pragma("unroll") for (int k = 0; k < 2; ++k) dst[m][k] = *(const LAS bf16x8*)(lds + PG8_SA(b, h) + aoff + m * 2048 + k * 1024); } while (0)
#define PG8_LDB(dst, b, h) do { _Pragma("unroll") for (int n = 0; n < 2; ++n) _Pragma("unroll") for (int k = 0; k < 2; ++k) dst[n][k] = *(const LAS bf16x8*)(lds + PG8_SB(b, h) + boff + n * 2048 + k * 1024); } while (0)
#define PG8_MMA(ai, bj, At, Bt) do { __builtin_amdgcn_s_setprio(1); _Pragma("unroll") for (int m = 0; m < 4; ++m) _Pragma("unroll") for (int n = 0; n < 2; ++n) _Pragma("unroll") for (int k = 0; k < 2; ++k) \
        acc[ai][bj][m][n] = __builtin_amdgcn_mfma_f32_16x16x32_bf16(Bt[n][k], At[m][k], acc[ai][bj][m][n], 0, 0, 0); __builtin_amdgcn_s_setprio(0); } while (0)
#define PG8_WAIT_V(n) asm volatile("s_waitcnt vmcnt(" #n ")" ::: "memory")
#define PG8_WAIT_L(n) asm volatile("s_waitcnt lgkmcnt(" #n ")" ::: "memory")
#define PG8_BAR __builtin_amdgcn_s_barrier()
#define PG8_SCHED __builtin_amdgcn_sched_barrier(0)
    Unit cur, nxt; int ui = 0;
    if (!S.next(0, cur)) return;
    f32x4 acc[2][2][4][2];
#pragma unroll
    for (int a = 0; a < 2; ++a)
#pragma unroll
        for (int b = 0; b < 2; ++b)
#pragma unroll
            for (int m = 0; m < 4; ++m)
#pragma unroll
                for (int n = 0; n < 2; ++n) acc[a][b][m][n] = (f32x4){0.f, 0.f, 0.f, 0.f};
    bf16x8 At[4][2], B0[2][2], B1[2][2];
    const char* cA = (const char*)g.A + (size_t)cur.pm * tstepA; const char* cB = (const char*)g.Bt + (size_t)cur.pn * tstep;
    PG8_STAGE(PG8_SB(0, 0), cB, voffB); PG8_STAGE(PG8_SB(0, 1), cB + hstep, voffB); PG8_STAGE(PG8_SA(0, 0), cA, voffA); PG8_STAGE(PG8_SA(0, 1), cA + hstepA, voffA);
    if (wr == 1) PG8_BAR;
    PG8_WAIT_V(2); PG8_BAR;
    PG8_STAGE(PG8_SB(1, 0), cB + kstep, voffB); PG8_STAGE(PG8_SA(1, 0), cA + kstep, voffA); PG8_STAGE(PG8_SB(1, 1), cB + hstep + kstep, voffB);
    PG8_WAIT_V(6); PG8_BAR;
    for (;;) {
        const bool has_next = S.next(ui + 1, nxt);
        const char* nA = has_next ? (const char*)g.A + (size_t)nxt.pm * tstepA : cA; const char* nB = has_next ? (const char*)g.Bt + (size_t)nxt.pn * tstep : cB;
        for (int t = 0; t < nt; t += 2) {
            const bool last = (t == nt - 2);
            const char* a1 = cA + (size_t)(t + 1) * kstep;
            const char* a2 = last ? nA : cA + (size_t)(t + 2) * kstep; const char* b2 = last ? nB : cB + (size_t)(t + 2) * kstep;
            const char* a3 = a2 + kstep; const char* b3 = b2 + kstep;
            PG8_LDB(B0, 0, 0); PG8_LDB(B1, 0, 1); PG8_SCHED; PG8_LDA(At, 0, 0); PG8_STAGE(PG8_SA(1, 1), a1 + hstepA, voffA);
            PG8_WAIT_V(8); PG8_WAIT_L(0); PG8_BAR; PG8_MMA(0, 0, At, B0); PG8_MMA(0, 1, At, B1); PG8_BAR; PG8_SCHED;
            PG8_LDA(At, 0, 1); PG8_STAGE(PG8_SB(0, 0), b2, voffB); PG8_STAGE(PG8_SB(0, 1), b2 + hstep, voffB); PG8_STAGE(PG8_SA(0, 0), a2, voffA);
            PG8_WAIT_V(8); PG8_WAIT_L(0); PG8_BAR; PG8_MMA(1, 0, At, B0); PG8_MMA(1, 1, At, B1); PG8_BAR; PG8_SCHED;
            PG8_LDB(B0, 1, 0); PG8_LDB(B1, 1, 1); PG8_SCHED; PG8_LDA(At, 1, 0); PG8_STAGE(PG8_SA(0, 1), a2 + hstepA, voffA);
            PG8_WAIT_V(8); PG8_WAIT_L(0); PG8_BAR; PG8_MMA(0, 0, At, B0); PG8_MMA(0, 1, At, B1); PG8_BAR; PG8_SCHED;
            PG8_LDA(At, 1, 1); PG8_STAGE(PG8_SB(1, 0), b3, voffB); PG8_STAGE(PG8_SB(1, 1), b3 + hstep, voffB); PG8_STAGE(PG8_SA(1, 0), a3, voffA);
            PG8_WAIT_V(8); PG8_WAIT_L(0); PG8_BAR; PG8_MMA(1, 0, At, B0); PG8_MMA(1, 1, At, B1); PG8_BAR; PG8_SCHED;
        }
        if (wr == 0) PG8_BAR;
        E(acc, cur, wr, wc, fr, fq);
        if (!has_next) break;
#pragma unroll
        for (int a = 0; a < 2; ++a)
#pragma unroll
            for (int b = 0; b < 2; ++b)
#pragma unroll
                for (int m = 0; m < 4; ++m)
#pragma unroll
                    for (int n = 0; n < 2; ++n) acc[a][b][m][n] = (f32x4){0.f, 0.f, 0.f, 0.f};
        cur = nxt; cA = nA; cB = nB; ++ui;
        if (wr == 1) PG8_BAR;
    }
    PG8_WAIT_V(0);
    PG8_BAR;
#undef PG8_SA
#undef PG8_SB
#undef PG8_STAGE
#undef PG8_LDA
#undef PG8_LDB
#undef PG8_MMA
#undef PG8_WAIT_V
#undef PG8_WAIT_L
#undef PG8_BAR
#undef PG8_SCHED
}
}

namespace att {
#define KSWZ(row, colB) ((row) * 256 + ((colB) ^ (((row) & 7) << 4)))
#define XSWZ(row, colB) ((row) * 128 + ((colB) ^ ((((row) >> 1) & 7) << 4)))
#define SBAR() __builtin_amdgcn_sched_barrier(0)
__device__ __forceinline__ int crow(int r, int hi) { return (r & 3) + 8 * (r >> 2) + 4 * hi; }
__device__ __forceinline__ unsigned cvtpk(float lo, float hi) { unsigned r; asm volatile("v_cvt_pk_bf16_f32 %0, %1, %2" : "=v"(r) : "v"(lo), "v"(hi)); return r; }
__device__ __forceinline__ bf16x8 ld8(const bf16_t* p) { return *(const GAS bf16x8*)p; }

__device__ __forceinline__ void partialSM(f32x16& p0, f32x16& p1, float& m_reg, float& mn, float& alpha, const float C, const float thr) {
    float pmax = p0[0];
#pragma unroll
    for (int r = 1; r < 16; ++r) pmax = fmaxf(pmax, p0[r]);
#pragma unroll
    for (int r = 0; r < 16; ++r) pmax = fmaxf(pmax, p1[r]);
    { auto rr = __builtin_amdgcn_permlane32_swap(__float_as_uint(pmax), __float_as_uint(pmax), false, false);
      pmax = fmaxf(__uint_as_float(rr[0]), __uint_as_float(rr[1])); }
    if (__builtin_expect(__all(pmax - m_reg <= thr), 1)) { mn = m_reg; alpha = 1.f; }
    else { mn = fmaxf(m_reg, pmax); alpha = __builtin_amdgcn_exp2f((m_reg - mn) * C); m_reg = mn; }
    const float mnC = -mn * C;
#pragma unroll
    for (int r = 0; r < 16; ++r) p0[r] = fmaf(p0[r], C, mnC);
#pragma unroll
    for (int r = 0; r < 16; ++r) p1[r] = fmaf(p1[r], C, mnC);
#pragma unroll
    for (int r = 0; r < 16; ++r) p0[r] = __builtin_amdgcn_exp2f(p0[r]);
}
__device__ __forceinline__ void finishSM(f32x16& p0, f32x16& p1, float alpha, float& l_reg, bf16x8& pa0, bf16x8& pa1, bf16x8& pa2, bf16x8& pa3) {
#pragma unroll
    for (int r = 0; r < 16; ++r) p1[r] = __builtin_amdgcn_exp2f(p1[r]);
    float ps = 0;
#pragma unroll
    for (int r = 0; r < 16; ++r) ps += p0[r];
#pragma unroll
    for (int r = 0; r < 16; ++r) ps += p1[r];
    { auto rr = __builtin_amdgcn_permlane32_swap(__float_as_uint(ps), __float_as_uint(ps), false, false);
      ps = __uint_as_float(rr[0]) + __uint_as_float(rr[1]); }
    l_reg = l_reg * alpha + ps;
#define PK4(P, BASE, OUT) do { unsigned a0 = cvtpk(P[BASE + 0], P[BASE + 1]), a1 = cvtpk(P[BASE + 2], P[BASE + 3]);   \
    unsigned b0 = cvtpk(P[BASE + 4], P[BASE + 5]), b1 = cvtpk(P[BASE + 6], P[BASE + 7]);                              \
    auto r0 = __builtin_amdgcn_permlane32_swap(a0, b0, false, false); auto r1 = __builtin_amdgcn_permlane32_swap(a1, b1, false, false); \
    u32x4 w = {r0[0], r1[0], r0[1], r1[1]}; OUT = *reinterpret_cast<bf16x8*>(&w); } while (0)
    PK4(p0, 0, pa0); PK4(p0, 8, pa1); PK4(p1, 0, pa2); PK4(p1, 8, pa3);
#undef PK4
}
__device__ __forceinline__ int v_st(int k, int c) { const int kk = (k & ~0xC) | ((k & 4) << 1) | ((k & 8) >> 1); return ((kk >> 3) * 4 + (c >> 5)) * 512 + ((kk & 7) * 32 + (c & 31)) * 2; }
__device__ __forceinline__ int v_rd_base(int lane) { return ((lane & 3) << 3) | (((lane >> 2) & 3) << 6) | (((lane >> 4) & 1) << 5) | (((lane >> 5) & 1) << 8); }
constexpr int v_rd_off(int d0, int ks, int half) { return d0 * 512 + ks * 4096 + half * 2048; }
template <int OFF> __device__ __forceinline__ s16x4 tr_read(int vb) {
    s16x4 r; asm volatile("ds_read_b64_tr_b16 %0, %1 offset:%2" : "=&v"(r) : "v"(vb), "i"(OFF) : "memory"); return r;
}
template <int D0> __device__ __forceinline__ void pv_one(f32x16& od, int vb, bf16x8 pa0, bf16x8 pa1, bf16x8 pa2, bf16x8 pa3) {
    const s16x4 l0 = tr_read<v_rd_off(D0, 0, 0)>(vb), h0 = tr_read<v_rd_off(D0, 0, 1)>(vb), l1 = tr_read<v_rd_off(D0, 1, 0)>(vb), h1 = tr_read<v_rd_off(D0, 1, 1)>(vb);
    const s16x4 l2 = tr_read<v_rd_off(D0, 2, 0)>(vb), h2 = tr_read<v_rd_off(D0, 2, 1)>(vb), l3 = tr_read<v_rd_off(D0, 3, 0)>(vb), h3 = tr_read<v_rd_off(D0, 3, 1)>(vb);
    asm volatile("s_waitcnt lgkmcnt(0)" ::: "memory"); SBAR();
#define PK(L, H) (bf16x8){L[0], L[1], L[2], L[3], H[0], H[1], H[2], H[3]}
    od = __builtin_amdgcn_mfma_f32_32x32x16_bf16(pa0, PK(l0, h0), od, 0, 0, 0);
    od = __builtin_amdgcn_mfma_f32_32x32x16_bf16(pa1, PK(l1, h1), od, 0, 0, 0);
    od = __builtin_amdgcn_mfma_f32_32x32x16_bf16(pa2, PK(l2, h2), od, 0, 0, 0);
    od = __builtin_amdgcn_mfma_f32_32x32x16_bf16(pa3, PK(l3, h3), od, 0, 0, 0);
#undef PK
}
__device__ __forceinline__ void pv_d0(f32x16* o, int vb, bf16x8 pa0, bf16x8 pa1, bf16x8 pa2, bf16x8 pa3) {
    pv_one<0>(o[0], vb, pa0, pa1, pa2, pa3); pv_one<1>(o[1], vb, pa0, pa1, pa2, pa3); pv_one<2>(o[2], vb, pa0, pa1, pa2, pa3); pv_one<3>(o[3], vb, pa0, pa1, pa2, pa3);
}

template <int RX, bool HOLDX, bool DIL, bool F32OUT>
__device__ __forceinline__ void attn_unit(const bf16_t* __restrict__ Qb, long ldq,
                                          const bf16_t* __restrict__ Kh, const bf16_t* __restrict__ Vh, long ldk,
                                          const bf16_t* __restrict__ Kx, long ldkx,
                                          const int NT, const float SCALE,
                                          bf16_t* Ob, long ldo, float* Of, long ldof, float* Lse, long ldl,
                                          const int q0, const int ssub, const float* biasL, char* lds, const int wv) {
    constexpr int NX = RX / 16, NQH = 8 + (HOLDX ? NX - 1 : 0);
    constexpr int SHM_V = 64 * 128 * 2, SHM_K = 64 * 128 * 2, SHM_X = 64 * (RX ? RX : 8) * 2;
    const int tid_ = opaque_tid(wv);
    const int tid = tid_, wid = tid >> 6, lane = tid & 63, r32 = lane & 31, hi = lane >> 5;
    char* V_lds = lds; char* K_lds = lds + 2 * SHM_V; char* X_lds = lds + 2 * SHM_V + 2 * SHM_K;
    float* ws = (float*)(lds + 2 * SHM_V + 2 * SHM_K + 2 * SHM_X) + wid * 64; float* li_l = ws; float* al_l = ws + 32;
    const float C = SCALE * 1.4426950408889634f, thr = 8.f / SCALE;
    float m_reg = DIL ? -1e29f : -1e30f, l_reg = 0; f32x16 o[4] = {}; bf16x8 qr[NQH];
    const bf16_t* Qw = Qb + (long)(wid * 32 + r32) * ldq + hi * 8;
#pragma unroll
    for (int d0 = 0; d0 < NQH; ++d0) qr[d0] = ld8(Qw + d0 * 16);
    const int sr = tid >> 4, sc = (tid & 15) * 8, vst0 = v_st(sr, sc), vst1 = v_st(32 + sr, sc);
    const int xr = tid >> 3, xc = (tid & 7) * 8;
    const int vb0 = (int)(uintptr_t)V_lds + v_rd_base(lane);
    const int kbase = DIL ? q0 - 64 : 0;
    bf16x8 vs0, vs1, ks0, ks1, xs0, xs1;
#define ROWK(k) (DIL ? (long)min(max((k), 0), ssub - 1) : (long)(k))
#define SLOAD(k0) do { const long ra_ = ROWK(kbase + (k0) + sr), rb_ = ROWK(kbase + (k0) + 32 + sr); \
        vs0 = ld8(Vh + ra_ * ldk + sc); vs1 = ld8(Vh + rb_ * ldk + sc); ks0 = ld8(Kh + ra_ * ldk + sc); ks1 = ld8(Kh + rb_ * ldk + sc); \
        if constexpr (RX == 64) { xs0 = ld8(Kx + (long)((k0) + xr) * ldkx + xc); } \
        if constexpr (RX == 128) { xs0 = ld8(Kx + ra_ * ldkx + sc); xs1 = ld8(Kx + rb_ * ldkx + sc); } } while (0)
#define SWRITE(b) do { *(bf16x8*)(V_lds + (b) * SHM_V + vst0) = vs0; *(bf16x8*)(V_lds + (b) * SHM_V + vst1) = vs1; const int kc = sc * 2; \
        *(bf16x8*)(K_lds + (b) * SHM_K + KSWZ(sr, kc)) = ks0; *(bf16x8*)(K_lds + (b) * SHM_K + KSWZ(32 + sr, kc)) = ks1; \
        if constexpr (RX == 64) { *(bf16x8*)(X_lds + (b) * SHM_X + XSWZ(xr, xc * 2)) = xs0; } \
        if constexpr (RX == 128) { *(bf16x8*)(X_lds + (b) * SHM_X + KSWZ(sr, kc)) = xs0; *(bf16x8*)(X_lds + (b) * SHM_X + KSWZ(32 + sr, kc)) = xs1; } } while (0)
#define SWAIT() asm volatile("s_waitcnt vmcnt(0)" ::: "memory")
#define RESC(a) do { if (__any((a) < 1.f)) { if (hi == 0) al_l[r32] = (a); asm volatile("s_waitcnt lgkmcnt(0)" ::: "memory"); \
        _Pragma("unroll") for (int d = 0; d < 4; ++d) _Pragma("unroll") for (int r = 0; r < 16; ++r) o[d][r] *= al_l[crow(r, hi)]; } } while (0)
#define QKT(P0, P1, b) do { P0 = f32x16{}; P1 = f32x16{}; const char* Kb_ = K_lds + (b) * SHM_K; const char* Xb_ = X_lds + (b) * SHM_X; \
        _Pragma("unroll") for (int d0 = 0; d0 < 8; ++d0) { const int cb = (d0 * 16 + hi * 8) * 2; \
            const bf16x8 b0 = *reinterpret_cast<const bf16x8*>(Kb_ + KSWZ(r32, cb)); const bf16x8 b1 = *reinterpret_cast<const bf16x8*>(Kb_ + KSWZ(32 + r32, cb)); \
            P0 = __builtin_amdgcn_mfma_f32_32x32x16_bf16(b0, qr[d0], P0, 0, 0, 0); P1 = __builtin_amdgcn_mfma_f32_32x32x16_bf16(b1, qr[d0], P1, 0, 0, 0); } \
        _Pragma("unroll") for (int x = 0; x < NX; ++x) { const int cb = (x * 16 + hi * 8) * 2; bf16x8 b0, b1; \
            if constexpr (RX == 64) { b0 = *reinterpret_cast<const bf16x8*>(Xb_ + XSWZ(r32, cb)); b1 = *reinterpret_cast<const bf16x8*>(Xb_ + XSWZ(32 + r32, cb)); } \
            else { b0 = *reinterpret_cast<const bf16x8*>(Xb_ + KSWZ(r32, cb)); b1 = *reinterpret_cast<const bf16x8*>(Xb_ + KSWZ(32 + r32, cb)); } \
            bf16x8 qx; if ((8 + x) < NQH) qx = qr[(8 + x) < NQH ? (8 + x) : 0]; else qx = ld8(Qw + (8 + x) * 16); \
            P0 = __builtin_amdgcn_mfma_f32_32x32x16_bf16(b0, qx, P0, 0, 0, 0); P1 = __builtin_amdgcn_mfma_f32_32x32x16_bf16(b1, qx, P1, 0, 0, 0); } } while (0)
#define MASK(P0, P1, t) do { if constexpr (DIL) { const int qq_ = q0 + wid * 32 + r32; const int kt_ = q0 - 64 + (t) * 64 + 4 * hi; \
        _Pragma("unroll") for (int r = 0; r < 16; ++r) { const int kk_ = kt_ + (r & 3) + 8 * (r >> 2); const int rel_ = kk_ - qq_; \
            { const bool ok_ = (rel_ >= -64) & (rel_ <= 64) & (kk_ >= 0) & (kk_ < ssub); const float b_ = biasL[min(max(rel_ + 64, 0), 128)]; P0[r] = ok_ ? P0[r] + b_ : -1e30f; } \
            { const int k2_ = kk_ + 32, r2_ = rel_ + 32; const bool ok_ = (r2_ >= -64) & (r2_ <= 64) & (k2_ >= 0) & (k2_ < ssub); const float b_ = biasL[min(max(r2_ + 64, 0), 128)]; P1[r] = ok_ ? P1[r] + b_ : -1e30f; } } } } while (0)
    f32x16 pA0, pA1, pB0, pB1; float mnA, mnB, alA, alB; bf16x8 pa0, pa1, pa2, pa3;
    SLOAD(0); SWAIT(); SWRITE(0); __syncthreads();
    QKT(pA0, pA1, 0); MASK(pA0, pA1, 0); partialSM(pA0, pA1, m_reg, mnA, alA, C, thr);
    SLOAD(64);
    SWAIT(); SWRITE(1); __syncthreads();
    for (int j = 1; j + 1 < NT; j += 2) {
        SBAR(); QKT(pB0, pB1, 1); MASK(pB0, pB1, j);
        finishSM(pA0, pA1, alA, l_reg, pa0, pa1, pa2, pa3); SBAR();
        SLOAD((j + 1) * 64); SBAR();
        pv_d0(o, vb0, pa0, pa1, pa2, pa3); partialSM(pB0, pB1, m_reg, mnB, alB, C, thr);
        __syncthreads(); SWAIT(); SWRITE(0);
        RESC(alB); __syncthreads();
        SBAR(); QKT(pA0, pA1, 0); MASK(pA0, pA1, j + 1);
        finishSM(pB0, pB1, alB, l_reg, pa0, pa1, pa2, pa3); SBAR();
        SLOAD((j + 2) * 64); SBAR();
        pv_d0(o, vb0 + SHM_V, pa0, pa1, pa2, pa3); partialSM(pA0, pA1, m_reg, mnA, alA, C, thr);
        __syncthreads(); SWAIT(); SWRITE(1);
        RESC(alA); __syncthreads();
    }
    SBAR(); QKT(pB0, pB1, 1); MASK(pB0, pB1, NT - 1);
    finishSM(pA0, pA1, alA, l_reg, pa0, pa1, pa2, pa3); SBAR();
    pv_d0(o, vb0, pa0, pa1, pa2, pa3); partialSM(pB0, pB1, m_reg, mnB, alB, C, thr);
    __syncthreads(); RESC(alB);
    finishSM(pB0, pB1, alB, l_reg, pa0, pa1, pa2, pa3); SBAR();
    pv_d0(o, vb0 + SHM_V, pa0, pa1, pa2, pa3);
    if (hi == 0) li_l[r32] = l_reg; asm volatile("s_waitcnt lgkmcnt(0)" ::: "memory");
    float rli[16];
#pragma unroll
    for (int r = 0; r < 16; ++r) rli[r] = __builtin_amdgcn_rcpf(li_l[crow(r, hi)]);
    if constexpr (F32OUT) {
        float* Ow = Of + (long)(wid * 32) * ldof;
#pragma unroll
        for (int r = 0; r < 16; ++r) { const int orow = crow(r, hi);
#pragma unroll
            for (int d0 = 0; d0 < 4; ++d0) *(GAS float*)(Ow + (long)orow * ldof + d0 * 32 + r32) = o[d0][r] * rli[r]; }
        if (hi == 0) *(GAS float*)(Lse + (long)(wid * 32 + r32) * ldl) = m_reg * SCALE + __logf(l_reg);
    } else {
        bf16_t* Ow = Ob + (long)(wid * 32) * ldo;
#pragma unroll
        for (int r = 0; r < 16; ++r) { const int orow = crow(r, hi);
#pragma unroll
            for (int d0 = 0; d0 < 4; ++d0) *(GAS bf16_t*)(Ow + (long)orow * ldo + d0 * 32 + r32) = (bf16_t)(cvtpk(o[d0][r] * rli[r], 0.f) & 0xffffu); }
    }
    __syncthreads();
#undef ROWK
#undef SLOAD
#undef SWRITE
#undef SWAIT
#undef RESC
#undef QKT
#undef MASK
}
}

__device__ __forceinline__ float wave_sum(float v, int lane) {
#pragma unroll
    for (int o = 1; o < 64; o <<= 1) v += shx(v, lane, o);
    return v;
}
__device__ __forceinline__ unsigned f2bf(float f) { unsigned u = __float_as_uint(f); return (u + 0x7fffu + ((u >> 16) & 1u)) >> 16; }
__device__ __forceinline__ unsigned pk2(float lo, float hi) { return f2bf(lo) | (f2bf(hi) << 16); }
__device__ __forceinline__ float bfbits2f(unsigned h) { return __uint_as_float(h << 16); }

__device__ __forceinline__ int src_col(int mat, int n) {
    if (mat == 0) { if (n >= 1024 && n < 1088) { const int p = n - 1024, j = p >> 3, e = p & 7; return 1024 + ((e < 4) ? (4 * j + e) : (32 + 4 * j + (e - 4))); }
        return n < 1088 ? n : (n < 1280 ? -1 : n - 192); }
    if (mat == 1) { if (n < 1536) { return (n >> 7) * 192 + (n & 127); }
        const int cc = n - 1536, h = cc >> 6, p = cc & 63, j = p >> 3, e = p & 7; const int orig = (e < 4) ? (4 * j + e) : (32 + 4 * j + (e - 4)); return h * 192 + 128 + orig; }
    return n;
}
__device__ __forceinline__ void transpose_item(const float* W, int K, int Nsrc, int Ndst, bf16_t* WT, int mat, LAS float* scr, int item, int lane, const float* kscale = nullptr) {
    const int nblk = Ndst / 32, kb = item / nblk, nb = item % nblk, k0 = 64 * kb, n0 = 32 * nb;
    const int sc = src_col(mat, n0 + (lane & 31));
#pragma unroll 8
    for (int i = 0; i < 32; ++i) { const int kk = 2 * i + (lane >> 5); float wv = (sc >= 0) ? W[(size_t)(k0 + kk) * Nsrc + sc] : 0.f; if (kscale) wv *= kscale[k0 + kk]; scr[kk * 33 + (lane & 31)] = wv; }
    asm volatile("s_waitcnt lgkmcnt(0)" ::: "memory");
    const int c = lane & 7;
#pragma unroll
    for (int j = 0; j < 4; ++j) { const int n = (lane >> 3) + 8 * j; const LAS float* s = scr + (8 * c) * 33 + n;
        u32x4 o; o.x = pk2(s[0 * 33], s[1 * 33]); o.y = pk2(s[2 * 33], s[3 * 33]); o.z = pk2(s[4 * 33], s[5 * 33]); o.w = pk2(s[6 * 33], s[7 * 33]);
        *(u32x4*)(WT + (size_t)(n0 + n) * K + k0 + 8 * c) = o; }
    asm volatile("s_waitcnt lgkmcnt(0)" ::: "memory");
}
__device__ __forceinline__ void norm_row_bf16(const float* xrow, const float* g, bf16_t* orow, int lane) {
    const f32x4* xr = (const f32x4*)xrow + lane; f32x4 v[8]; float s = 0.f;
#pragma unroll
    for (int j = 0; j < 8; ++j) { v[j] = xr[64 * j]; s += (v[j].x * v[j].x + v[j].y * v[j].y) + (v[j].z * v[j].z + v[j].w * v[j].w); }
    const float rstd = rsqrtf(wave_sum(s, lane) * (1.f / 2048.f) + EPS);
    const f32x4* gr = (const f32x4*)g + lane; u32x2* o8 = (u32x2*)orow + lane;
#pragma unroll
    for (int j = 0; j < 8; ++j) { const f32x4 gg = gr[64 * j]; u32x2 w; w.x = pk2(v[j].x * rstd * gg.x, v[j].y * rstd * gg.y); w.y = pk2(v[j].z * rstd * gg.z, v[j].w * rstd * gg.w); o8[64 * j] = w; }
}
__device__ __forceinline__ void norm_row_f32(float* xrow, const float* g, int lane) {
    f32x4* xr = (f32x4*)xrow + lane; f32x4 v[8]; float s = 0.f;
#pragma unroll
    for (int j = 0; j < 8; ++j) { v[j] = xr[64 * j]; s += (v[j].x * v[j].x + v[j].y * v[j].y) + (v[j].z * v[j].z + v[j].w * v[j].w); }
    const float rstd = rsqrtf(wave_sum(s, lane) * (1.f / 2048.f) + EPS);
    const f32x4* gr = (const f32x4*)g + lane;
#pragma unroll
    for (int j = 0; j < 8; ++j) { const f32x4 gg = gr[64 * j]; xr[64 * j] = v[j] * rstd * gg; }
}

__global__ void __launch_bounds__(512, 2) fwd_megakernel(Params P) {
    extern __shared__ __attribute__((aligned(16))) unsigned char lds[];
    cg::grid_group grid = cg::this_grid();
    const int G = gridDim.x, bx = blockIdx.x, NGW = G * 8;
    const int wv_s = __builtin_amdgcn_readfirstlane((int)threadIdx.x >> 6);
#define OPQ() const int tid_ = opaque_tid(wv_s); const int tid = tid_, lane = tid & 63, wave = __builtin_amdgcn_readfirstlane(tid >> 6), gw = bx * 8 + wave; (void)tid; (void)lane; (void)gw; WSP()
    LAS unsigned char* ldsl = (LAS unsigned char*)lds;
#define WSP() unsigned char* ws = P.ws; asm volatile("" : "+s"(ws))
#define ROPE ((const f32x2*)(ws + WS_ROPE))
#define BIAS ((float*)(ws + WS_BIAS))
#define WIN ((bf16_t*)(ws + WS_WIN))
#define WUQ ((bf16_t*)(ws + WS_WUQ))
#define WUKV ((bf16_t*)(ws + WS_WUKV))
#define WMKV ((bf16_t*)(ws + WS_WMKV))
#define WBM ((bf16_t*)(ws + WS_WBM))
#define WBD ((bf16_t*)(ws + WS_WBD))
#define WBX ((bf16_t*)(ws + WS_WBX))
#define WOUT ((bf16_t*)(ws + WS_WOUT))
#define WUP ((bf16_t*)(ws + WS_WUP))
#define WDN ((bf16_t*)(ws + WS_WDN))
#define MEMN ((bf16_t*)(ws + WS_MEMN))
#define MEMKV ((bf16_t*)(ws + WS_MEMKV))
#define H ((bf16_t*)(ws + WS_H))
#define PROJ ((bf16_t*)(ws + WS_PROJ))
#define UPACT ((bf16_t*)(ws + WS_PROJ))
#define CQ ((bf16_t*)(ws + WS_CQ))
#define CKV ((bf16_t*)(ws + WS_CKV))
#define KPE ((bf16_t*)(ws + WS_KPE))
#define QB ((bf16_t*)(ws + WS_Q))
#define KVB ((bf16_t*)(ws + WS_KV))
#define OMLA ((bf16_t*)(ws + WS_OMLA))
#define ODG ((float*)(ws + WS_ODG))
#define LSEB ((float*)(ws + WS_LSE))
#define ODIL ((bf16_t*)(ws + WS_ODIL))
#define OMEM ((bf16_t*)(ws + WS_OMEM))
#define TMP ((float*)(ws + WS_TMP))
#define MERG ((bf16_t*)(ws + WS_MERG))
#define SSQ ((float*)(ws + WS_SSQ))
#define SSQ2 ((float*)(ws + WS_SSQ2))
#define MLP ((float*)(ws + WS_MLP))
#define MLSE ((float*)(ws + WS_MLSE))

    {
        OPQ();
        LAS float* scr = (LAS float*)(ldsl + wave * 16384);
        constexpr int I0 = 32 * (NPROJ / 32), I1 = 8 * (NQ / 32), I2 = 8 * (NKV / 32), I3 = 32 * 64, I4 = 24 * 64, I5 = 8 * 64, I6 = 16 * 64, I7 = 32 * 64, I8 = 32 * 256, I9 = 128 * 64;
        constexpr int NITEMS = I0 + I1 + I2 + I3 + I4 + I5 + I6 + I7 + I8 + I9;
        for (int it = gw; it < NITEMS; it += NGW) {
            int r = it;
            if (r < I0) { transpose_item(P.in[6], 2048, 12864, NPROJ, WIN, 0, scr, r, lane); continue; } r -= I0;
            if (r < I1) { transpose_item(P.in[8], 512, NQ, NQ, WUQ, 1, scr, r, lane, P.in[7]); continue; } r -= I1;
            if (r < I2) { transpose_item(P.in[10], 512, NKV, NKV, WUKV, 2, scr, r, lane, P.in[9]); continue; } r -= I2;
            if (r < I3) { transpose_item(P.in[12], 2048, 2048, 2048, WMKV, 2, scr, r, lane); continue; } r -= I3;
            if (r < I4) { transpose_item(P.in[13], 1536, 2048, 2048, WBM, 2, scr, r, lane); continue; } r -= I4;
            if (r < I5) { transpose_item(P.in[14], 512, 2048, 2048, WBD, 2, scr, r, lane); continue; } r -= I5;
            if (r < I6) { transpose_item(P.in[15], 1024, 2048, 2048, WBX, 2, scr, r, lane); continue; } r -= I6;
            if (r < I7) { transpose_item(P.in[16], 2048, 2048, 2048, WOUT, 2, scr, r, lane); continue; } r -= I7;
            if (r < I8) { transpose_item(P.in[18], 2048, 8192, 8192, WUP, 2, scr, r, lane, P.in[17]); continue; } r -= I8;
            transpose_item(P.in[19], 8192, 2048, 2048, WDN, 2, scr, r, lane);
        }
        for (int idx = bx * 512 + tid; idx < 8192 * 32; idx += G * 512) {
            const int pos = idx >> 5, i = idx & 31; const float ang = (float)pos * P.inv[i];
            float t = ang * 0.15915494309189535f; t = t - floorf(t);
            const float rr = (t > 0.5f ? t - 1.f : t) * 6.283185307179586f;
            ((f32x2*)(ws + WS_ROPE))[idx] = (f32x2){__cosf(rr), __sinf(rr)};
        }
        for (int idx = bx * 512 + tid; idx < 12 * 129; idx += G * 512) {
            const int gh = idx / 129, k = idx % 129, g = gh >> 2;
            BIAS[idx] = P.in[4][(int)P.bkt[g][k] * 12 + gh] * 11.313708498984761f;
        }
        for (int m = gw; m < NMEMROWS; m += NGW) {
            const float* src = (m < 512) ? P.in[2] + (size_t)m * DM : P.in[3] + (size_t)(m - 512) * DM;
            norm_row_bf16(src, P.in[11], MEMN + (size_t)m * DM, lane);
        }
    }
    grid.sync();

    for (int ch = 0; ch < NCHUNK; ++ch) {
        const float* xin = (ch < 2) ? P.in[0] + (size_t)ch * MC * DM : P.in[1] + (size_t)(ch - 2) * MC * DM;
        float* xout = P.out + (size_t)ch * MC * DM;
        const int S = (ch < 2) ? 8192 : 4096;
        { OPQ(); for (int m = gw; m < MC; m += NGW) { norm_row_bf16(xin + (size_t)m * DM, P.in[5], H + (size_t)m * DM, lane);
            if (lane < 2) SSQ[m * 2 + lane] = 0.f; if (lane == 2) SSQ2[m] = 0.f; } }
        grid.sync();
        if ((PH & 8) && ch == 0) { WSP(); pg8::Gemm g{MEMN, WMKV, NMEMROWS, 2048, 2048, 2048}; pg8::StaticOrder So; So.init(NMEMROWS, 2048, G, G - 1 - bx);
            pg8::EpiStore<0, false> E{MEMKV, 2048, nullptr, 0, 0.f}; pg8::gemm_phase(ldsl, g, So, E, wv_s); }
        if (PH & 8) { WSP(); pg8::Gemm g{H, WIN, MC, NPROJ, 2048, 2048}; pg8::StaticOrder So; So.init(MC, NPROJ, G, bx);
          pg8::EpiProj E{PROJ, SSQ, KPE, ROPE, S - 1}; pg8::gemm_phase(ldsl, g, So, E, wv_s); }
        grid.sync();
        if (PH & 16) { WSP(); pg8::Gemm g{PROJ + OFF_CQ, WUQ, MC, NQ, 512, NPROJ}; pg8::StaticOrder So; So.init(MC, NQ, G, bx);
          pg8::EpiQRope E{QB, ROPE, S - 1, SSQ}; pg8::gemm_phase(ldsl, g, So, E, wv_s); }
        if (PH & 32) { WSP(); pg8::Gemm g{PROJ + OFF_CKV, WUKV, MC, NKV, 512, NPROJ}; pg8::StaticOrder So; So.init(MC, NKV, G, (bx + 128) % G);
          pg8::EpiStore<0, true> E{KVB, NKV, SSQ + 1, 2, 1.f / 512.f}; pg8::gemm_phase(ldsl, g, So, E, wv_s); }
        grid.sync();
        for (int u = bx; u < 1152; u += G) {
            OPQ();
            if ((PH & 1) && u < 256) {
                const int h = u >> 5, qb = u & 31, rowq = qb * 256, seqbase = (rowq / S) * S;
                att::attn_unit<64, true, false, false>(QB + (size_t)rowq * NQ + h * 192, NQ, KVB + (size_t)seqbase * NKV + h * 256, KVB + (size_t)seqbase * NKV + h * 256 + 128, NKV,
                    KPE + (size_t)seqbase * 64, 64, S / 64, 0.07216878364870322f, OMLA + (size_t)rowq * 1536 + h * 128, 1536, nullptr, 0, nullptr, 0, 0, 0, nullptr, (char*)lds, wv_s);
            } else if ((PH & 1) && u >= 256 && u < 512) {
                const int v = u - 256, half = v & 1, w = v >> 1, h4 = w >> 5, h = 8 + h4, qb = w & 31, rowq = qb * 256, seqbase = (rowq / S) * S, kr0 = seqbase + half * (S / 2);
                att::attn_unit<64, true, false, true>(QB + (size_t)rowq * NQ + h * 192, NQ, KVB + (size_t)kr0 * NKV + h * 256, KVB + (size_t)kr0 * NKV + h * 256 + 128, NKV,
                    KPE + (size_t)kr0 * 64, 64, S / 128, 0.07216878364870322f, nullptr, 0, MLP + ((size_t)half * MC + rowq) * 512 + h4 * 128, 512,
                    MLSE + ((size_t)half * MC + rowq) * 4 + h4, 4, 0, 0, nullptr, (char*)lds, wv_s);
            } else if ((PH & 2) && u >= 512 && u < 896) {
                const int v = u - 512, g = v >> 7, w = v & 127, hh = w >> 5, x = w & 31;
                const int per = S / 256, sq = x / per, y = x % per, r = (g == 0) ? 1 : (g == 1 ? 4 : 16), nblk = per / r, c = y / nblk, qb = y % nblk;
                const int seqbase = sq * S, ssub = S / r, q0 = qb * 256;
                float* bl = (float*)(lds + LDS_BIAS_OFF);
                if (tid < 129) bl[tid] = BIAS[(g * 4 + hh) * 129 + tid];
                __syncthreads();
                const size_t tok0 = (size_t)seqbase + c;
                const bf16_t* kb = PROJ + tok0 * NPROJ + OFF_DIL + 1536 + g * 512 + hh * 128;
                att::attn_unit<0, false, true, true>(PROJ + (tok0 + (size_t)r * q0) * NPROJ + OFF_DIL + g * 512 + hh * 128, (long)r * NPROJ, kb, kb + 1536, (long)r * NPROJ,
                    nullptr, 0, 6, 0.08838834764831845f, nullptr, 0, ODG + ((size_t)g * MC + tok0 + (size_t)r * q0) * 512 + hh * 128, (long)r * 512,
                    LSEB + ((size_t)g * MC + tok0 + (size_t)r * q0) * 4 + hh, (long)r * 4, q0, ssub, bl, (char*)lds, wv_s);
            } else if ((PH & 4) && u >= 896) {
                const int v = u - 896, vh = v & 1, w = v >> 1, h = w >> 5, qb = w & 31, rowq = qb * 256;
                const int bg = (ch < 2) ? ch : 2 + (ch - 2) * 2 + rowq / 4096;
                const bf16_t* kb = MEMKV + (size_t)bg * 256 * 2048 + h * 256;
                att::attn_unit<128, false, false, false>(PROJ + (size_t)rowq * NPROJ + OFF_XQ + h * 256, NPROJ, kb, kb + 1024 + vh * 128, 2048, kb + 128, 2048, 4, 0.0625f,
                    OMEM + (size_t)rowq * 1024 + h * 256 + vh * 128, 1024, nullptr, 0, nullptr, 0, 0, 0, nullptr, (char*)lds, wv_s);
            }
        }
        grid.sync();
        { OPQ();
        for (int m = gw; m < MC; m += NGW) {
            const int hh = lane >> 4; float l[3], wgt[3];
#pragma unroll
            for (int g = 0; g < 3; ++g) l[g] = LSEB[((size_t)g * MC + m) * 4 + hh];
            const float mx = fmaxf(l[0], fmaxf(l[1], l[2])); float sum = 0.f;
#pragma unroll
            for (int g = 0; g < 3; ++g) { wgt[g] = __expf(l[g] - mx); sum += wgt[g]; }
            const float inv = 1.f / sum; f32x4 a0 = {0.f, 0.f, 0.f, 0.f}, a1 = {0.f, 0.f, 0.f, 0.f};
#pragma unroll
            for (int g = 0; g < 3; ++g) { const f32x4* op = (const f32x4*)(ODG + ((size_t)g * MC + m) * 512) + 2 * lane; a0 += op[0] * (wgt[g] * inv); a1 += op[1] * (wgt[g] * inv); }
            u32x4 o; o.x = pk2(a0.x, a0.y); o.y = pk2(a0.z, a0.w); o.z = pk2(a1.x, a1.y); o.w = pk2(a1.z, a1.w);
            *((u32x4*)(ODIL + (size_t)m * 512) + lane) = o;
            {
                const float l0 = MLSE[((size_t)0 * MC + m) * 4 + hh], l1 = MLSE[((size_t)1 * MC + m) * 4 + hh]; const float mx2 = fmaxf(l0, l1);
                const float w0 = __expf(l0 - mx2), w1 = __expf(l1 - mx2), iv = 1.f / (w0 + w1);
                const f32x4* p0 = (const f32x4*)(MLP + ((size_t)0 * MC + m) * 512) + 2 * lane; const f32x4* p1 = (const f32x4*)(MLP + ((size_t)1 * MC + m) * 512) + 2 * lane;
                const f32x4 b0 = p0[0] * (w0 * iv) + p1[0] * (w1 * iv), b1 = p0[1] * (w0 * iv) + p1[1] * (w1 * iv);
                u32x4 o2; o2.x = pk2(b0.x, b0.y); o2.y = pk2(b0.z, b0.w); o2.z = pk2(b1.x, b1.y); o2.w = pk2(b1.z, b1.w);
                *((u32x4*)(OMLA + (size_t)m * 1536 + 1024) + lane) = o2; }
        } }
        if (PH & 64) { WSP(); pg8::Gemm g{OMLA, WBM, MC, 2048, 1536, 1536}; pg8::StaticOrder So; So.init(MC, 2048, G, bx);
          pg8::EpiGate<0> E{PROJ + OFF_GATE, TMP, MERG}; pg8::gemm_phase(ldsl, g, So, E, wv_s); }
        grid.sync();
        if (PH & 128) { WSP(); pg8::Gemm g{ODIL, WBD, MC, 2048, 512, 512}; pg8::StaticOrder So; So.init(MC, 2048, G, bx);
          pg8::EpiGate<1> E{PROJ + OFF_GATE + 2048, TMP, MERG}; pg8::gemm_phase(ldsl, g, So, E, wv_s); }
        if (PH & 256) { WSP(); pg8::Gemm g{OMEM, WBX, MC, 2048, 1024, 1024}; pg8::StaticOrder So; So.init(MC, 2048, G, bx);
          pg8::EpiGate<2> E{PROJ + OFF_GATE + 4096, TMP, MERG}; pg8::gemm_phase(ldsl, g, So, E, wv_s); }
        grid.sync();
        if (PH & 512) { WSP(); pg8::Gemm g{MERG, WOUT, MC, 2048, 2048, 2048}; pg8::StaticOrder So; So.init(MC, 2048, G, bx);
          pg8::EpiResid<true> E{xin, xout, H, SSQ2}; pg8::gemm_phase(ldsl, g, So, E, wv_s); }
        grid.sync();
        if (PH & 1024) { WSP(); pg8::Gemm g{H, WUP, MC, DFF, 2048, 2048}; pg8::StaticOrder So; So.init(MC, DFF, G, bx);
          pg8::EpiStore<1, true> E{UPACT, DFF, SSQ2, 1, 1.f / 2048.f}; pg8::gemm_phase(ldsl, g, So, E, wv_s); }
        grid.sync();
        if (PH & 2048) { WSP(); pg8::Gemm g{UPACT, WDN, MC, 2048, DFF, DFF}; pg8::StaticOrder So; So.init(MC, 2048, G, bx);
          pg8::EpiResid<false> E{xout, xout, nullptr, nullptr}; pg8::gemm_phase(ldsl, g, So, E, wv_s); }
        grid.sync();
        { OPQ(); for (int m = gw; m < MC; m += NGW) norm_row_f32(xout + (size_t)m * DM, P.in[20], lane); }
    }
}

static int t5_bucket_host(int rel) {
    const int nb = 16; int ret = (rel > 0) ? nb : 0; const int n = rel < 0 ? -rel : rel; const int max_exact = nb / 2;
    int large = max_exact + (int)(std::log((double)(n > 1 ? n : 1) / max_exact) / std::log(1024.0 / max_exact) * (nb - max_exact));
    if (large > nb - 1) large = nb - 1;
    return ret + (n < max_exact ? n : large);
}
extern "C" void kernel_launch(void* const* d_in, const int* in_sizes, int n_in, void* d_out, int out_size, void* d_ws, size_t ws_size, hipStream_t stream) {
    static int grid = 0;
    if (grid == 0) {
        if (n_in != 21 || ws_size < WS_END) { fprintf(stderr, "kernel_launch: n_in %d ws %zu (need %zu)\n", n_in, ws_size, (size_t)WS_END); grid = -1; return; }
        int dev = 0, cus = 0, per_cu = 0;
        hipGetDevice(&dev); hipDeviceGetAttribute(&cus, hipDeviceAttributeMultiprocessorCount, dev);
        hipFuncSetAttribute((const void*)fwd_megakernel, hipFuncAttributeMaxDynamicSharedMemorySize, LDS_BYTES);
        hipOccupancyMaxActiveBlocksPerMultiprocessor(&per_cu, (const void*)fwd_megakernel, 512, LDS_BYTES);
        if (per_cu < 1) per_cu = 1;
        grid = cus * 1;
        (void)hipGetLastError();
    }
    if (grid < 0) return;
    Params p{};
    for (int i = 0; i < 21; ++i) p.in[i] = (const float*)d_in[i];
    p.out = (float*)d_out; p.ws = (unsigned char*)d_ws;
    for (int i = 0; i < 32; ++i) p.inv[i] = 1.0f / powf(10000.0f, (float)i / 32.0f);
    const int dil[3] = {1, 4, 16};
    for (int g = 0; g < 3; ++g) for (int k = 0; k < 129; ++k) p.bkt[g][k] = (unsigned char)t5_bucket_host((k - 64) * dil[g]);
    void* args[] = {&p};
    hipError_t e = hipLaunchCooperativeKernel((const void*)fwd_megakernel, dim3(grid), dim3(512), args, LDS_BYTES, stream);
    if (e != hipSuccess) fprintf(stderr, "cooperative launch failed: %s (grid %d)\n", hipGetErrorString(e), grid);
}
```

```cpp
#include <hip/hip_runtime.h>
#include <hip/hip_cooperative_groups.h>
#include <cstdio>
#include <cstdint>
#include <cmath>
namespace cg = cooperative_groups;
#ifndef PH
#define PH 0xffff
#endif
#ifndef DBL
#define DBL 0
#endif

#define LAS __attribute__((address_space(3)))
#define GAS __attribute__((address_space(1)))
typedef unsigned short bf16_t;
typedef short bf16x8 __attribute__((ext_vector_type(8)));
typedef short s16x4 __attribute__((ext_vector_type(4)));
typedef float f32x4 __attribute__((ext_vector_type(4)));
typedef float f32x2 __attribute__((ext_vector_type(2)));
typedef float f32x16 __attribute__((ext_vector_type(16)));
typedef unsigned u32x4 __attribute__((ext_vector_type(4)));
typedef unsigned u32x2 __attribute__((ext_vector_type(2)));

__device__ __forceinline__ float shx(float v, int lane, int mask) { return __int_as_float(__builtin_amdgcn_ds_bpermute((lane ^ mask) << 2, __float_as_int(v))); }
__device__ __forceinline__ int opaque_tid(int wv) { int l; asm volatile("v_mbcnt_lo_u32_b32 %0, -1, 0\n\tv_mbcnt_hi_u32_b32 %0, -1, %0" : "=v"(l)); return wv * 64 + l; }
constexpr int DM = 2048, MC = 8192, NCHUNK = 6, DFF = 8192;
constexpr int NPROJ = 13056;
constexpr int OFF_CQ = 0, OFF_CKV = 512, OFF_KR = 1024, OFF_DIL = 1280, OFF_XQ = 5888, OFF_GATE = 6912;
constexpr int NQ = 2304, NKV = 3072;
constexpr int NMEMROWS = 2560;
constexpr float EPS = 1e-6f;

constexpr size_t WS_CTL  = 0;
constexpr size_t WS_ROPE = 4096;
constexpr size_t WS_BIAS = WS_ROPE + (size_t)8192 * 32 * 8;
constexpr size_t WS_WIN  = WS_BIAS + 8192;
constexpr size_t WS_WUQ  = WS_WIN  + (size_t)NPROJ * 2048 * 2;
constexpr size_t WS_WUKV = WS_WUQ  + (size_t)NQ * 512 * 2;
constexpr size_t WS_WMKV = WS_WUKV + (size_t)NKV * 512 * 2;
constexpr size_t WS_WBM  = WS_WMKV + (size_t)2048 * 2048 * 2;
constexpr size_t WS_WBD  = WS_WBM  + (size_t)2048 * 1536 * 2;
constexpr size_t WS_WBX  = WS_WBD  + (size_t)2048 * 512 * 2;
constexpr size_t WS_WOUT = WS_WBX  + (size_t)2048 * 1024 * 2;
constexpr size_t WS_WUP  = WS_WOUT + (size_t)2048 * 2048 * 2;
constexpr size_t WS_WDN  = WS_WUP  + (size_t)8192 * 2048 * 2;
constexpr size_t WS_MEMN = WS_WDN  + (size_t)2048 * 8192 * 2;
constexpr size_t WS_MEMKV= WS_MEMN + (size_t)NMEMROWS * 2048 * 2;
constexpr size_t WS_H    = WS_MEMKV+ (size_t)NMEMROWS * 2048 * 2;
constexpr size_t WS_PROJ = WS_H    + (size_t)MC * 2048 * 2;
constexpr size_t WS_CQ   = WS_PROJ + (size_t)MC * NPROJ * 2;
constexpr size_t WS_CKV  = WS_CQ   + (size_t)MC * 512 * 2;
constexpr size_t WS_KPE  = WS_CKV  + (size_t)MC * 512 * 2;
constexpr size_t WS_Q    = WS_KPE  + (size_t)MC * 64 * 2;
constexpr size_t WS_KV   = WS_Q    + (size_t)MC * NQ * 2;
constexpr size_t WS_OMLA = WS_KV   + (size_t)MC * NKV * 2;
constexpr size_t WS_ODG  = WS_OMLA + (size_t)MC * 1536 * 2;
constexpr size_t WS_LSE  = WS_ODG  + (size_t)3 * MC * 512 * 4;
constexpr size_t WS_ODIL = WS_LSE  + (size_t)3 * MC * 4 * 4;
constexpr size_t WS_OMEM = WS_ODIL + (size_t)MC * 512 * 2;
constexpr size_t WS_TMP  = WS_OMEM + (size_t)MC * 1024 * 2;
constexpr size_t WS_MERG = WS_TMP  + (size_t)MC * 2048 * 4;
constexpr size_t WS_SSQ  = WS_MERG + (size_t)MC * 2048 * 2;
constexpr size_t WS_SSQ2 = WS_SSQ  + (size_t)MC * 2 * 4;
constexpr size_t WS_MLP  = WS_SSQ2 + (size_t)MC * 4;
constexpr size_t WS_MLSE = WS_MLP  + (size_t)2 * MC * 512 * 4;
constexpr size_t WS_BAR  = WS_MLSE + (size_t)2 * MC * 4 * 4;
constexpr size_t WS_END  = WS_BAR + 16384;

constexpr int LDS_BYTES = 131072 + 1024;
constexpr int LDS_BIAS_OFF = 126976;

struct Params {
    const float* in[21]; float* out; unsigned char* ws;
    float inv[32];
    unsigned char bkt[3][132];
    int pad;
};

namespace pg8 {
constexpr int BM = 256, BK = 64, HALF = 128, HTB = HALF * BK * 2, STAGE_BYTES = 8 * HTB, NXCD = 8, WGM = 8;
__host__ __device__ __forceinline__ int lds_byte(int r, int c) { const int st = (r >> 4) * 2 + (c >> 5), rr = r & 15, cc = c & 31, ob = rr * 64 + cc * 2; return st * 1024 + (ob ^ (((ob >> 9) & 1) << 5)); }
__host__ __device__ __forceinline__ void stage_rc(int b, int& R, int& C) { const int st = b / 1024, sb = b % 1024, swz = sb ^ (((sb >> 9) & 1) << 5); R = (st >> 1) * 16 + swz / 64; C = (st & 1) * 32 + (swz % 64) / 2; }
__host__ __device__ __forceinline__ int perm32(int rho) { const int n = rho >> 4, i = rho & 15; return 8 * (i >> 2) + 4 * n + (i & 3); }
struct Unit { int pm, pn; };
struct Gemm { const bf16_t* A; const bf16_t* Bt; int M, N, K, lda; };
struct StaticOrder {
    int nM, nN, nwg, G, c;
    __host__ __device__ void init(int M, int N, int G_, int c_) { nM = M / BM; nN = N / BM; nwg = nM * nN; G = G_; c = c_; }
    __host__ __device__ bool next(int i, Unit& u) const {
        const long L = (long)i * G + c; if (L >= nwg) return false;
        int wgid = (int)L; { const int q = nwg / NXCD, r = nwg % NXCD, xcd = wgid % NXCD, off = wgid / NXCD; wgid = (xcd < r ? xcd * (q + 1) : r * (q + 1) + (xcd - r) * q) + off; }
        const int nig = WGM * nN, gid = wgid / nig, fm = gid * WGM, gsz = (nM - fm) < WGM ? (nM - fm) : WGM;
        u.pm = fm + ((wgid % nig) % gsz); u.pn = (wgid % nig) / gsz; return true;
    }
};
__device__ __forceinline__ unsigned cvt_pk_bf16(float lo, float hi) { unsigned r; asm volatile("v_cvt_pk_bf16_f32 %0, %1, %2" : "=v"(r) : "v"(lo), "v"(hi)); return r; }
__device__ __forceinline__ u32x4 pack8(f32x4 v0, f32x4 v1) { u32x4 w; w.x = cvt_pk_bf16(v0[0], v0[1]); w.y = cvt_pk_bf16(v0[2], v0[3]); w.z = cvt_pk_bf16(v1[0], v1[1]); w.w = cvt_pk_bf16(v1[2], v1[3]); return w; }
__device__ __forceinline__ float bf2f(unsigned short h) { return __uint_as_float(((unsigned)h) << 16); }

__device__ __forceinline__ void st16(bf16_t* p, u32x4 v) { *(GAS u32x4*)p = v; }
__device__ __forceinline__ void stf4(float* p, f32x4 v) { *(GAS f32x4*)p = v; }
__device__ __forceinline__ f32x4 ldf4(const float* p) { return *(const GAS f32x4*)p; }
__device__ __forceinline__ float sq8(f32x4 a, f32x4 b) { return (a[0] * a[0] + a[1] * a[1]) + (a[2] * a[2] + a[3] * a[3]) + (b[0] * b[0] + b[1] * b[1]) + (b[2] * b[2] + b[3] * b[3]); }
template <int ACT  , bool RS> struct EpiStore {
    static constexpr bool PERM = true;
    bf16_t* O; int ldc; const float* rs; int rss; float invdim;
    __device__ __forceinline__ void operator()(const f32x4 (&acc)[2][2][4][2], const Unit& u, int wr, int wc, int fr, int fq) const {
        const int row0 = u.pm * BM + wr * 64 + fr, col0 = u.pn * BM + wc * 32 + 8 * fq;
#pragma unroll
        for (int ai = 0; ai < 2; ++ai)
#pragma unroll
            for (int m = 0; m < 4; ++m) { const int row = row0 + ai * HALF + m * 16; bf16_t* rowp = O + (size_t)row * ldc + col0;
                float sc = 1.f; if (RS) sc = rsqrtf(*(const GAS float*)(rs + (size_t)row * rss) * invdim + EPS);
#pragma unroll
                for (int bj = 0; bj < 2; ++bj) { f32x4 v0 = acc[ai][bj][m][0], v1 = acc[ai][bj][m][1];
                    if (RS) { v0 *= sc; v1 *= sc; }
                    if (ACT == 1) {
#pragma unroll
                        for (int e = 0; e < 4; ++e) { float a = fmaxf(v0[e], 0.f), b = fmaxf(v1[e], 0.f); v0[e] = a * a; v1[e] = b * b; } }
                    st16(rowp + bj * HALF, pack8(v0, v1)); } }
    }
};
struct EpiProj {
    static constexpr bool PERM = true;
    bf16_t* O; float* ssq; bf16_t* kpe; const f32x2* rope; int posmask;
    __device__ __forceinline__ void operator()(const f32x4 (&acc)[2][2][4][2], const Unit& u, int wr, int wc, int fr, int fq) const {
        const int row0 = u.pm * BM + wr * 64 + fr, col0 = u.pn * BM + wc * 32 + 8 * fq;
        if (u.pn == 4) {
            if (wc < 2) {
                const int p = wc * 32 + 8 * fq, j = p >> 3;
#pragma unroll
                for (int ai = 0; ai < 2; ++ai)
#pragma unroll
                    for (int m = 0; m < 4; ++m) { const int row = row0 + ai * HALF + m * 16; const int pos = row & posmask;
                        const f32x4 v0 = acc[ai][0][m][0], v1 = acc[ai][0][m][1]; f32x4 o1, o2; const f32x2* rp = rope + (size_t)pos * 32 + 4 * j;
#pragma unroll
                        for (int e = 0; e < 4; ++e) { const f32x2 cs = *(const GAS f32x2*)(rp + e); o1[e] = v0[e] * cs.x - v1[e] * cs.y; o2[e] = v1[e] * cs.x + v0[e] * cs.y; }
                        st16(kpe + (size_t)row * 64 + p, pack8(o1, o2)); }
            }
            return;
        }
#pragma unroll
        for (int ai = 0; ai < 2; ++ai)
#pragma unroll
            for (int m = 0; m < 4; ++m) { const int row = row0 + ai * HALF + m * 16; bf16_t* rowp = O + (size_t)row * NPROJ + col0;
                st16(rowp, pack8(acc[ai][0][m][0], acc[ai][0][m][1])); st16(rowp + HALF, pack8(acc[ai][1][m][0], acc[ai][1][m][1]));
                if (u.pn < 4) { float s = sq8(acc[ai][0][m][0], acc[ai][0][m][1]) + sq8(acc[ai][1][m][0], acc[ai][1][m][1]);
                    { const int ln_ = fq * 16 + fr; s += shx(s, ln_, 16); s += shx(s, ln_, 32); }
                    if (fq == 0) __hip_atomic_fetch_add(ssq + (size_t)row * 2 + (u.pn >> 1), s, __ATOMIC_RELAXED, __HIP_MEMORY_SCOPE_AGENT); } }
    }
};
struct EpiQRope {
    static constexpr bool PERM = true;
    bf16_t* Q; const f32x2* rope; int posmask; const float* ssq;
    __device__ __forceinline__ void operator()(const f32x4 (&acc)[2][2][4][2], const Unit& u, int wr, int wc, int fr, int fq) const {
        const int row0 = u.pm * BM + wr * 64 + fr, col0 = u.pn * BM + wc * 32 + 8 * fq;
#pragma unroll
        for (int ai = 0; ai < 2; ++ai)
#pragma unroll
            for (int m = 0; m < 4; ++m) { const int row = row0 + ai * HALF + m * 16; const int pos = row & posmask;
                const float sc = rsqrtf(*(const GAS float*)(ssq + (size_t)row * 2) * (1.f / 512.f) + EPS);
#pragma unroll
                for (int bj = 0; bj < 2; ++bj) { const int c = col0 + bj * HALF; const f32x4 v0 = acc[ai][bj][m][0] * sc, v1 = acc[ai][bj][m][1] * sc;
                    if (u.pn < 6) { const int h = c >> 7, d = c & 127; st16(Q + (size_t)row * NQ + h * 192 + d, pack8(v0, v1)); }
                    else { const int cc = c - 1536, h = cc >> 6, p = cc & 63, j = p >> 3; f32x4 o1, o2;
                        const f32x2* rp = rope + (size_t)pos * 32 + 4 * j;
#pragma unroll
                        for (int e = 0; e < 4; ++e) { const f32x2 cs = *(const GAS f32x2*)(rp + e); o1[e] = v0[e] * cs.x - v1[e] * cs.y; o2[e] = v1[e] * cs.x + v0[e] * cs.y; }
                        st16(Q + (size_t)row * NQ + h * 192 + 128 + p, pack8(o1, o2)); } } }
    }
};
template <int MODE  > struct EpiGate {
    static constexpr bool PERM = true;
    const bf16_t* gate; float* tmp; bf16_t* merged;
    __device__ __forceinline__ void operator()(const f32x4 (&acc)[2][2][4][2], const Unit& u, int wr, int wc, int fr, int fq) const {
        const int row0 = u.pm * BM + wr * 64 + fr, col0 = u.pn * BM + wc * 32 + 8 * fq;
#pragma unroll
        for (int ai = 0; ai < 2; ++ai)
#pragma unroll
            for (int m = 0; m < 4; ++m) { const int row = row0 + ai * HALF + m * 16;
#pragma unroll
                for (int bj = 0; bj < 2; ++bj) { const int c = col0 + bj * HALF;
                    const u32x4 gw = *(const GAS u32x4*)(gate + (size_t)row * NPROJ + c);
                    f32x4 v0 = acc[ai][bj][m][0], v1 = acc[ai][bj][m][1];
#pragma unroll
                    for (int e = 0; e < 4; ++e) {
                        const unsigned w0 = gw[e >> 1], w1 = gw[2 + (e >> 1)];
                        const float g0 = __uint_as_float((e & 1) ? (w0 & 0xffff0000u) : (w0 << 16)), g1 = __uint_as_float((e & 1) ? (w1 & 0xffff0000u) : (w1 << 16));
                        v0[e] *= 1.f / (1.f + __expf(-g0)); v1[e] *= 1.f / (1.f + __expf(-g1)); }
                    float* tp = tmp + (size_t)row * DM + c;
                    if (MODE == 0) { stf4(tp, v0); stf4(tp + 4, v1); }
                    else { v0 += ldf4(tp); v1 += ldf4(tp + 4);
                        if (MODE == 1) { stf4(tp, v0); stf4(tp + 4, v1); }
                        else st16(merged + (size_t)row * DM + c, pack8(v0, v1)); } } }
    }
};
template <bool NRM> struct EpiResid {
    static constexpr bool PERM = true;
    const float* base; float* out; bf16_t* hb; float* ssq2;
    __device__ __forceinline__ void operator()(const f32x4 (&acc)[2][2][4][2], const Unit& u, int wr, int wc, int fr, int fq) const {
        const int row0 = u.pm * BM + wr * 64 + fr, col0 = u.pn * BM + wc * 32 + 8 * fq;
#pragma unroll
        for (int ai = 0; ai < 2; ++ai)
#pragma unroll
            for (int m = 0; m < 4; ++m) { const int row = row0 + ai * HALF + m * 16; const size_t off = (size_t)row * DM + col0; float s = 0.f;
#pragma unroll
                for (int bj = 0; bj < 2; ++bj) { const f32x4 o0 = ldf4(base + off + bj * HALF) + acc[ai][bj][m][0], o1 = ldf4(base + off + bj * HALF + 4) + acc[ai][bj][m][1];
                    stf4(out + off + bj * HALF, o0); stf4(out + off + bj * HALF + 4, o1);
                    if (NRM) { st16(hb + off + bj * HALF, pack8(o0, o1)); s += sq8(o0, o1); } }
                if (NRM) { { const int ln_ = fq * 16 + fr; s += shx(s, ln_, 16); s += shx(s, ln_, 32); }
                    if (fq == 0) __hip_atomic_fetch_add(ssq2 + row, s, __ATOMIC_RELAXED, __HIP_MEMORY_SCOPE_AGENT); } }
    }
};

template <class Epi>
__device__ __forceinline__ void gemm_phase(LAS unsigned char* lds, const Gemm g, const StaticOrder& S, const Epi& E, const int wv) {
    const int tid_ = opaque_tid(wv);
    const int tid = tid_, wid = __builtin_amdgcn_readfirstlane(tid >> 6), lane = tid & 63, wr = wid >> 2, wc = wid & 3, fr = lane & 15, fq = lane >> 4;
    const int K = g.K, nt = K / BK;
    unsigned voffA[2], voffB[2];
#pragma unroll
    for (int i = 0; i < 2; ++i) { int R, C; stage_rc(tid * 16 + i * 8192, R, C); const int Rb = Epi::PERM ? ((R & ~31) + perm32(R & 31)) : R;
        voffA[i] = (unsigned)(R * g.lda + C) * 2u; voffB[i] = (unsigned)(Rb * K + C) * 2u; }
    const size_t kstep = (size_t)(BK * 2);
    const size_t hstep = (size_t)HALF * K * 2;
    const size_t tstep = 2 * hstep;
    const size_t hstepA = (size_t)HALF * g.lda * 2, tstepA = 2 * hstepA;
    const unsigned ldsw = (unsigned)wid * 1024u;
    const int aoff = lds_byte(wr * 64 + fr, fq * 8), boff = lds_byte(wc * 32 + fr, fq * 8);
#define PG8_SA(b, h) (((b) * 2 + (h)) * HTB)
#define PG8_SB(b, h) ((4 + (b) * 2 + (h)) * HTB)
#define PG8_STAGE(bufoff, gbase, voff) do { _Pragma("unroll") for (int _i = 0; _i < 2; ++_i) \
        __builtin_amdgcn_global_load_lds((const unsigned*)((const char*)(gbase) + (voff)[_i]), (LAS unsigned*)(lds + (bufoff) + ldsw + _i * 8192), 16, 0, 0); } while (0)
#define PG8_LDA(dst, b, h) do { _Pragma("unroll") for (int m = 0; m < 4; ++m) _Pragma("unroll") for (int k = 0; k < 2; ++k) dst[m][k] = *(const LAS bf16x8*)(lds + PG8_SA(b, h) + aoff + m * 2048 + k * 1024); } while (0)
#define PG8_LDB(dst, b, h) do { _Pragma("unroll") for (int n = 0; n < 2; ++n) _Pragma("unroll") for (int k = 0; k < 2; ++k) dst[n][k] = *(const LAS bf16x8*)(lds + PG8_SB(b, h) + boff + n * 2048 + k * 1024); } while (0)
#define PG8_MMA(ai, bj, At, Bt) do { __builtin_amdgcn_s_setprio(1); _Pragma("unroll") for (int m = 0; m < 4; ++m) _Pragma("unroll") for (int n = 0; n < 2; ++n) _Pragma("unroll") for (int k = 0; k < 2; ++k) \
        acc[ai][bj][m][n] = __builtin_amdgcn_mfma_f32_16x16x32_bf16(Bt[n][k], At[m][k], acc[ai][bj][m][n], 0, 0, 0); __builtin_amdgcn_s_setprio(0); } while (0)
#define PG8_WAIT_V(n) asm volatile("s_waitcnt vmcnt(" #n ")" ::: "memory")
#define PG8_WAIT_L(n) asm volatile("s_waitcnt lgkmcnt(" #n ")" ::: "memory")
#define PG8_BAR __builtin_amdgcn_s_barrier()
#define PG8_SCHED __builtin_amdgcn_sched_barrier(0)
    Unit cur, nxt; int ui = 0;
    if (!S.next(0, cur)) return;
    f32x4 acc[2][2][4][2];
#pragma unroll
    for (int a = 0; a < 2; ++a)
#pragma unroll
        for (int b = 0; b < 2; ++b)
#pragma unroll
            for (int m = 0; m < 4; ++m)
#pragma unroll
                for (int n = 0; n < 2; ++n) acc[a][b][m][n] = (f32x4){0.f, 0.f, 0.f, 0.f};
    bf16x8 At[4][2], B0[2][2], B1[2][2];
    const char* cA = (const char*)g.A + (size_t)cur.pm * tstepA; const char* cB = (const char*)g.Bt + (size_t)cur.pn * tstep;
    PG8_STAGE(PG8_SB(0, 0), cB, voffB); PG8_STAGE(PG8_SB(0, 1), cB + hstep, voffB); PG8_STAGE(PG8_SA(0, 0), cA, voffA); PG8_STAGE(PG8_SA(0, 1), cA + hstepA, voffA);
    if (wr == 1) PG8_BAR;
    PG8_WAIT_V(2); PG8_BAR;
    PG8_STAGE(PG8_SB(1, 0), cB + kstep, voffB); PG8_STAGE(PG8_SA(1, 0), cA + kstep, voffA); PG8_STAGE(PG8_SB(1, 1), cB + hstep + kstep, voffB);
    PG8_WAIT_V(6); PG8_BAR;
    for (;;) {
        const bool has_next = S.next(ui + 1, nxt);
        const char* nA = has_next ? (const char*)g.A + (size_t)nxt.pm * tstepA : cA; const char* nB = has_next ? (const char*)g.Bt + (size_t)nxt.pn * tstep : cB;
        for (int t = 0; t < nt; t += 2) {
            const bool last = (t == nt - 2);
            const char* a1 = cA + (size_t)(t + 1) * kstep;
            const char* a2 = last ? nA : cA + (size_t)(t + 2) * kstep; const char* b2 = last ? nB : cB + (size_t)(t + 2) * kstep;
            const char* a3 = a2 + kstep; const char* b3 = b2 + kstep;
            PG8_LDB(B0, 0, 0); PG8_LDB(B1, 0, 1); PG8_SCHED; PG8_LDA(At, 0, 0); PG8_STAGE(PG8_SA(1, 1), a1 + hstepA, voffA);
            PG8_WAIT_V(8); PG8_WAIT_L(0); PG8_BAR; PG8_MMA(0, 0, At, B0); PG8_MMA(0, 1, At, B1); PG8_BAR; PG8_SCHED;
            PG8_LDA(At, 0, 1); PG8_STAGE(PG8_SB(0, 0), b2, voffB); PG8_STAGE(PG8_SB(0, 1), b2 + hstep, voffB); PG8_STAGE(PG8_SA(0, 0), a2, voffA);
            PG8_WAIT_V(8); PG8_WAIT_L(0); PG8_BAR; PG8_MMA(1, 0, At, B0); PG8_MMA(1, 1, At, B1); PG8_BAR; PG8_SCHED;
            PG8_LDB(B0, 1, 0); PG8_LDB(B1, 1, 1); PG8_SCHED; PG8_LDA(At, 1, 0); PG8_STAGE(PG8_SA(0, 1), a2 + hstepA, voffA);
            PG8_WAIT_V(8); PG8_WAIT_L(0); PG8_BAR; PG8_MMA(0, 0, At, B0); PG8_MMA(0, 1, At, B1); PG8_BAR; PG8_SCHED;
            PG8_LDA(At, 1, 1); PG8_STAGE(PG8_SB(1, 0), b3, voffB); PG8_STAGE(PG8_SB(1, 1), b3 + hstep, voffB); PG8_STAGE(PG8_SA(1, 0), a3, voffA);
            PG8_WAIT_V(8); PG8_WAIT_L(0); PG8_BAR; PG8_MMA(1, 0, At, B0); PG8_MMA(1, 1, At, B1); PG8_BAR; PG8_SCHED;
        }
        if (wr == 0) PG8_BAR;
        E(acc, cur, wr, wc, fr, fq);
        if (!has_next) break;
#pragma unroll
        for (int a = 0; a < 2; ++a)
#pragma unroll
            for (int b = 0; b < 2; ++b)
#pragma unroll
                for (int m = 0; m < 4; ++m)
#pragma unroll
                    for (int n = 0; n < 2; ++n) acc[a][b][m][n] = (f32x4){0.f, 0.f, 0.f, 0.f};
        cur = nxt; cA = nA; cB = nB; ++ui;
        if (wr == 1) PG8_BAR;
    }
    PG8_WAIT_V(0);
    PG8_BAR;
#undef PG8_SA
#undef PG8_SB
#undef PG8_STAGE
#undef PG8_LDA
#undef PG8_LDB
#undef PG8_MMA
#undef PG8_WAIT_V
#undef PG8_WAIT_L
#undef PG8_BAR
#undef PG8_SCHED
}
}

namespace att {
#define KSWZ(row, colB) ((row) * 256 + ((colB) ^ (((row) & 7) << 4)))
#define XSWZ(row, colB) ((row) * 128 + ((colB) ^ ((((row) >> 1) & 7) << 4)))
#define SBAR() __builtin_amdgcn_sched_barrier(0)
__device__ __forceinline__ int crow(int r, int hi) { return (r & 3) + 8 * (r >> 2) + 4 * hi; }
__device__ __forceinline__ unsigned cvtpk(float lo, float hi) { unsigned r; asm volatile("v_cvt_pk_bf16_f32 %0, %1, %2" : "=v"(r) : "v"(lo), "v"(hi)); return r; }
__device__ __forceinline__ bf16x8 ld8(const bf16_t* p) { return *(const GAS bf16x8*)p; }

__device__ __forceinline__ void partialSM(f32x16& p0, f32x16& p1, float& m_reg, float& mn, float& alpha, const float C, const float thr) {
    float pmax = p0[0];
#pragma unroll
    for (int r = 1; r < 16; ++r) pmax = fmaxf(pmax, p0[r]);
#pragma unroll
    for (int r = 0; r < 16; ++r) pmax = fmaxf(pmax, p1[r]);
    { auto rr = __builtin_amdgcn_permlane32_swap(__float_as_uint(pmax), __float_as_uint(pmax), false, false);
      pmax = fmaxf(__uint_as_float(rr[0]), __uint_as_float(rr[1])); }
    if (__builtin_expect(__all(pmax - m_reg <= thr), 1)) { mn = m_reg; alpha = 1.f; }
    else { mn = fmaxf(m_reg, pmax); alpha = __builtin_amdgcn_exp2f((m_reg - mn) * C); m_reg = mn; }
    const float mnC = -mn * C;
#pragma unroll
    for (int r = 0; r < 16; ++r) p0[r] = fmaf(p0[r], C, mnC);
#pragma unroll
    for (int r = 0; r < 16; ++r) p1[r] = fmaf(p1[r], C, mnC);
#pragma unroll
    for (int r = 0; r < 16; ++r) p0[r] = __builtin_amdgcn_exp2f(p0[r]);
}
__device__ __forceinline__ void finishSM(f32x16& p0, f32x16& p1, float alpha, float& l_reg, bf16x8& pa0, bf16x8& pa1, bf16x8& pa2, bf16x8& pa3) {
#pragma unroll
    for (int r = 0; r < 16; ++r) p1[r] = __builtin_amdgcn_exp2f(p1[r]);
    float ps = 0;
#pragma unroll
    for (int r = 0; r < 16; ++r) ps += p0[r];
#pragma unroll
    for (int r = 0; r < 16; ++r) ps += p1[r];
    { auto rr = __builtin_amdgcn_permlane32_swap(__float_as_uint(ps), __float_as_uint(ps), false, false);
      ps = __uint_as_float(rr[0]) + __uint_as_float(rr[1]); }
    l_reg = l_reg * alpha + ps;
#define PK4(P, BASE, OUT) do { unsigned a0 = cvtpk(P[BASE + 0], P[BASE + 1]), a1 = cvtpk(P[BASE + 2], P[BASE + 3]);   \
    unsigned b0 = cvtpk(P[BASE + 4], P[BASE + 5]), b1 = cvtpk(P[BASE + 6], P[BASE + 7]);                              \
    auto r0 = __builtin_amdgcn_permlane32_swap(a0, b0, false, false); auto r1 = __builtin_amdgcn_permlane32_swap(a1, b1, false, false); \
    u32x4 w = {r0[0], r1[0], r0[1], r1[1]}; OUT = *reinterpret_cast<bf16x8*>(&w); } while (0)
    PK4(p0, 0, pa0); PK4(p0, 8, pa1); PK4(p1, 0, pa2); PK4(p1, 8, pa3);
#undef PK4
}
__device__ __forceinline__ int v_st(int k, int c) { const int kk = (k & ~0xC) | ((k & 4) << 1) | ((k & 8) >> 1); return ((kk >> 3) * 4 + (c >> 5)) * 512 + ((kk & 7) * 32 + (c & 31)) * 2; }
__device__ __forceinline__ int v_rd_base(int lane) { return ((lane & 3) << 3) | (((lane >> 2) & 3) << 6) | (((lane >> 4) & 1) << 5) | (((lane >> 5) & 1) << 8); }
constexpr int v_rd_off(int d0, int ks, int half) { return d0 * 512 + ks * 4096 + half * 2048; }
template <int OFF> __device__ __forceinline__ s16x4 tr_read(int vb) {
    s16x4 r; asm volatile("ds_read_b64_tr_b16 %0, %1 offset:%2" : "=&v"(r) : "v"(vb), "i"(OFF) : "memory"); return r;
}
template <int D0> __device__ __forceinline__ void pv_one(f32x16& od, int vb, bf16x8 pa0, bf16x8 pa1, bf16x8 pa2, bf16x8 pa3) {
    const s16x4 l0 = tr_read<v_rd_off(D0, 0, 0)>(vb), h0 = tr_read<v_rd_off(D0, 0, 1)>(vb), l1 = tr_read<v_rd_off(D0, 1, 0)>(vb), h1 = tr_read<v_rd_off(D0, 1, 1)>(vb);
    const s16x4 l2 = tr_read<v_rd_off(D0, 2, 0)>(vb), h2 = tr_read<v_rd_off(D0, 2, 1)>(vb), l3 = tr_read<v_rd_off(D0, 3, 0)>(vb), h3 = tr_read<v_rd_off(D0, 3, 1)>(vb);
    asm volatile("s_waitcnt lgkmcnt(0)" ::: "memory"); SBAR();
#define PK(L, H) (bf16x8){L[0], L[1], L[2], L[3], H[0], H[1], H[2], H[3]}
    od = __builtin_amdgcn_mfma_f32_32x32x16_bf16(pa0, PK(l0, h0), od, 0, 0, 0);
    od = __builtin_amdgcn_mfma_f32_32x32x16_bf16(pa1, PK(l1, h1), od, 0, 0, 0);
    od = __builtin_amdgcn_mfma_f32_32x32x16_bf16(pa2, PK(l2, h2), od, 0, 0, 0);
    od = __builtin_amdgcn_mfma_f32_32x32x16_bf16(pa3, PK(l3, h3), od, 0, 0, 0);
#undef PK
}
__device__ __forceinline__ void pv_d0(f32x16* o, int vb, bf16x8 pa0, bf16x8 pa1, bf16x8 pa2, bf16x8 pa3) {
    pv_one<0>(o[0], vb, pa0, pa1, pa2, pa3); pv_one<1>(o[1], vb, pa0, pa1, pa2, pa3); pv_one<2>(o[2], vb, pa0, pa1, pa2, pa3); pv_one<3>(o[3], vb, pa0, pa1, pa2, pa3);
}

template <int RX, bool HOLDX, bool DIL, bool F32OUT>
__device__ __forceinline__ void attn_unit(const bf16_t* __restrict__ Qb, long ldq,
                                          const bf16_t* __restrict__ Kh, const bf16_t* __restrict__ Vh, long ldk,
                                          const bf16_t* __restrict__ Kx, long ldkx,
                                          const int NT, const float SCALE,
                                          bf16_t* Ob, long ldo, float* Of, long ldof, float* Lse, long ldl,
                                          const int q0, const int ssub, const float* biasL, char* lds, const int wv) {
    constexpr int NX = RX / 16, NQH = 8 + (HOLDX ? NX - 1 : 0);
    constexpr int SHM_V = 64 * 128 * 2, SHM_K = 64 * 128 * 2, SHM_X = 64 * (RX ? RX : 8) * 2;
    const int tid_ = opaque_tid(wv);
    const int tid = tid_, wid = tid >> 6, lane = tid & 63, r32 = lane & 31, hi = lane >> 5;
    char* V_lds = lds; char* K_lds = lds + 2 * SHM_V; char* X_lds = lds + 2 * SHM_V + 2 * SHM_K;
    float* ws = (float*)(lds + 2 * SHM_V + 2 * SHM_K + 2 * SHM_X) + wid * 64; float* li_l = ws; float* al_l = ws + 32;
    const float C = SCALE * 1.4426950408889634f, thr = 8.f / SCALE;
    float m_reg = DIL ? -1e29f : -1e30f, l_reg = 0; f32x16 o[4] = {}; bf16x8 qr[NQH];
    const bf16_t* Qw = Qb + (long)(wid * 32 + r32) * ldq + hi * 8;
#pragma unroll
    for (int d0 = 0; d0 < NQH; ++d0) qr[d0] = ld8(Qw + d0 * 16);
    const int sr = tid >> 4, sc = (tid & 15) * 8, vst0 = v_st(sr, sc), vst1 = v_st(32 + sr, sc);
    const int xr = tid >> 3, xc = (tid & 7) * 8;
    const int vb0 = (int)(uintptr_t)V_lds + v_rd_base(lane);
    const int kbase = DIL ? q0 - 64 : 0;
    bf16x8 vs0, vs1, ks0, ks1, xs0, xs1;
#define ROWK(k) (DIL ? (long)min(max((k), 0), ssub - 1) : (long)(k))
#define SLOAD(k0) do { const long ra_ = ROWK(kbase + (k0) + sr), rb_ = ROWK(kbase + (k0) + 32 + sr); \
        vs0 = ld8(Vh + ra_ * ldk + sc); vs1 = ld8(Vh + rb_ * ldk + sc); ks0 = ld8(Kh + ra_ * ldk + sc); ks1 = ld8(Kh + rb_ * ldk + sc); \
        if constexpr (RX == 64) { xs0 = ld8(Kx + (long)((k0) + xr) * ldkx + xc); } \
        if constexpr (RX == 128) { xs0 = ld8(Kx + ra_ * ldkx + sc); xs1 = ld8(Kx + rb_ * ldkx + sc); } } while (0)
#define SWRITE(b) do { *(bf16x8*)(V_lds + (b) * SHM_V + vst0) = vs0; *(bf16x8*)(V_lds + (b) * SHM_V + vst1) = vs1; const int kc = sc * 2; \
        *(bf16x8*)(K_lds + (b) * SHM_K + KSWZ(sr, kc)) = ks0; *(bf16x8*)(K_lds + (b) * SHM_K + KSWZ(32 + sr, kc)) = ks1; \
        if constexpr (RX == 64) { *(bf16x8*)(X_lds + (b) * SHM_X + XSWZ(xr, xc * 2)) = xs0; } \
        if constexpr (RX == 128) { *(bf16x8*)(X_lds + (b) * SHM_X + KSWZ(sr, kc)) = xs0; *(bf16x8*)(X_lds + (b) * SHM_X + KSWZ(32 + sr, kc)) = xs1; } } while (0)
#define SWAIT() asm volatile("s_waitcnt vmcnt(0)" ::: "memory")
#define RESC(a) do { if (__any((a) < 1.f)) { if (hi == 0) al_l[r32] = (a); asm volatile("s_waitcnt lgkmcnt(0)" ::: "memory"); \
        _Pragma("unroll") for (int d = 0; d < 4; ++d) _Pragma("unroll") for (int r = 0; r < 16; ++r) o[d][r] *= al_l[crow(r, hi)]; } } while (0)
#define QKT(P0, P1, b) do { P0 = f32x16{}; P1 = f32x16{}; const char* Kb_ = K_lds + (b) * SHM_K; const char* Xb_ = X_lds + (b) * SHM_X; \
        _Pragma("unroll") for (int d0 = 0; d0 < 8; ++d0) { const int cb = (d0 * 16 + hi * 8) * 2; \
            const bf16x8 b0 = *reinterpret_cast<const bf16x8*>(Kb_ + KSWZ(r32, cb)); const bf16x8 b1 = *reinterpret_cast<const bf16x8*>(Kb_ + KSWZ(32 + r32, cb)); \
            P0 = __builtin_amdgcn_mfma_f32_32x32x16_bf16(b0, qr[d0], P0, 0, 0, 0); P1 = __builtin_amdgcn_mfma_f32_32x32x16_bf16(b1, qr[d0], P1, 0, 0, 0); } \
        _Pragma("unroll") for (int x = 0; x < NX; ++x) { const int cb = (x * 16 + hi * 8) * 2; bf16x8 b0, b1; \
            if constexpr (RX == 64) { b0 = *reinterpret_cast<const bf16x8*>(Xb_ + XSWZ(r32, cb)); b1 = *reinterpret_cast<const bf16x8*>(Xb_ + XSWZ(32 + r32, cb)); } \
            else { b0 = *reinterpret_cast<const bf16x8*>(Xb_ + KSWZ(r32, cb)); b1 = *reinterpret_cast<const bf16x8*>(Xb_ + KSWZ(32 + r32, cb)); } \
            bf16x8 qx; if ((8 + x) < NQH) qx = qr[(8 + x) < NQH ? (8 + x) : 0]; else qx = ld8(Qw + (8 + x) * 16); \
            P0 = __builtin_amdgcn_mfma_f32_32x32x16_bf16(b0, qx, P0, 0, 0, 0); P1 = __builtin_amdgcn_mfma_f32_32x32x16_bf16(b1, qx, P1, 0, 0, 0); } } while (0)
#define MASK(P0, P1, t) do { if constexpr (DIL) { const int qq_ = q0 + wid * 32 + r32; const int kt_ = q0 - 64 + (t) * 64 + 4 * hi; \
        _Pragma("unroll") for (int r = 0; r < 16; ++r) { const int kk_ = kt_ + (r & 3) + 8 * (r >> 2); const int rel_ = kk_ - qq_; \
            { const bool ok_ = (rel_ >= -64) & (rel_ <= 64) & (kk_ >= 0) & (kk_ < ssub); const float b_ = biasL[min(max(rel_ + 64, 0), 128)]; P0[r] = ok_ ? P0[r] + b_ : -1e30f; } \
            { const int k2_ = kk_ + 32, r2_ = rel_ + 32; const bool ok_ = (r2_ >= -64) & (r2_ <= 64) & (k2_ >= 0) & (k2_ < ssub); const float b_ = biasL[min(max(r2_ + 64, 0), 128)]; P1[r] = ok_ ? P1[r] + b_ : -1e30f; } } } } while (0)
    f32x16 pA0, pA1, pB0, pB1; float mnA, mnB, alA, alB; bf16x8 pa0, pa1, pa2, pa3;
    SLOAD(0); SWAIT(); SWRITE(0); __syncthreads();
    QKT(pA0, pA1, 0); MASK(pA0, pA1, 0); partialSM(pA0, pA1, m_reg, mnA, alA, C, thr);
    SLOAD(64);
    SWAIT(); SWRITE(1); __syncthreads();
    for (int j = 1; j + 1 < NT; j += 2) {
        SBAR(); QKT(pB0, pB1, 1); MASK(pB0, pB1, j);
        finishSM(pA0, pA1, alA, l_reg, pa0, pa1, pa2, pa3); SBAR();
        SLOAD((j + 1) * 64); SBAR();
        pv_d0(o, vb0, pa0, pa1, pa2, pa3); partialSM(pB0, pB1, m_reg, mnB, alB, C, thr);
        __syncthreads(); SWAIT(); SWRITE(0);
        RESC(alB); __syncthreads();
        SBAR(); QKT(pA0, pA1, 0); MASK(pA0, pA1, j + 1);
        finishSM(pB0, pB1, alB, l_reg, pa0, pa1, pa2, pa3); SBAR();
        SLOAD((j + 2) * 64); SBAR();
        pv_d0(o, vb0 + SHM_V, pa0, pa1, pa2, pa3); partialSM(pA0, pA1, m_reg, mnA, alA, C, thr);
        __syncthreads(); SWAIT(); SWRITE(1);
        RESC(alA); __syncthreads();
    }
    SBAR(); QKT(pB0, pB1, 1); MASK(pB0, pB1, NT - 1);
    finishSM(pA0, pA1, alA, l_reg, pa0, pa1, pa2, pa3); SBAR();
    pv_d0(o, vb0, pa0, pa1, pa2, pa3); partialSM(pB0, pB1, m_reg, mnB, alB, C, thr);
    __syncthreads(); RESC(alB);
    finishSM(pB0, pB1, alB, l_reg, pa0, pa1, pa2, pa3); SBAR();
    pv_d0(o, vb0 + SHM_V, pa0, pa1, pa2, pa3);
    if (hi == 0) li_l[r32] = l_reg; asm volatile("s_waitcnt lgkmcnt(0)" ::: "memory");
    float rli[16];
#pragma unroll
    for (int r = 0; r < 16; ++r) rli[r] = __builtin_amdgcn_rcpf(li_l[crow(r, hi)]);
    if constexpr (F32OUT) {
        float* Ow = Of + (long)(wid * 32) * ldof;
#pragma unroll
        for (int r = 0; r < 16; ++r) { const int orow = crow(r, hi);
#pragma unroll
            for (int d0 = 0; d0 < 4; ++d0) *(GAS float*)(Ow + (long)orow * ldof + d0 * 32 + r32) = o[d0][r] * rli[r]; }
        if (hi == 0) *(GAS float*)(Lse + (long)(wid * 32 + r32) * ldl) = m_reg * SCALE + __logf(l_reg);
    } else {
        bf16_t* Ow = Ob + (long)(wid * 32) * ldo;
#pragma unroll
        for (int r = 0; r < 16; ++r) { const int orow = crow(r, hi);
#pragma unroll
            for (int d0 = 0; d0 < 4; ++d0) *(GAS bf16_t*)(Ow + (long)orow * ldo + d0 * 32 + r32) = (bf16_t)(cvtpk(o[d0][r] * rli[r], 0.f) & 0xffffu); }
    }
    __syncthreads();
#undef ROWK
#undef SLOAD
#undef SWRITE
#undef SWAIT
#undef RESC
#undef QKT
#undef MASK
}
}

__device__ __forceinline__ float wave_sum(float v, int lane) {
#pragma unroll
    for (int o = 1; o < 64; o <<= 1) v += shx(v, lane, o);
    return v;
}
__device__ __forceinline__ unsigned f2bf(float f) { unsigned u = __float_as_uint(f); return (u + 0x7fffu + ((u >> 16) & 1u)) >> 16; }
__device__ __forceinline__ unsigned pk2(float lo, float hi) { return f2bf(lo) | (f2bf(hi) << 16); }
__device__ __forceinline__ float bfbits2f(unsigned h) { return __uint_as_float(h << 16); }

__device__ __forceinline__ int src_col(int mat, int n) {
    if (mat == 0) { if (n >= 1024 && n < 1088) { const int p = n - 1024, j = p >> 3, e = p & 7; return 1024 + ((e < 4) ? (4 * j + e) : (32 + 4 * j + (e - 4))); }
        return n < 1088 ? n : (n < 1280 ? -1 : n - 192); }
    if (mat == 1) { if (n < 1536) { return (n >> 7) * 192 + (n & 127); }
        const int cc = n - 1536, h = cc >> 6, p = cc & 63, j = p >> 3, e = p & 7; const int orig = (e < 4) ? (4 * j + e) : (32 + 4 * j + (e - 4)); return h * 192 + 128 + orig; }
    return n;
}
__device__ __forceinline__ void transpose_item(const float* W, int K, int Nsrc, int Ndst, bf16_t* WT, int mat, LAS float* scr, int item, int lane, const float* kscale = nullptr) {
    const int nblk = Ndst / 32, kb = item / nblk, nb = item % nblk, k0 = 64 * kb, n0 = 32 * nb;
    const int sc = src_col(mat, n0 + (lane & 31));
#pragma unroll 8
    for (int i = 0; i < 32; ++i) { const int kk = 2 * i + (lane >> 5); float wv = (sc >= 0) ? W[(size_t)(k0 + kk) * Nsrc + sc] : 0.f; if (kscale) wv *= kscale[k0 + kk]; scr[kk * 33 + (lane & 31)] = wv; }
    asm volatile("s_waitcnt lgkmcnt(0)" ::: "memory");
    const int c = lane & 7;
#pragma unroll
    for (int j = 0; j < 4; ++j) { const int n = (lane >> 3) + 8 * j; const LAS float* s = scr + (8 * c) * 33 + n;
        u32x4 o; o.x = pk2(s[0 * 33], s[1 * 33]); o.y = pk2(s[2 * 33], s[3 * 33]); o.z = pk2(s[4 * 33], s[5 * 33]); o.w = pk2(s[6 * 33], s[7 * 33]);
        *(u32x4*)(WT + (size_t)(n0 + n) * K + k0 + 8 * c) = o; }
    asm volatile("s_waitcnt lgkmcnt(0)" ::: "memory");
}
__device__ __forceinline__ void norm_row_bf16(const float* xrow, const float* g, bf16_t* orow, int lane) {
    const f32x4* xr = (const f32x4*)xrow + lane; f32x4 v[8]; float s = 0.f;
#pragma unroll
    for (int j = 0; j < 8; ++j) { v[j] = xr[64 * j]; s += (v[j].x * v[j].x + v[j].y * v[j].y) + (v[j].z * v[j].z + v[j].w * v[j].w); }
    const float rstd = rsqrtf(wave_sum(s, lane) * (1.f / 2048.f) + EPS);
    const f32x4* gr = (const f32x4*)g + lane; u32x2* o8 = (u32x2*)orow + lane;
#pragma unroll
    for (int j = 0; j < 8; ++j) { const f32x4 gg = gr[64 * j]; u32x2 w; w.x = pk2(v[j].x * rstd * gg.x, v[j].y * rstd * gg.y); w.y = pk2(v[j].z * rstd * gg.z, v[j].w * rstd * gg.w); o8[64 * j] = w; }
}
__device__ __forceinline__ void norm_row_f32(float* xrow, const float* g, int lane) {
    f32x4* xr = (f32x4*)xrow + lane; f32x4 v[8]; float s = 0.f;
#pragma unroll
    for (int j = 0; j < 8; ++j) { v[j] = xr[64 * j]; s += (v[j].x * v[j].x + v[j].y * v[j].y) + (v[j].z * v[j].z + v[j].w * v[j].w); }
    const float rstd = rsqrtf(wave_sum(s, lane) * (1.f / 2048.f) + EPS);
    const f32x4* gr = (const f32x4*)g + lane;
#pragma unroll
    for (int j = 0; j < 8; ++j) { const f32x4 gg = gr[64 * j]; xr[64 * j] = v[j] * rstd * gg; }
}


#define XB_TMO      128
#define XB_XCNT(j)  (256  + 64 * (j))
#define XB_XSUB(j)  (1280 + 64 * (j))
#define XB_XGEN(j)  (2304 + 64 * (j))
#define XB_TOP      3328
#define XB_TOPGEN   3392
#define XCD_BAR_WORDS 3456
#define XB_SPIN_CAP (1u << 18)
__device__ __forceinline__ unsigned xb_ld(unsigned* p)              { return __hip_atomic_load(p, __ATOMIC_RELAXED, __HIP_MEMORY_SCOPE_AGENT); }
__device__ __forceinline__ unsigned xb_add(unsigned* p, unsigned v) { return __hip_atomic_fetch_add(p, v, __ATOMIC_RELAXED, __HIP_MEMORY_SCOPE_AGENT); }
__device__ __forceinline__ unsigned xb_xcc_id() { return (unsigned)__builtin_amdgcn_s_getreg((3 << 11) | 20) & 0xFu; }
#define XB_SPIN(cond, bar) do { unsigned _sp = 0; while (cond) { __builtin_amdgcn_s_sleep(1); \
    if ((++_sp & 255u) == 0u) { if (xb_ld(&(bar)[XB_TMO])) break; if (_sp > XB_SPIN_CAP) { atomicAdd(&(bar)[XB_TMO], 1u); break; } } } } while (0)
struct XcdBarrier { unsigned* bar; unsigned x; volatile LAS unsigned* st; };
__device__ __forceinline__ void xcd_barrier_complete(unsigned* bar, unsigned x, unsigned& nloc, unsigned& nx) {
    const unsigned G = gridDim.x * gridDim.y * gridDim.z;
    unsigned sum, cnt, mine, sp = 0u;
    for (;;) {
        sum = 0u; cnt = 0u; mine = 0u;
#pragma unroll
        for (unsigned j = 0; j < 16; ++j) { const unsigned c = xb_ld(&bar[XB_XCNT(j)]); sum += c; cnt += (c > 0u) ? 1u : 0u; mine = (j == x) ? c : mine; }
        if (sum == G) break;
        __builtin_amdgcn_s_sleep(1);
        if ((++sp & 255u) == 0u) { if (xb_ld(&bar[XB_TMO])) break; if (sp > XB_SPIN_CAP) { atomicAdd(&bar[XB_TMO], 1u); break; } }
    }
    nloc = mine > 0u ? mine : 1u; nx = cnt > 0u ? cnt : 1u;
}
__device__ __forceinline__ void xcd_barrier(const XcdBarrier& b, const bool leader_thread) {
    asm volatile("s_waitcnt vmcnt(0)" ::: "memory");
    __syncthreads();
    if (leader_thread) {
        unsigned* bar = b.bar;
        __builtin_amdgcn_s_waitcnt(0);
        unsigned nloc = b.st[0], nx = b.st[1];
        if (nloc == 0u) { xcd_barrier_complete(bar, b.x, nloc, nx); b.st[0] = nloc; b.st[1] = nx; }
        const unsigned old = xb_add(&bar[XB_XSUB(b.x)], 1u);
        const unsigned gen = old / nloc;
        if (old + 1u == (gen + 1u) * nloc) {
            __builtin_amdgcn_fence(__ATOMIC_RELEASE, "agent");
            asm volatile("s_waitcnt vmcnt(0)" ::: "memory");
            const unsigned og = xb_add(&bar[XB_TOP], 1u);
            const unsigned tg = og / nx;
            if (og + 1u == (tg + 1u) * nx) xb_add(&bar[XB_TOPGEN], 1u);
            else XB_SPIN(xb_ld(&bar[XB_TOPGEN]) == tg, bar);
            __builtin_amdgcn_fence(__ATOMIC_ACQUIRE, "agent");
            xb_add(&bar[XB_XGEN(b.x)], 1u);
            asm volatile("s_waitcnt vmcnt(0)" ::: "memory");
        } else {
            XB_SPIN(xb_ld(&bar[XB_XGEN(b.x)]) == gen, bar);
            __builtin_amdgcn_fence(__ATOMIC_ACQUIRE, "agent");
            asm volatile("s_waitcnt vmcnt(0)" ::: "memory");
        }
    }
    __syncthreads();
}

__global__ void __launch_bounds__(512, 2) fwd_megakernel(Params P) {
    extern __shared__ __attribute__((aligned(16))) unsigned char lds[];
    cg::grid_group grid = cg::this_grid();
    const int G = gridDim.x, bx = blockIdx.x, NGW = G * 8;
    const int wv_s = __builtin_amdgcn_readfirstlane((int)threadIdx.x >> 6);
    XcdBarrier xbar;
    {   volatile LAS unsigned* st = (volatile LAS unsigned*)((LAS unsigned char*)lds + 131072);
        if (threadIdx.x < 2) st[threadIdx.x] = 0u;
        __syncthreads();
        xbar.bar = (unsigned*)(P.ws + WS_BAR); xbar.x = xb_xcc_id(); xbar.st = st;
        if (threadIdx.x == 0) (void)xb_add(&xbar.bar[XB_XCNT(xbar.x)], 1u); }
#define GSYNC() xcd_barrier(xbar, opaque_tid(wv_s) == 0)
#define OPQ() const int tid_ = opaque_tid(wv_s); const int tid = tid_, lane = tid & 63, wave = __builtin_amdgcn_readfirstlane(tid >> 6), gw = bx * 8 + wave; (void)tid; (void)lane; (void)gw; WSP()
    LAS unsigned char* ldsl = (LAS unsigned char*)lds;
#define WSP() unsigned char* ws = P.ws; asm volatile("" : "+s"(ws))
#define ROPE ((const f32x2*)(ws + WS_ROPE))
#define BIAS ((float*)(ws + WS_BIAS))
#define WIN ((bf16_t*)(ws + WS_WIN))
#define WUQ ((bf16_t*)(ws + WS_WUQ))
#define WUKV ((bf16_t*)(ws + WS_WUKV))
#define WMKV ((bf16_t*)(ws + WS_WMKV))
#define WBM ((bf16_t*)(ws + WS_WBM))
#define WBD ((bf16_t*)(ws + WS_WBD))
#define WBX ((bf16_t*)(ws + WS_WBX))
#define WOUT ((bf16_t*)(ws + WS_WOUT))
#define WUP ((bf16_t*)(ws + WS_WUP))
#define WDN ((bf16_t*)(ws + WS_WDN))
#define MEMN ((bf16_t*)(ws + WS_MEMN))
#define MEMKV ((bf16_t*)(ws + WS_MEMKV))
#define H ((bf16_t*)(ws + WS_H))
#define PROJ ((bf16_t*)(ws + WS_PROJ))
#define UPACT ((bf16_t*)(ws + WS_PROJ))
#define CQ ((bf16_t*)(ws + WS_CQ))
#define CKV ((bf16_t*)(ws + WS_CKV))
#define KPE ((bf16_t*)(ws + WS_KPE))
#define QB ((bf16_t*)(ws + WS_Q))
#define KVB ((bf16_t*)(ws + WS_KV))
#define OMLA ((bf16_t*)(ws + WS_OMLA))
#define ODG ((float*)(ws + WS_ODG))
#define LSEB ((float*)(ws + WS_LSE))
#define ODIL ((bf16_t*)(ws + WS_ODIL))
#define OMEM ((bf16_t*)(ws + WS_OMEM))
#define TMP ((float*)(ws + WS_TMP))
#define MERG ((bf16_t*)(ws + WS_MERG))
#define SSQ ((float*)(ws + WS_SSQ))
#define SSQ2 ((float*)(ws + WS_SSQ2))
#define MLP ((float*)(ws + WS_MLP))
#define MLSE ((float*)(ws + WS_MLSE))

    {
        OPQ();
        LAS float* scr = (LAS float*)(ldsl + wave * 16384);
        constexpr int I0 = 32 * (NPROJ / 32), I1 = 8 * (NQ / 32), I2 = 8 * (NKV / 32), I3 = 32 * 64, I4 = 24 * 64, I5 = 8 * 64, I6 = 16 * 64, I7 = 32 * 64, I8 = 32 * 256, I9 = 128 * 64;
        constexpr int NITEMS = I0 + I1 + I2 + I3 + I4 + I5 + I6 + I7 + I8 + I9;
        for (int it = gw; it < NITEMS; it += NGW) {
            int r = it;
            if (r < I0) { transpose_item(P.in[6], 2048, 12864, NPROJ, WIN, 0, scr, r, lane); continue; } r -= I0;
            if (r < I1) { transpose_item(P.in[8], 512, NQ, NQ, WUQ, 1, scr, r, lane, P.in[7]); continue; } r -= I1;
            if (r < I2) { transpose_item(P.in[10], 512, NKV, NKV, WUKV, 2, scr, r, lane, P.in[9]); continue; } r -= I2;
            if (r < I3) { transpose_item(P.in[12], 2048, 2048, 2048, WMKV, 2, scr, r, lane); continue; } r -= I3;
            if (r < I4) { transpose_item(P.in[13], 1536, 2048, 2048, WBM, 2, scr, r, lane); continue; } r -= I4;
            if (r < I5) { transpose_item(P.in[14], 512, 2048, 2048, WBD, 2, scr, r, lane); continue; } r -= I5;
            if (r < I6) { transpose_item(P.in[15], 1024, 2048, 2048, WBX, 2, scr, r, lane); continue; } r -= I6;
            if (r < I7) { transpose_item(P.in[16], 2048, 2048, 2048, WOUT, 2, scr, r, lane); continue; } r -= I7;
            if (r < I8) { transpose_item(P.in[18], 2048, 8192, 8192, WUP, 2, scr, r, lane, P.in[17]); continue; } r -= I8;
            transpose_item(P.in[19], 8192, 2048, 2048, WDN, 2, scr, r, lane);
        }
        for (int idx = bx * 512 + tid; idx < 8192 * 32; idx += G * 512) {
            const int pos = idx >> 5, i = idx & 31; const float ang = (float)pos * P.inv[i];
            float t = ang * 0.15915494309189535f; t = t - floorf(t);
            const float rr = (t > 0.5f ? t - 1.f : t) * 6.283185307179586f;
            ((f32x2*)(ws + WS_ROPE))[idx] = (f32x2){__cosf(rr), __sinf(rr)};
        }
        for (int idx = bx * 512 + tid; idx < 12 * 129; idx += G * 512) {
            const int gh = idx / 129, k = idx % 129, g = gh >> 2;
            BIAS[idx] = P.in[4][(int)P.bkt[g][k] * 12 + gh] * 11.313708498984761f;
        }
        for (int m = gw; m < NMEMROWS; m += NGW) {
            const float* src = (m < 512) ? P.in[2] + (size_t)m * DM : P.in[3] + (size_t)(m - 512) * DM;
            norm_row_bf16(src, P.in[11], MEMN + (size_t)m * DM, lane);
        }
    }
    grid.sync();

    for (int ch = 0; ch < NCHUNK; ++ch) {
        const float* xin = (ch < 2) ? P.in[0] + (size_t)ch * MC * DM : P.in[1] + (size_t)(ch - 2) * MC * DM;
        float* xout = P.out + (size_t)ch * MC * DM;
        const int S = (ch < 2) ? 8192 : 4096;
        { OPQ(); for (int m = gw; m < MC; m += NGW) { norm_row_bf16(xin + (size_t)m * DM, P.in[5], H + (size_t)m * DM, lane);
            if (lane < 2) SSQ[m * 2 + lane] = 0.f; if (lane == 2) SSQ2[m] = 0.f; } }
        GSYNC();
        if ((PH & 8) && ch == 0) { WSP(); pg8::Gemm g{MEMN, WMKV, NMEMROWS, 2048, 2048, 2048}; pg8::StaticOrder So; So.init(NMEMROWS, 2048, G, G - 1 - bx);
            pg8::EpiStore<0, false> E{MEMKV, 2048, nullptr, 0, 0.f}; pg8::gemm_phase(ldsl, g, So, E, wv_s); }
        if (PH & 8) { WSP(); pg8::Gemm g{H, WIN, MC, NPROJ, 2048, 2048}; pg8::StaticOrder So; So.init(MC, NPROJ, G, bx);
          pg8::EpiProj E{PROJ, SSQ, KPE, ROPE, S - 1}; pg8::gemm_phase(ldsl, g, So, E, wv_s); }
        GSYNC();
        if (PH & 16) { WSP(); pg8::Gemm g{PROJ + OFF_CQ, WUQ, MC, NQ, 512, NPROJ}; pg8::StaticOrder So; So.init(MC, NQ, G, bx);
          pg8::EpiQRope E{QB, ROPE, S - 1, SSQ}; pg8::gemm_phase(ldsl, g, So, E, wv_s); }
        if (PH & 32) { WSP(); pg8::Gemm g{PROJ + OFF_CKV, WUKV, MC, NKV, 512, NPROJ}; pg8::StaticOrder So; So.init(MC, NKV, G, (bx + 128) % G);
          pg8::EpiStore<0, true> E{KVB, NKV, SSQ + 1, 2, 1.f / 512.f}; pg8::gemm_phase(ldsl, g, So, E, wv_s); }
        GSYNC();
        for (int rep_ = 0; rep_ < ((DBL & 1) ? 2 : 1); ++rep_)
        for (int u = bx; u < 1152; u += G) {
            OPQ();
            if ((PH & 1) && u < 256) {
                const int h = u >> 5, qb = u & 31, rowq = qb * 256, seqbase = (rowq / S) * S;
                att::attn_unit<64, true, false, false>(QB + (size_t)rowq * NQ + h * 192, NQ, KVB + (size_t)seqbase * NKV + h * 256, KVB + (size_t)seqbase * NKV + h * 256 + 128, NKV,
                    KPE + (size_t)seqbase * 64, 64, S / 64, 0.07216878364870322f, OMLA + (size_t)rowq * 1536 + h * 128, 1536, nullptr, 0, nullptr, 0, 0, 0, nullptr, (char*)lds, wv_s);
            } else if ((PH & 1) && u >= 256 && u < 512) {
                const int v = u - 256, half = v & 1, w = v >> 1, h4 = w >> 5, h = 8 + h4, qb = w & 31, rowq = qb * 256, seqbase = (rowq / S) * S, kr0 = seqbase + half * (S / 2);
                att::attn_unit<64, true, false, true>(QB + (size_t)rowq * NQ + h * 192, NQ, KVB + (size_t)kr0 * NKV + h * 256, KVB + (size_t)kr0 * NKV + h * 256 + 128, NKV,
                    KPE + (size_t)kr0 * 64, 64, S / 128, 0.07216878364870322f, nullptr, 0, MLP + ((size_t)half * MC + rowq) * 512 + h4 * 128, 512,
                    MLSE + ((size_t)half * MC + rowq) * 4 + h4, 4, 0, 0, nullptr, (char*)lds, wv_s);
            } else if ((PH & 2) && u >= 512 && u < 896) {
                const int v = u - 512, g = v >> 7, w = v & 127, hh = w >> 5, x = w & 31;
                const int per = S / 256, sq = x / per, y = x % per, r = (g == 0) ? 1 : (g == 1 ? 4 : 16), nblk = per / r, c = y / nblk, qb = y % nblk;
                const int seqbase = sq * S, ssub = S / r, q0 = qb * 256;
                float* bl = (float*)(lds + LDS_BIAS_OFF);
                if (tid < 129) bl[tid] = BIAS[(g * 4 + hh) * 129 + tid];
                __syncthreads();
                const size_t tok0 = (size_t)seqbase + c;
                const bf16_t* kb = PROJ + tok0 * NPROJ + OFF_DIL + 1536 + g * 512 + hh * 128;
                att::attn_unit<0, false, true, true>(PROJ + (tok0 + (size_t)r * q0) * NPROJ + OFF_DIL + g * 512 + hh * 128, (long)r * NPROJ, kb, kb + 1536, (long)r * NPROJ,
                    nullptr, 0, 6, 0.08838834764831845f, nullptr, 0, ODG + ((size_t)g * MC + tok0 + (size_t)r * q0) * 512 + hh * 128, (long)r * 512,
                    LSEB + ((size_t)g * MC + tok0 + (size_t)r * q0) * 4 + hh, (long)r * 4, q0, ssub, bl, (char*)lds, wv_s);
            } else if ((PH & 4) && u >= 896) {
                const int v = u - 896, vh = v & 1, w = v >> 1, h = w >> 5, qb = w & 31, rowq = qb * 256;
                const int bg = (ch < 2) ? ch : 2 + (ch - 2) * 2 + rowq / 4096;
                const bf16_t* kb = MEMKV + (size_t)bg * 256 * 2048 + h * 256;
                att::attn_unit<128, false, false, false>(PROJ + (size_t)rowq * NPROJ + OFF_XQ + h * 256, NPROJ, kb, kb + 1024 + vh * 128, 2048, kb + 128, 2048, 4, 0.0625f,
                    OMEM + (size_t)rowq * 1024 + h * 256 + vh * 128, 1024, nullptr, 0, nullptr, 0, 0, 0, nullptr, (char*)lds, wv_s);
            }
        }
        GSYNC();
        { OPQ();
        for (int m = gw; m < MC; m += NGW) {
            const int hh = lane >> 4; float l[3], wgt[3];
#pragma unroll
            for (int g = 0; g < 3; ++g) l[g] = LSEB[((size_t)g * MC + m) * 4 + hh];
            const float mx = fmaxf(l[0], fmaxf(l[1], l[2])); float sum = 0.f;
#pragma unroll
            for (int g = 0; g < 3; ++g) { wgt[g] = __expf(l[g] - mx); sum += wgt[g]; }
            const float inv = 1.f / sum; f32x4 a0 = {0.f, 0.f, 0.f, 0.f}, a1 = {0.f, 0.f, 0.f, 0.f};
#pragma unroll
            for (int g = 0; g < 3; ++g) { const f32x4* op = (const f32x4*)(ODG + ((size_t)g * MC + m) * 512) + 2 * lane; a0 += op[0] * (wgt[g] * inv); a1 += op[1] * (wgt[g] * inv); }
            u32x4 o; o.x = pk2(a0.x, a0.y); o.y = pk2(a0.z, a0.w); o.z = pk2(a1.x, a1.y); o.w = pk2(a1.z, a1.w);
            *((u32x4*)(ODIL + (size_t)m * 512) + lane) = o;
            {
                const float l0 = MLSE[((size_t)0 * MC + m) * 4 + hh], l1 = MLSE[((size_t)1 * MC + m) * 4 + hh]; const float mx2 = fmaxf(l0, l1);
                const float w0 = __expf(l0 - mx2), w1 = __expf(l1 - mx2), iv = 1.f / (w0 + w1);
                const f32x4* p0 = (const f32x4*)(MLP + ((size_t)0 * MC + m) * 512) + 2 * lane; const f32x4* p1 = (const f32x4*)(MLP + ((size_t)1 * MC + m) * 512) + 2 * lane;
                const f32x4 b0 = p0[0] * (w0 * iv) + p1[0] * (w1 * iv), b1 = p0[1] * (w0 * iv) + p1[1] * (w1 * iv);
                u32x4 o2; o2.x = pk2(b0.x, b0.y); o2.y = pk2(b0.z, b0.w); o2.z = pk2(b1.x, b1.y); o2.w = pk2(b1.z, b1.w);
                *((u32x4*)(OMLA + (size_t)m * 1536 + 1024) + lane) = o2; }
        } }
        if (PH & 64) { WSP(); pg8::Gemm g{OMLA, WBM, MC, 2048, 1536, 1536}; pg8::StaticOrder So; So.init(MC, 2048, G, bx);
          pg8::EpiGate<0> E{PROJ + OFF_GATE, TMP, MERG}; pg8::gemm_phase(ldsl, g, So, E, wv_s); }
        GSYNC();
        if (PH & 128) { WSP(); pg8::Gemm g{ODIL, WBD, MC, 2048, 512, 512}; pg8::StaticOrder So; So.init(MC, 2048, G, bx);
          pg8::EpiGate<1> E{PROJ + OFF_GATE + 2048, TMP, MERG}; pg8::gemm_phase(ldsl, g, So, E, wv_s); }
        if (PH & 256) { WSP(); pg8::Gemm g{OMEM, WBX, MC, 2048, 1024, 1024}; pg8::StaticOrder So; So.init(MC, 2048, G, bx);
          pg8::EpiGate<2> E{PROJ + OFF_GATE + 4096, TMP, MERG}; pg8::gemm_phase(ldsl, g, So, E, wv_s); }
        GSYNC();
        if (PH & 512) { WSP(); pg8::Gemm g{MERG, WOUT, MC, 2048, 2048, 2048}; pg8::StaticOrder So; So.init(MC, 2048, G, bx);
          pg8::EpiResid<true> E{xin, xout, H, SSQ2}; pg8::gemm_phase(ldsl, g, So, E, wv_s); }
        GSYNC();
        for (int rep_ = 0; rep_ < ((DBL & 2) ? 2 : 1); ++rep_)
        if (PH & 1024) { WSP(); pg8::Gemm g{H, WUP, MC, DFF, 2048, 2048}; pg8::StaticOrder So; So.init(MC, DFF, G, bx);
          pg8::EpiStore<1, true> E{UPACT, DFF, SSQ2, 1, 1.f / 2048.f}; pg8::gemm_phase(ldsl, g, So, E, wv_s); }
        GSYNC();
        if (PH & 2048) { WSP(); pg8::Gemm g{UPACT, WDN, MC, 2048, DFF, DFF}; pg8::StaticOrder So; So.init(MC, 2048, G, bx);
          pg8::EpiResid<false> E{xout, xout, nullptr, nullptr}; pg8::gemm_phase(ldsl, g, So, E, wv_s); }
        GSYNC();
        { OPQ(); for (int m = gw; m < MC; m += NGW) norm_row_f32(xout + (size_t)m * DM, P.in[20], lane); }
    }
}

static int t5_bucket_host(int rel) {
    const int nb = 16; int ret = (rel > 0) ? nb : 0; const int n = rel < 0 ? -rel : rel; const int max_exact = nb / 2;
    int large = max_exact + (int)(std::log((double)(n > 1 ? n : 1) / max_exact) / std::log(1024.0 / max_exact) * (nb - max_exact));
    if (large > nb - 1) large = nb - 1;
    return ret + (n < max_exact ? n : large);
}
extern "C" void kernel_launch(void* const* d_in, const int* in_sizes, int n_in, void* d_out, int out_size, void* d_ws, size_t ws_size, hipStream_t stream) {
    static int grid = 0;
    if (grid == 0) {
        if (n_in != 21 || ws_size < WS_END) { fprintf(stderr, "kernel_launch: n_in %d ws %zu (need %zu)\n", n_in, ws_size, (size_t)WS_END); grid = -1; return; }
        int dev = 0, cus = 0, per_cu = 0;
        hipGetDevice(&dev); hipDeviceGetAttribute(&cus, hipDeviceAttributeMultiprocessorCount, dev);
        hipFuncSetAttribute((const void*)fwd_megakernel, hipFuncAttributeMaxDynamicSharedMemorySize, LDS_BYTES);
        hipOccupancyMaxActiveBlocksPerMultiprocessor(&per_cu, (const void*)fwd_megakernel, 512, LDS_BYTES);
        if (per_cu < 1) per_cu = 1;
        grid = cus * 1;
        (void)hipGetLastError();
    }
    if (grid < 0) return;
    Params p{};
    for (int i = 0; i < 21; ++i) p.in[i] = (const float*)d_in[i];
    p.out = (float*)d_out; p.ws = (unsigned char*)d_ws;
    for (int i = 0; i < 32; ++i) p.inv[i] = 1.0f / powf(10000.0f, (float)i / 32.0f);
    const int dil[3] = {1, 4, 16};
    for (int g = 0; g < 3; ++g) for (int k = 0; k < 129; ++k) p.bkt[g][k] = (unsigned char)t5_bucket_host((k - 64) * dil[g]);
    (void)hipMemsetAsync((char*)d_ws + WS_BAR, 0, 16384, stream);
    void* args[] = {&p};
    hipError_t e = hipLaunchCooperativeKernel((const void*)fwd_megakernel, dim3(grid), dim3(512), args, LDS_BYTES, stream);
    if (e != hipSuccess) fprintf(stderr, "cooperative launch failed: %s (grid %d)\n", hipGetErrorString(e), grid);
}
```

```cpp
#include <hip/hip_runtime.h>
#include <hip/hip_cooperative_groups.h>
#include <cstdio>
#include <cstdint>
#include <cmath>
namespace cg = cooperative_groups;
#ifndef PH
#define PH 0xffff
#endif
#ifndef DBL
#define DBL 0
#endif

#define LAS __attribute__((address_space(3)))
#define GAS __attribute__((address_space(1)))
typedef unsigned short bf16_t;
typedef short bf16x8 __attribute__((ext_vector_type(8)));
typedef short s16x4 __attribute__((ext_vector_type(4)));
typedef float f32x4 __attribute__((ext_vector_type(4)));
typedef float f32x2 __attribute__((ext_vector_type(2)));
typedef float f32x16 __attribute__((ext_vector_type(16)));
typedef unsigned u32x4 __attribute__((ext_vector_type(4)));
typedef unsigned u32x2 __attribute__((ext_vector_type(2)));

__device__ __forceinline__ float shx(float v, int lane, int mask) { return __int_as_float(__builtin_amdgcn_ds_bpermute((lane ^ mask) << 2, __float_as_int(v))); }
__device__ __forceinline__ int opaque_tid(int wv) { int l; asm volatile("v_mbcnt_lo_u32_b32 %0, -1, 0\n\tv_mbcnt_hi_u32_b32 %0, -1, %0" : "=v"(l)); return wv * 64 + l; }
constexpr int DM = 2048, MC = 8192, NCHUNK = 6, DFF = 8192;
constexpr int NPROJ = 13056;
constexpr int OFF_CQ = 0, OFF_CKV = 512, OFF_KR = 1024, OFF_DIL = 1280, OFF_XQ = 5888, OFF_GATE = 6912;
constexpr int NQ = 2304, NKV = 3072;
constexpr int NMEMROWS = 2560;
constexpr float EPS = 1e-6f;

constexpr size_t WS_CTL  = 0;
constexpr size_t WS_ROPE = 4096;
constexpr size_t WS_BIAS = WS_ROPE + (size_t)8192 * 32 * 8;
constexpr size_t WS_WIN  = WS_BIAS + 8192;
constexpr size_t WS_WUQ  = WS_WIN  + (size_t)NPROJ * 2048 * 2;
constexpr size_t WS_WUKV = WS_WUQ  + (size_t)NQ * 512 * 2;
constexpr size_t WS_WMKV = WS_WUKV + (size_t)NKV * 512 * 2;
constexpr size_t WS_WBM  = WS_WMKV + (size_t)2048 * 2048 * 2;
constexpr size_t WS_WBD  = WS_WBM  + (size_t)2048 * 1536 * 2;
constexpr size_t WS_WBX  = WS_WBD  + (size_t)2048 * 512 * 2;
constexpr size_t WS_WOUT = WS_WBX  + (size_t)2048 * 1024 * 2;
constexpr size_t WS_WUP  = WS_WOUT + (size_t)2048 * 2048 * 2;
constexpr size_t WS_WDN  = WS_WUP  + (size_t)8192 * 2048 * 2;
constexpr size_t WS_MEMN = WS_WDN  + (size_t)2048 * 8192 * 2;
constexpr size_t WS_MEMKV= WS_MEMN + (size_t)NMEMROWS * 2048 * 2;
constexpr size_t WS_H    = WS_MEMKV+ (size_t)NMEMROWS * 2048 * 2;
constexpr size_t WS_PROJ = WS_H    + (size_t)MC * 2048 * 2;
constexpr size_t WS_CQ   = WS_PROJ + (size_t)MC * NPROJ * 2;
constexpr size_t WS_CKV  = WS_CQ   + (size_t)MC * 512 * 2;
constexpr size_t WS_KPE  = WS_CKV  + (size_t)MC * 512 * 2;
constexpr size_t WS_Q    = WS_KPE  + (size_t)MC * 64 * 2;
constexpr size_t WS_KV   = WS_Q    + (size_t)MC * NQ * 2;
constexpr size_t WS_OMLA = WS_KV   + (size_t)MC * NKV * 2;
constexpr size_t WS_ODG  = WS_OMLA + (size_t)MC * 3072 * 2;
constexpr size_t WS_LSE  = WS_ODG  + (size_t)3 * MC * 512 * 4;
constexpr size_t WS_ODIL = WS_LSE  + (size_t)3 * MC * 4 * 4;
constexpr size_t WS_OMEM = WS_ODIL + (size_t)MC * 512 * 2;
constexpr size_t WS_TMP  = WS_OMEM + (size_t)MC * 1024 * 2;
constexpr size_t WS_MERG = WS_TMP  + (size_t)MC * 2048 * 4;
constexpr size_t WS_SSQ  = WS_MERG + (size_t)MC * 2048 * 2;
constexpr size_t WS_SSQ2 = WS_SSQ  + (size_t)MC * 2 * 4;
constexpr size_t WS_MLP  = WS_SSQ2 + (size_t)MC * 4;
constexpr size_t WS_MLSE = WS_MLP  + (size_t)2 * MC * 512 * 4;
constexpr size_t WS_HN1  = WS_MLSE + (size_t)2 * MC * 4 * 4;
constexpr size_t WS_HX   = WS_HN1  + (size_t)MC * 2048 * 2;
constexpr size_t WS_SSQ3 = WS_HX   + (size_t)MC * 2048 * 2;
constexpr size_t WS_PCNT = WS_SSQ3 + (size_t)MC * 4;
constexpr size_t WS_BAR  = WS_PCNT + 32 * 64 * 4;
constexpr size_t WS_END  = WS_BAR + 16384;

constexpr int LDS_BYTES = 131072 + 1024;
constexpr int LDS_BIAS_OFF = 126976;

struct Params {
    const float* in[21]; float* out; unsigned char* ws;
    float inv[32];
    unsigned char bkt[3][132];
    int pad;
};

namespace pg8 {
constexpr int BM = 256, BK = 64, HALF = 128, HTB = HALF * BK * 2, STAGE_BYTES = 8 * HTB, NXCD = 8, WGM = 8;
__host__ __device__ __forceinline__ int lds_byte(int r, int c) { const int st = (r >> 4) * 2 + (c >> 5), rr = r & 15, cc = c & 31, ob = rr * 64 + cc * 2; return st * 1024 + (ob ^ (((ob >> 9) & 1) << 5)); }
__host__ __device__ __forceinline__ void stage_rc(int b, int& R, int& C) { const int st = b / 1024, sb = b % 1024, swz = sb ^ (((sb >> 9) & 1) << 5); R = (st >> 1) * 16 + swz / 64; C = (st & 1) * 32 + (swz % 64) / 2; }
__host__ __device__ __forceinline__ int perm32(int rho) { const int n = rho >> 4, i = rho & 15; return 8 * (i >> 2) + 4 * n + (i & 3); }
struct Unit { int pm, pn; };
struct Gemm { const bf16_t* A; const bf16_t* Bt; int M, N, K, lda; };
struct StaticOrder {
    int nM, nN, nwg, G, c;
    __host__ __device__ void init(int M, int N, int G_, int c_) { nM = M / BM; nN = N / BM; nwg = nM * nN; G = G_; c = c_; }
    __host__ __device__ bool next(int i, Unit& u) const {
        const long L = (long)i * G + c; if (L >= nwg) return false;
        int wgid = (int)L; { const int q = nwg / NXCD, r = nwg % NXCD, xcd = wgid % NXCD, off = wgid / NXCD; wgid = (xcd < r ? xcd * (q + 1) : r * (q + 1) + (xcd - r) * q) + off; }
        const int nig = WGM * nN, gid = wgid / nig, fm = gid * WGM, gsz = (nM - fm) < WGM ? (nM - fm) : WGM;
        u.pm = fm + ((wgid % nig) % gsz); u.pn = (wgid % nig) / gsz; return true;
    }
};
__device__ __forceinline__ unsigned cvt_pk_bf16(float lo, float hi) { unsigned r; asm volatile("v_cvt_pk_bf16_f32 %0, %1, %2" : "=v"(r) : "v"(lo), "v"(hi)); return r; }
__device__ __forceinline__ u32x4 pack8(f32x4 v0, f32x4 v1) { u32x4 w; w.x = cvt_pk_bf16(v0[0], v0[1]); w.y = cvt_pk_bf16(v0[2], v0[3]); w.z = cvt_pk_bf16(v1[0], v1[1]); w.w = cvt_pk_bf16(v1[2], v1[3]); return w; }
__device__ __forceinline__ float bf2f(unsigned short h) { return __uint_as_float(((unsigned)h) << 16); }

__device__ __forceinline__ void st16(bf16_t* p, u32x4 v) { *(GAS u32x4*)p = v; }
__device__ __forceinline__ void stf4(float* p, f32x4 v) { *(GAS f32x4*)p = v; }
__device__ __forceinline__ f32x4 ldf4(const float* p) { return *(const GAS f32x4*)p; }
__device__ __forceinline__ float sq8(f32x4 a, f32x4 b) { return (a[0] * a[0] + a[1] * a[1]) + (a[2] * a[2] + a[3] * a[3]) + (b[0] * b[0] + b[1] * b[1]) + (b[2] * b[2] + b[3] * b[3]); }
template <int ACT  , bool RS> struct EpiStore {
    static constexpr bool PERM = true, HOOK = false;
    bf16_t* O; int ldc; const float* rs; int rss; float invdim;
    __device__ __forceinline__ void operator()(const f32x4 (&acc)[2][2][4][2], const Unit& u, int wr, int wc, int fr, int fq) const {
        const int row0 = u.pm * BM + wr * 64 + fr, col0 = u.pn * BM + wc * 32 + 8 * fq;
#pragma unroll
        for (int ai = 0; ai < 2; ++ai)
#pragma unroll
            for (int m = 0; m < 4; ++m) { const int row = row0 + ai * HALF + m * 16; bf16_t* rowp = O + (size_t)row * ldc + col0;
                float sc = 1.f; if (RS) sc = rsqrtf(*(const GAS float*)(rs + (size_t)row * rss) * invdim + EPS);
#pragma unroll
                for (int bj = 0; bj < 2; ++bj) { f32x4 v0 = acc[ai][bj][m][0], v1 = acc[ai][bj][m][1];
                    if (RS) { v0 *= sc; v1 *= sc; }
                    if (ACT == 1) {
#pragma unroll
                        for (int e = 0; e < 4; ++e) { float a = fmaxf(v0[e], 0.f), b = fmaxf(v1[e], 0.f); v0[e] = a * a; v1[e] = b * b; } }
                    st16(rowp + bj * HALF, pack8(v0, v1)); } }
    }
};
struct EpiProj {
    static constexpr bool PERM = true, HOOK = false;
    bf16_t* O; float* ssq; bf16_t* kpe; const f32x2* rope; int posmask;
    __device__ __forceinline__ void operator()(const f32x4 (&acc)[2][2][4][2], const Unit& u, int wr, int wc, int fr, int fq) const {
        const int row0 = u.pm * BM + wr * 64 + fr, col0 = u.pn * BM + wc * 32 + 8 * fq;
        if (u.pn == 4) {
            if (wc < 2) {
                const int p = wc * 32 + 8 * fq, j = p >> 3;
#pragma unroll
                for (int ai = 0; ai < 2; ++ai)
#pragma unroll
                    for (int m = 0; m < 4; ++m) { const int row = row0 + ai * HALF + m * 16; const int pos = row & posmask;
                        const f32x4 v0 = acc[ai][0][m][0], v1 = acc[ai][0][m][1]; f32x4 o1, o2; const f32x2* rp = rope + (size_t)pos * 32 + 4 * j;
#pragma unroll
                        for (int e = 0; e < 4; ++e) { const f32x2 cs = *(const GAS f32x2*)(rp + e); o1[e] = v0[e] * cs.x - v1[e] * cs.y; o2[e] = v1[e] * cs.x + v0[e] * cs.y; }
                        st16(kpe + (size_t)row * 64 + p, pack8(o1, o2)); }
            }
            return;
        }
#pragma unroll
        for (int ai = 0; ai < 2; ++ai)
#pragma unroll
            for (int m = 0; m < 4; ++m) { const int row = row0 + ai * HALF + m * 16; bf16_t* rowp = O + (size_t)row * NPROJ + col0;
                st16(rowp, pack8(acc[ai][0][m][0], acc[ai][0][m][1])); st16(rowp + HALF, pack8(acc[ai][1][m][0], acc[ai][1][m][1]));
                if (u.pn < 4) { float s = sq8(acc[ai][0][m][0], acc[ai][0][m][1]) + sq8(acc[ai][1][m][0], acc[ai][1][m][1]);
                    { const int ln_ = fq * 16 + fr; s += shx(s, ln_, 16); s += shx(s, ln_, 32); }
                    if (fq == 0) __hip_atomic_fetch_add(ssq + (size_t)row * 2 + (u.pn >> 1), s, __ATOMIC_RELAXED, __HIP_MEMORY_SCOPE_AGENT); } }
    }
};
struct EpiQRope {
    static constexpr bool PERM = true, HOOK = false;
    bf16_t* Q; const f32x2* rope; int posmask; const float* ssq;
    __device__ __forceinline__ void operator()(const f32x4 (&acc)[2][2][4][2], const Unit& u, int wr, int wc, int fr, int fq) const {
        const int row0 = u.pm * BM + wr * 64 + fr, col0 = u.pn * BM + wc * 32 + 8 * fq;
#pragma unroll
        for (int ai = 0; ai < 2; ++ai)
#pragma unroll
            for (int m = 0; m < 4; ++m) { const int row = row0 + ai * HALF + m * 16; const int pos = row & posmask;
                const float sc = rsqrtf(*(const GAS float*)(ssq + (size_t)row * 2) * (1.f / 512.f) + EPS);
#pragma unroll
                for (int bj = 0; bj < 2; ++bj) { const int c = col0 + bj * HALF; const f32x4 v0 = acc[ai][bj][m][0] * sc, v1 = acc[ai][bj][m][1] * sc;
                    if (u.pn < 6) { const int h = c >> 7, d = c & 127; st16(Q + (size_t)row * NQ + h * 192 + d, pack8(v0, v1)); }
                    else { const int cc = c - 1536, h = cc >> 6, p = cc & 63, j = p >> 3; f32x4 o1, o2;
                        const f32x2* rp = rope + (size_t)pos * 32 + 4 * j;
#pragma unroll
                        for (int e = 0; e < 4; ++e) { const f32x2 cs = *(const GAS f32x2*)(rp + e); o1[e] = v0[e] * cs.x - v1[e] * cs.y; o2[e] = v1[e] * cs.x + v0[e] * cs.y; }
                        st16(Q + (size_t)row * NQ + h * 192 + 128 + p, pack8(o1, o2)); } } }
    }
};
template <int MODE  > struct EpiGate {
    static constexpr bool PERM = true, HOOK = false;
    const bf16_t* gate; float* tmp; bf16_t* merged;
    __device__ __forceinline__ void operator()(const f32x4 (&acc)[2][2][4][2], const Unit& u, int wr, int wc, int fr, int fq) const {
        const int row0 = u.pm * BM + wr * 64 + fr, col0 = u.pn * BM + wc * 32 + 8 * fq;
#pragma unroll
        for (int ai = 0; ai < 2; ++ai)
#pragma unroll
            for (int m = 0; m < 4; ++m) { const int row = row0 + ai * HALF + m * 16;
#pragma unroll
                for (int bj = 0; bj < 2; ++bj) { const int c = col0 + bj * HALF;
                    const u32x4 gw = *(const GAS u32x4*)(gate + (size_t)row * NPROJ + c);
                    f32x4 v0 = acc[ai][bj][m][0], v1 = acc[ai][bj][m][1];
#pragma unroll
                    for (int e = 0; e < 4; ++e) {
                        const unsigned w0 = gw[e >> 1], w1 = gw[2 + (e >> 1)];
                        const float g0 = __uint_as_float((e & 1) ? (w0 & 0xffff0000u) : (w0 << 16)), g1 = __uint_as_float((e & 1) ? (w1 & 0xffff0000u) : (w1 << 16));
                        v0[e] *= 1.f / (1.f + __expf(-g0)); v1[e] *= 1.f / (1.f + __expf(-g1)); }
                    float* tp = tmp + (size_t)row * DM + c;
                    if (MODE == 0) { stf4(tp, v0); stf4(tp + 4, v1); }
                    else { v0 += ldf4(tp); v1 += ldf4(tp + 4);
                        if (MODE == 1) { stf4(tp, v0); stf4(tp + 4, v1); }
                        else st16(merged + (size_t)row * DM + c, pack8(v0, v1)); } } }
    }
};
struct EpiBranch {
    static constexpr bool PERM = true, HOOK = true;
    const bf16_t* gate; bf16_t* merged;
    static __device__ __forceinline__ float gsel(const u32x4& w, int i) { const unsigned x = w[i >> 1]; return __uint_as_float((i & 1) ? (x & 0xffff0000u) : (x << 16)); }
    __device__ __forceinline__ void hook(f32x4 (&acc)[2][2][4][2], const Unit& u, int seg, int wr, int wc, int fr, int fq) const {
        const int row0 = u.pm * BM + wr * 64 + fr, col0 = u.pn * BM + wc * 32 + 8 * fq;
        int zero = 0;
#pragma unroll
        for (int ai = 0; ai < 2; ++ai)
#pragma unroll
            for (int m = 0; m < 4; ++m) { const bf16_t* gp = gate + (size_t)(row0 + ai * HALF + m * 16 + zero) * NPROJ + seg * 2048 + col0;
#pragma unroll
                for (int bj = 0; bj < 2; ++bj) { const u32x4 ga = *(const GAS u32x4*)(gp + bj * HALF), gb = *(const GAS u32x4*)(gp + 2048 + bj * HALF);
#pragma unroll
                    for (int e = 0; e < 4; ++e) {
                        acc[ai][bj][m][0][e] *= (1.f + __expf(-gsel(gb, e))) * __builtin_amdgcn_rcpf(1.f + __expf(-gsel(ga, e)));
                        acc[ai][bj][m][1][e] *= (1.f + __expf(-gsel(gb, 4 + e))) * __builtin_amdgcn_rcpf(1.f + __expf(-gsel(ga, 4 + e))); } }
                asm volatile("" : "+v"(zero), "+v"(acc[ai][0][m][0]), "+v"(acc[ai][1][m][1])); }
    }
    __device__ __forceinline__ void operator()(const f32x4 (&acc)[2][2][4][2], const Unit& u, int wr, int wc, int fr, int fq) const {
        const int row0 = u.pm * BM + wr * 64 + fr, col0 = u.pn * BM + wc * 32 + 8 * fq;
#pragma unroll
        for (int ai = 0; ai < 2; ++ai)
#pragma unroll
            for (int m = 0; m < 4; ++m) { const int row = row0 + ai * HALF + m * 16; const bf16_t* gp = gate + (size_t)row * NPROJ + 4096 + col0;
#pragma unroll
                for (int bj = 0; bj < 2; ++bj) { const u32x4 gw = *(const GAS u32x4*)(gp + bj * HALF); f32x4 v0 = acc[ai][bj][m][0], v1 = acc[ai][bj][m][1];
#pragma unroll
                    for (int e = 0; e < 4; ++e) { v0[e] *= __builtin_amdgcn_rcpf(1.f + __expf(-gsel(gw, e))); v1[e] *= __builtin_amdgcn_rcpf(1.f + __expf(-gsel(gw, 4 + e))); }
                    st16(merged + (size_t)row * DM + col0 + bj * HALF, pack8(v0, v1)); } }
    }
};
template <bool NRM> struct EpiResid {
    static constexpr bool PERM = true, HOOK = false;
    const float* base; float* out; bf16_t* hb; float* ssq2;
    __device__ __forceinline__ void operator()(const f32x4 (&acc)[2][2][4][2], const Unit& u, int wr, int wc, int fr, int fq) const {
        const int row0 = u.pm * BM + wr * 64 + fr, col0 = u.pn * BM + wc * 32 + 8 * fq;
#pragma unroll
        for (int ai = 0; ai < 2; ++ai)
#pragma unroll
            for (int m = 0; m < 4; ++m) { const int row = row0 + ai * HALF + m * 16; const size_t off = (size_t)row * DM + col0; float s = 0.f;
#pragma unroll
                for (int bj = 0; bj < 2; ++bj) { const f32x4 o0 = ldf4(base + off + bj * HALF) + acc[ai][bj][m][0], o1 = ldf4(base + off + bj * HALF + 4) + acc[ai][bj][m][1];
                    stf4(out + off + bj * HALF, o0); stf4(out + off + bj * HALF + 4, o1);
                    if (NRM) { st16(hb + off + bj * HALF, pack8(o0, o1)); s += sq8(o0, o1); } }
                if (NRM) { { const int ln_ = fq * 16 + fr; s += shx(s, ln_, 16); s += shx(s, ln_, 32); }
                    if (fq == 0) __hip_atomic_fetch_add(ssq2 + row, s, __ATOMIC_RELAXED, __HIP_MEMORY_SCOPE_AGENT); } }
    }
};

struct EpiFinal {
    static constexpr bool PERM = true, HOOK = false;
    const float* base; float* out; const float* gfin; float* ssq3; unsigned* pcnt;
    __device__ __forceinline__ void operator()(f32x4 (&acc)[2][2][4][2], const Unit& u, int wr, int wc, int fr, int fq) const {
        const int row0 = u.pm * BM + wr * 64 + fr, col0 = u.pn * BM + wc * 32 + 8 * fq; const int ln_ = fq * 16 + fr;
#pragma unroll
        for (int ai = 0; ai < 2; ++ai)
#pragma unroll
            for (int m = 0; m < 4; ++m) { const int row = row0 + ai * HALF + m * 16; const size_t off = (size_t)row * DM + col0; float s = 0.f;
#pragma unroll
                for (int bj = 0; bj < 2; ++bj) { acc[ai][bj][m][0] += ldf4(base + off + bj * HALF); acc[ai][bj][m][1] += ldf4(base + off + bj * HALF + 4); s += sq8(acc[ai][bj][m][0], acc[ai][bj][m][1]); }
                s += shx(s, ln_, 16); s += shx(s, ln_, 32);
                if (fq == 0) __hip_atomic_fetch_add(ssq3 + row, s, __ATOMIC_RELAXED, __HIP_MEMORY_SCOPE_AGENT); }
        asm volatile("s_waitcnt vmcnt(0)" ::: "memory");
        unsigned* cw = pcnt + 64 * u.pm;
        if (ln_ == 0) __hip_atomic_fetch_add(cw, 1u, __ATOMIC_RELAXED, __HIP_MEMORY_SCOPE_AGENT);
        { unsigned sp = 0; while ((unsigned)__builtin_amdgcn_readfirstlane(__hip_atomic_load(cw, __ATOMIC_RELAXED, __HIP_MEMORY_SCOPE_AGENT)) < 64u) { __builtin_amdgcn_s_sleep(2); if (++sp > (1u << 22)) break; } }
        __builtin_amdgcn_fence(__ATOMIC_ACQUIRE, "agent");
        f32x4 g0[2], g1[2];
#pragma unroll
        for (int bj = 0; bj < 2; ++bj) { g0[bj] = ldf4(gfin + col0 + bj * HALF); g1[bj] = ldf4(gfin + col0 + bj * HALF + 4); }
#pragma unroll
        for (int ai = 0; ai < 2; ++ai)
#pragma unroll
            for (int m = 0; m < 4; ++m) { const int row = row0 + ai * HALF + m * 16; const size_t off = (size_t)row * DM + col0;
                const float rstd = rsqrtf(__hip_atomic_load(ssq3 + row, __ATOMIC_RELAXED, __HIP_MEMORY_SCOPE_AGENT) * (1.f / 2048.f) + EPS);
#pragma unroll
                for (int bj = 0; bj < 2; ++bj) { stf4(out + off + bj * HALF, acc[ai][bj][m][0] * rstd * g0[bj]); stf4(out + off + bj * HALF + 4, acc[ai][bj][m][1] * rstd * g1[bj]); } }
    }
};

template <class Epi>
__device__ __forceinline__ void gemm_phase(LAS unsigned char* lds, const Gemm g, const StaticOrder& S, const Epi& E, const int wv) {
    const int tid_ = opaque_tid(wv);
    const int tid = tid_, wid = __builtin_amdgcn_readfirstlane(tid >> 6), lane = tid & 63, wr = wid >> 2, wc = wid & 3, fr = lane & 15, fq = lane >> 4;
    const int K = g.K, nt = K / BK;
    unsigned voffA[2], voffB[2];
#pragma unroll
    for (int i = 0; i < 2; ++i) { int R, C; stage_rc(tid * 16 + i * 8192, R, C); const int Rb = Epi::PERM ? ((R & ~31) + perm32(R & 31)) : R;
        voffA[i] = (unsigned)(R * g.lda + C) * 2u; voffB[i] = (unsigned)(Rb * K + C) * 2u; }
    const size_t kstep = (size_t)(BK * 2);
    const size_t hstep = (size_t)HALF * K * 2;
    const size_t tstep = 2 * hstep;
    const size_t hstepA = (size_t)HALF * g.lda * 2, tstepA = 2 * hstepA;
    const unsigned ldsw = (unsigned)wid * 1024u;
    const int aoff = lds_byte(wr * 64 + fr, fq * 8), boff = lds_byte(wc * 32 + fr, fq * 8);
#define PG8_SA(b, h) (((b) * 2 + (h)) * HTB)
#define PG8_SB(b, h) ((4 + (b) * 2 + (h)) * HTB)
#define PG8_STAGE(bufoff, gbase, voff) do { _Pragma("unroll") for (int _i = 0; _i < 2; ++_i) \
        __builtin_amdgcn_global_load_lds((const unsigned*)((const char*)(gbase) + (voff)[_i]), (LAS unsigned*)(lds + (bufoff) + ldsw + _i * 8192), 16, 0, 0); } while (0)
#define PG8_LDA(dst, b, h) do { _Pragma("unroll") for (int m = 0; m < 4; ++m) _Pragma("unroll") for (int k = 0; k < 2; ++k) dst[m][k] = *(const LAS bf16x8*)(lds + PG8_SA(b, h) + aoff + m * 2048 + k * 1024); } while (0)
#define PG8_LDB(dst, b, h) do { _Pragma("unroll") for (int n = 0; n < 2; ++n) _Pragma("unroll") for (int k = 0; k < 2; ++k) dst[n][k] = *(const LAS bf16x8*)(lds + PG8_SB(b, h) + boff + n * 2048 + k * 1024); } while (0)
#define PG8_MMA(ai, bj, At, Bt) do { __builtin_amdgcn_s_setprio(1); _Pragma("unroll") for (int m = 0; m < 4; ++m) _Pragma("unroll") for (int n = 0; n < 2; ++n) _Pragma("unroll") for (int k = 0; k < 2; ++k) \
        acc[ai][bj][m][n] = __builtin_amdgcn_mfma_f32_16x16x32_bf16(Bt[n][k], At[m][k], acc[ai][bj][m][n], 0, 0, 0); __builtin_amdgcn_s_setprio(0); } while (0)
#define PG8_WAIT_V(n) asm volatile("s_waitcnt vmcnt(" #n ")" ::: "memory")
#define PG8_WAIT_L(n) asm volatile("s_waitcnt lgkmcnt(" #n ")" ::: "memory")
#define PG8_BAR __builtin_amdgcn_s_barrier()
#define PG8_SCHED __builtin_amdgcn_sched_barrier(0)
    Unit cur, nxt; int ui = 0;
    if (!S.next(0, cur)) return;
    f32x4 acc[2][2][4][2];
#pragma unroll
    for (int a = 0; a < 2; ++a)
#pragma unroll
        for (int b = 0; b < 2; ++b)
#pragma unroll
            for (int m = 0; m < 4; ++m)
#pragma unroll
                for (int n = 0; n < 2; ++n) acc[a][b][m][n] = (f32x4){0.f, 0.f, 0.f, 0.f};
    bf16x8 At[4][2], B0[2][2], B1[2][2];
    const char* cA = (const char*)g.A + (size_t)cur.pm * tstepA; const char* cB = (const char*)g.Bt + (size_t)cur.pn * tstep;
    PG8_STAGE(PG8_SB(0, 0), cB, voffB); PG8_STAGE(PG8_SB(0, 1), cB + hstep, voffB); PG8_STAGE(PG8_SA(0, 0), cA, voffA); PG8_STAGE(PG8_SA(0, 1), cA + hstepA, voffA);
    if (wr == 1) PG8_BAR;
    PG8_WAIT_V(2); PG8_BAR;
    PG8_STAGE(PG8_SB(1, 0), cB + kstep, voffB); PG8_STAGE(PG8_SA(1, 0), cA + kstep, voffA); PG8_STAGE(PG8_SB(1, 1), cB + hstep + kstep, voffB);
    PG8_WAIT_V(6); PG8_BAR;
    for (;;) {
        const bool has_next = S.next(ui + 1, nxt);
        const char* nA = has_next ? (const char*)g.A + (size_t)nxt.pm * tstepA : cA; const char* nB = has_next ? (const char*)g.Bt + (size_t)nxt.pn * tstep : cB;
#define PG8_KITER(t) do { \
            const bool last = (t == nt - 2); \
            const char* a1 = cA + (size_t)(t + 1) * kstep; \
            const char* a2 = last ? nA : cA + (size_t)(t + 2) * kstep; const char* b2 = last ? nB : cB + (size_t)(t + 2) * kstep; \
            const char* a3 = a2 + kstep; const char* b3 = b2 + kstep; \
            PG8_LDB(B0, 0, 0); PG8_LDB(B1, 0, 1); PG8_SCHED; PG8_LDA(At, 0, 0); PG8_STAGE(PG8_SA(1, 1), a1 + hstepA, voffA); \
            PG8_WAIT_V(8); PG8_WAIT_L(0); PG8_BAR; PG8_MMA(0, 0, At, B0); PG8_MMA(0, 1, At, B1); PG8_BAR; PG8_SCHED; \
            PG8_LDA(At, 0, 1); PG8_STAGE(PG8_SB(0, 0), b2, voffB); PG8_STAGE(PG8_SB(0, 1), b2 + hstep, voffB); PG8_STAGE(PG8_SA(0, 0), a2, voffA); \
            PG8_WAIT_V(8); PG8_WAIT_L(0); PG8_BAR; PG8_MMA(1, 0, At, B0); PG8_MMA(1, 1, At, B1); PG8_BAR; PG8_SCHED; \
            PG8_LDB(B0, 1, 0); PG8_LDB(B1, 1, 1); PG8_SCHED; PG8_LDA(At, 1, 0); PG8_STAGE(PG8_SA(0, 1), a2 + hstepA, voffA); \
            PG8_WAIT_V(8); PG8_WAIT_L(0); PG8_BAR; PG8_MMA(0, 0, At, B0); PG8_MMA(0, 1, At, B1); PG8_BAR; PG8_SCHED; \
            PG8_LDA(At, 1, 1); PG8_STAGE(PG8_SB(1, 0), b3, voffB); PG8_STAGE(PG8_SB(1, 1), b3 + hstep, voffB); PG8_STAGE(PG8_SA(1, 0), a3, voffA); \
            PG8_WAIT_V(8); PG8_WAIT_L(0); PG8_BAR; PG8_MMA(1, 0, At, B0); PG8_MMA(1, 1, At, B1); PG8_BAR; PG8_SCHED; \
        } while (0)
        if constexpr (Epi::HOOK) {
            int t = 0;
#pragma nounroll
            for (int seg = 0; seg < 3; ++seg) { const int te = (seg == 0) ? 24 : (seg == 1 ? 32 : nt);
                for (; t < te; t += 2) PG8_KITER(t);
                if (seg < 2) E.hook(acc, cur, seg, wr, wc, fr, fq); }
        } else {
            for (int t = 0; t < nt; t += 2) PG8_KITER(t);
        }
        if (wr == 0) PG8_BAR;
        E(acc, cur, wr, wc, fr, fq);
        if (!has_next) break;
#pragma unroll
        for (int a = 0; a < 2; ++a)
#pragma unroll
            for (int b = 0; b < 2; ++b)
#pragma unroll
                for (int m = 0; m < 4; ++m)
#pragma unroll
                    for (int n = 0; n < 2; ++n) acc[a][b][m][n] = (f32x4){0.f, 0.f, 0.f, 0.f};
        cur = nxt; cA = nA; cB = nB; ++ui;
        if (wr == 1) PG8_BAR;
    }
    PG8_WAIT_V(0);
    PG8_BAR;
#undef PG8_SA
#undef PG8_SB
#undef PG8_STAGE
#undef PG8_LDA
#undef PG8_LDB
#undef PG8_MMA
#undef PG8_WAIT_V
#undef PG8_WAIT_L
#undef PG8_BAR
#undef PG8_SCHED
#undef PG8_KITER
}
}

namespace att {
#define KSWZ(row, colB) ((row) * 256 + ((colB) ^ (((row) & 7) << 4)))
#define XSWZ(row, colB) ((row) * 128 + ((colB) ^ ((((row) >> 1) & 7) << 4)))
#define SBAR() __builtin_amdgcn_sched_barrier(0)
__device__ __forceinline__ int crow(int r, int hi) { return (r & 3) + 8 * (r >> 2) + 4 * hi; }
__device__ __forceinline__ unsigned cvtpk(float lo, float hi) { unsigned r; asm volatile("v_cvt_pk_bf16_f32 %0, %1, %2" : "=v"(r) : "v"(lo), "v"(hi)); return r; }
__device__ __forceinline__ bf16x8 ld8(const bf16_t* p) { return *(const GAS bf16x8*)p; }

__device__ __forceinline__ void partialSM(f32x16& p0, f32x16& p1, float& m_reg, float& mn, float& alpha, const float C, const float thr) {
    float pmax = p0[0];
#pragma unroll
    for (int r = 1; r < 16; ++r) pmax = fmaxf(pmax, p0[r]);
#pragma unroll
    for (int r = 0; r < 16; ++r) pmax = fmaxf(pmax, p1[r]);
    { auto rr = __builtin_amdgcn_permlane32_swap(__float_as_uint(pmax), __float_as_uint(pmax), false, false);
      pmax = fmaxf(__uint_as_float(rr[0]), __uint_as_float(rr[1])); }
    if (__builtin_expect(__all(pmax - m_reg <= thr), 1)) { mn = m_reg; alpha = 1.f; }
    else { mn = fmaxf(m_reg, pmax); alpha = __builtin_amdgcn_exp2f((m_reg - mn) * C); m_reg = mn; }
    const float mnC = -mn * C;
#pragma unroll
    for (int r = 0; r < 16; ++r) p0[r] = fmaf(p0[r], C, mnC);
#pragma unroll
    for (int r = 0; r < 16; ++r) p1[r] = fmaf(p1[r], C, mnC);
#pragma unroll
    for (int r = 0; r < 16; ++r) p0[r] = __builtin_amdgcn_exp2f(p0[r]);
}
__device__ __forceinline__ void finishSM(f32x16& p0, f32x16& p1, float alpha, float& l_reg, bf16x8& pa0, bf16x8& pa1, bf16x8& pa2, bf16x8& pa3) {
#pragma unroll
    for (int r = 0; r < 16; ++r) p1[r] = __builtin_amdgcn_exp2f(p1[r]);
    float ps = 0;
#pragma unroll
    for (int r = 0; r < 16; ++r) ps += p0[r];
#pragma unroll
    for (int r = 0; r < 16; ++r) ps += p1[r];
    { auto rr = __builtin_amdgcn_permlane32_swap(__float_as_uint(ps), __float_as_uint(ps), false, false);
      ps = __uint_as_float(rr[0]) + __uint_as_float(rr[1]); }
    l_reg = l_reg * alpha + ps;
#define PK4(P, BASE, OUT) do { unsigned a0 = cvtpk(P[BASE + 0], P[BASE + 1]), a1 = cvtpk(P[BASE + 2], P[BASE + 3]);   \
    unsigned b0 = cvtpk(P[BASE + 4], P[BASE + 5]), b1 = cvtpk(P[BASE + 6], P[BASE + 7]);                              \
    auto r0 = __builtin_amdgcn_permlane32_swap(a0, b0, false, false); auto r1 = __builtin_amdgcn_permlane32_swap(a1, b1, false, false); \
    u32x4 w = {r0[0], r1[0], r0[1], r1[1]}; OUT = *reinterpret_cast<bf16x8*>(&w); } while (0)
    PK4(p0, 0, pa0); PK4(p0, 8, pa1); PK4(p1, 0, pa2); PK4(p1, 8, pa3);
#undef PK4
}
__device__ __forceinline__ int v_st(int k, int c) { const int kk = (k & ~0xC) | ((k & 4) << 1) | ((k & 8) >> 1); return ((kk >> 3) * 4 + (c >> 5)) * 512 + ((kk & 7) * 32 + (c & 31)) * 2; }
__device__ __forceinline__ int v_rd_base(int lane) { return ((lane & 3) << 3) | (((lane >> 2) & 3) << 6) | (((lane >> 4) & 1) << 5) | (((lane >> 5) & 1) << 8); }
constexpr int v_rd_off(int d0, int ks, int half) { return d0 * 512 + ks * 4096 + half * 2048; }
template <int OFF> __device__ __forceinline__ s16x4 tr_read(int vb) {
    s16x4 r; asm volatile("ds_read_b64_tr_b16 %0, %1 offset:%2" : "=&v"(r) : "v"(vb), "i"(OFF) : "memory"); return r;
}
template <int D0> __device__ __forceinline__ void pv_one(f32x16& od, int vb, bf16x8 pa0, bf16x8 pa1, bf16x8 pa2, bf16x8 pa3) {
    const s16x4 l0 = tr_read<v_rd_off(D0, 0, 0)>(vb), h0 = tr_read<v_rd_off(D0, 0, 1)>(vb), l1 = tr_read<v_rd_off(D0, 1, 0)>(vb), h1 = tr_read<v_rd_off(D0, 1, 1)>(vb);
    const s16x4 l2 = tr_read<v_rd_off(D0, 2, 0)>(vb), h2 = tr_read<v_rd_off(D0, 2, 1)>(vb), l3 = tr_read<v_rd_off(D0, 3, 0)>(vb), h3 = tr_read<v_rd_off(D0, 3, 1)>(vb);
    asm volatile("s_waitcnt lgkmcnt(0)" ::: "memory"); SBAR();
#define PK(L, H) (bf16x8){L[0], L[1], L[2], L[3], H[0], H[1], H[2], H[3]}
    od = __builtin_amdgcn_mfma_f32_32x32x16_bf16(pa0, PK(l0, h0), od, 0, 0, 0);
    od = __builtin_amdgcn_mfma_f32_32x32x16_bf16(pa1, PK(l1, h1), od, 0, 0, 0);
    od = __builtin_amdgcn_mfma_f32_32x32x16_bf16(pa2, PK(l2, h2), od, 0, 0, 0);
    od = __builtin_amdgcn_mfma_f32_32x32x16_bf16(pa3, PK(l3, h3), od, 0, 0, 0);
#undef PK
}
__device__ __forceinline__ void pv_d0(f32x16* o, int vb, bf16x8 pa0, bf16x8 pa1, bf16x8 pa2, bf16x8 pa3) {
    pv_one<0>(o[0], vb, pa0, pa1, pa2, pa3); pv_one<1>(o[1], vb, pa0, pa1, pa2, pa3); pv_one<2>(o[2], vb, pa0, pa1, pa2, pa3); pv_one<3>(o[3], vb, pa0, pa1, pa2, pa3);
}

template <int RX, bool HOLDX, bool DIL, bool F32OUT>
__device__ __forceinline__ void attn_unit(const bf16_t* __restrict__ Qb, long ldq,
                                          const bf16_t* __restrict__ Kh, const bf16_t* __restrict__ Vh, long ldk,
                                          const bf16_t* __restrict__ Kx, long ldkx,
                                          const int NT, const float SCALE,
                                          bf16_t* Ob, long ldo, float* Of, long ldof, float* Lse, long ldl,
                                          const int q0, const int ssub, const float* biasL, char* lds, const int wv) {
    constexpr int NX = RX / 16, NQH = 8 + (HOLDX ? NX : 0);
    constexpr int SHM_V = 64 * 128 * 2, SHM_K = 64 * 128 * 2, SHM_X = 64 * (RX ? RX : 8) * 2;
    const int tid_ = opaque_tid(wv);
    const int tid = tid_, wid = tid >> 6, lane = tid & 63, r32 = lane & 31, hi = lane >> 5;
    char* V_lds = lds; char* K_lds = lds + 2 * SHM_V; char* X_lds = lds + 2 * SHM_V + 2 * SHM_K;
    float* ws = (float*)(lds + 2 * SHM_V + 2 * SHM_K + 2 * SHM_X) + wid * 64; float* li_l = ws; float* al_l = ws + 32;
    const float C = SCALE * 1.4426950408889634f, thr = 8.f / SCALE;
    float m_reg = DIL ? -1e29f : -1e30f, l_reg = 0; f32x16 o[4] = {}; bf16x8 qr[NQH];
    const bf16_t* Qw = Qb + (long)(wid * 32 + r32) * ldq + hi * 8;
#pragma unroll
    for (int d0 = 0; d0 < NQH; ++d0) qr[d0] = ld8(Qw + d0 * 16);
    const int sr = tid >> 4, sc = (tid & 15) * 8, vst0 = v_st(sr, sc), vst1 = v_st(32 + sr, sc);
    const int xr = tid >> 3, xc = (tid & 7) * 8;
    const int vb0 = (int)(uintptr_t)V_lds + v_rd_base(lane);
    const int kbase = DIL ? q0 - 64 : 0;
    bf16x8 vs0, vs1, ks0, ks1, xs0, xs1;
#define ROWK(k) (DIL ? (long)min(max((k), 0), ssub - 1) : (long)(k))
#define SLOAD(k0) do { const long ra_ = ROWK(kbase + (k0) + sr), rb_ = ROWK(kbase + (k0) + 32 + sr); \
        vs0 = ld8(Vh + ra_ * ldk + sc); vs1 = ld8(Vh + rb_ * ldk + sc); ks0 = ld8(Kh + ra_ * ldk + sc); ks1 = ld8(Kh + rb_ * ldk + sc); \
        if constexpr (RX == 64) { xs0 = ld8(Kx + (long)((k0) + xr) * ldkx + xc); } \
        if constexpr (RX == 128) { xs0 = ld8(Kx + ra_ * ldkx + sc); xs1 = ld8(Kx + rb_ * ldkx + sc); } } while (0)
#define SWRITE(b) do { *(bf16x8*)(V_lds + (b) * SHM_V + vst0) = vs0; *(bf16x8*)(V_lds + (b) * SHM_V + vst1) = vs1; const int kc = sc * 2; \
        *(bf16x8*)(K_lds + (b) * SHM_K + KSWZ(sr, kc)) = ks0; *(bf16x8*)(K_lds + (b) * SHM_K + KSWZ(32 + sr, kc)) = ks1; \
        if constexpr (RX == 64) { *(bf16x8*)(X_lds + (b) * SHM_X + XSWZ(xr, xc * 2)) = xs0; } \
        if constexpr (RX == 128) { *(bf16x8*)(X_lds + (b) * SHM_X + KSWZ(sr, kc)) = xs0; *(bf16x8*)(X_lds + (b) * SHM_X + KSWZ(32 + sr, kc)) = xs1; } } while (0)
#define SWAIT() asm volatile("s_waitcnt vmcnt(0)" ::: "memory")
#define RESC(a) do { if (__any((a) < 1.f)) { if (hi == 0) al_l[r32] = (a); asm volatile("s_waitcnt lgkmcnt(0)" ::: "memory"); \
        _Pragma("unroll") for (int d = 0; d < 4; ++d) _Pragma("unroll") for (int r = 0; r < 16; ++r) o[d][r] *= al_l[crow(r, hi)]; } } while (0)
#define QKT(P0, P1, b) do { P0 = f32x16{}; P1 = f32x16{}; const char* Kb_ = K_lds + (b) * SHM_K; const char* Xb_ = X_lds + (b) * SHM_X; \
        _Pragma("unroll") for (int d0 = 0; d0 < 8; ++d0) { const int cb = (d0 * 16 + hi * 8) * 2; \
            const bf16x8 b0 = *reinterpret_cast<const bf16x8*>(Kb_ + KSWZ(r32, cb)); const bf16x8 b1 = *reinterpret_cast<const bf16x8*>(Kb_ + KSWZ(32 + r32, cb)); \
            P0 = __builtin_amdgcn_mfma_f32_32x32x16_bf16(b0, qr[d0], P0, 0, 0, 0); P1 = __builtin_amdgcn_mfma_f32_32x32x16_bf16(b1, qr[d0], P1, 0, 0, 0); } \
        _Pragma("unroll") for (int x = 0; x < NX; ++x) { const int cb = (x * 16 + hi * 8) * 2; bf16x8 b0, b1; \
            if constexpr (RX == 64) { b0 = *reinterpret_cast<const bf16x8*>(Xb_ + XSWZ(r32, cb)); b1 = *reinterpret_cast<const bf16x8*>(Xb_ + XSWZ(32 + r32, cb)); } \
            else { b0 = *reinterpret_cast<const bf16x8*>(Xb_ + KSWZ(r32, cb)); b1 = *reinterpret_cast<const bf16x8*>(Xb_ + KSWZ(32 + r32, cb)); } \
            bf16x8 qx; if ((8 + x) < NQH) qx = qr[(8 + x) < NQH ? (8 + x) : 0]; else qx = ld8(Qw + (8 + x) * 16); \
            P0 = __builtin_amdgcn_mfma_f32_32x32x16_bf16(b0, qx, P0, 0, 0, 0); P1 = __builtin_amdgcn_mfma_f32_32x32x16_bf16(b1, qx, P1, 0, 0, 0); } } while (0)
#define MASK(P0, P1, t) do { if constexpr (DIL) { const int qq_ = q0 + wid * 32 + r32; const int kt_ = q0 - 64 + (t) * 64 + 4 * hi; \
        _Pragma("unroll") for (int r = 0; r < 16; ++r) { const int kk_ = kt_ + (r & 3) + 8 * (r >> 2); const int rel_ = kk_ - qq_; \
            { const bool ok_ = (rel_ >= -64) & (rel_ <= 64) & (kk_ >= 0) & (kk_ < ssub); const float b_ = biasL[min(max(rel_ + 64, 0), 128)]; P0[r] = ok_ ? P0[r] + b_ : -1e30f; } \
            { const int k2_ = kk_ + 32, r2_ = rel_ + 32; const bool ok_ = (r2_ >= -64) & (r2_ <= 64) & (k2_ >= 0) & (k2_ < ssub); const float b_ = biasL[min(max(r2_ + 64, 0), 128)]; P1[r] = ok_ ? P1[r] + b_ : -1e30f; } } } } while (0)
    f32x16 pA0, pA1, pB0, pB1; float mnA, mnB, alA, alB; bf16x8 pa0, pa1, pa2, pa3;
    SLOAD(0); SWAIT(); SWRITE(0); __syncthreads();
    QKT(pA0, pA1, 0); MASK(pA0, pA1, 0); partialSM(pA0, pA1, m_reg, mnA, alA, C, thr);
    SLOAD(64);
    SWAIT(); SWRITE(1); __syncthreads();
    for (int j = 1; j + 1 < NT; j += 2) {
        SBAR(); QKT(pB0, pB1, 1); MASK(pB0, pB1, j);
        finishSM(pA0, pA1, alA, l_reg, pa0, pa1, pa2, pa3); SBAR();
        SLOAD((j + 1) * 64); SBAR();
        pv_d0(o, vb0, pa0, pa1, pa2, pa3); partialSM(pB0, pB1, m_reg, mnB, alB, C, thr);
        __syncthreads(); SWAIT(); SWRITE(0);
        RESC(alB); __syncthreads();
        SBAR(); QKT(pA0, pA1, 0); MASK(pA0, pA1, j + 1);
        finishSM(pB0, pB1, alB, l_reg, pa0, pa1, pa2, pa3); SBAR();
        SLOAD((j + 2) * 64); SBAR();
        pv_d0(o, vb0 + SHM_V, pa0, pa1, pa2, pa3); partialSM(pA0, pA1, m_reg, mnA, alA, C, thr);
        __syncthreads(); SWAIT(); SWRITE(1);
        RESC(alA); __syncthreads();
    }
    SBAR(); QKT(pB0, pB1, 1); MASK(pB0, pB1, NT - 1);
    finishSM(pA0, pA1, alA, l_reg, pa0, pa1, pa2, pa3); SBAR();
    pv_d0(o, vb0, pa0, pa1, pa2, pa3); partialSM(pB0, pB1, m_reg, mnB, alB, C, thr);
    __syncthreads(); RESC(alB);
    finishSM(pB0, pB1, alB, l_reg, pa0, pa1, pa2, pa3); SBAR();
    pv_d0(o, vb0 + SHM_V, pa0, pa1, pa2, pa3);
    if (hi == 0) li_l[r32] = l_reg; asm volatile("s_waitcnt lgkmcnt(0)" ::: "memory");
    float rli[16];
#pragma unroll
    for (int r = 0; r < 16; ++r) rli[r] = __builtin_amdgcn_rcpf(li_l[crow(r, hi)]);
    if constexpr (F32OUT) {
        float* Ow = Of + (long)(wid * 32) * ldof;
#pragma unroll
        for (int r = 0; r < 16; ++r) { const int orow = crow(r, hi);
#pragma unroll
            for (int d0 = 0; d0 < 4; ++d0) *(GAS float*)(Ow + (long)orow * ldof + d0 * 32 + r32) = o[d0][r] * rli[r]; }
        if (hi == 0) *(GAS float*)(Lse + (long)(wid * 32 + r32) * ldl) = m_reg * SCALE + __logf(l_reg);
    } else {
        bf16_t* Ow = Ob + (long)(wid * 32) * ldo;
#pragma unroll
        for (int r = 0; r < 16; ++r) { const int orow = crow(r, hi);
#pragma unroll
            for (int d0 = 0; d0 < 4; ++d0) *(GAS bf16_t*)(Ow + (long)orow * ldo + d0 * 32 + r32) = (bf16_t)(cvtpk(o[d0][r] * rli[r], 0.f) & 0xffffu); }
    }
    __syncthreads();
#undef ROWK
#undef SLOAD
#undef SWRITE
#undef SWAIT
#undef RESC
#undef QKT
#undef MASK
}
}

__device__ __forceinline__ float wave_sum(float v, int lane) {
#pragma unroll
    for (int o = 1; o < 64; o <<= 1) v += shx(v, lane, o);
    return v;
}
__device__ __forceinline__ unsigned f2bf(float f) { unsigned u = __float_as_uint(f); return (u + 0x7fffu + ((u >> 16) & 1u)) >> 16; }
__device__ __forceinline__ unsigned pk2(float lo, float hi) { return f2bf(lo) | (f2bf(hi) << 16); }
__device__ __forceinline__ float bfbits2f(unsigned h) { return __uint_as_float(h << 16); }

__device__ __forceinline__ int src_col(int mat, int n) {
    if (mat == 0) { if (n >= 1024 && n < 1088) { const int p = n - 1024, j = p >> 3, e = p & 7; return 1024 + ((e < 4) ? (4 * j + e) : (32 + 4 * j + (e - 4))); }
        return n < 1088 ? n : (n < 1280 ? -1 : n - 192); }
    if (mat == 1) { if (n < 1536) { return (n >> 7) * 192 + (n & 127); }
        const int cc = n - 1536, h = cc >> 6, p = cc & 63, j = p >> 3, e = p & 7; const int orig = (e < 4) ? (4 * j + e) : (32 + 4 * j + (e - 4)); return h * 192 + 128 + orig; }
    return n;
}
__device__ __forceinline__ void transpose_item(const float* W, int K, int Nsrc, int Ndst, bf16_t* WT, int mat, LAS float* scr, int item, int lane, const float* kscale = nullptr, int ldw = 0, int koff = 0) {
    if (ldw == 0) ldw = K;
    const int nblk = Ndst / 32, kb = item / nblk, nb = item % nblk, k0 = 64 * kb, n0 = 32 * nb;
    const int sc = src_col(mat, n0 + (lane & 31));
#pragma unroll 8
    for (int i = 0; i < 32; ++i) { const int kk = 2 * i + (lane >> 5); float wv = (sc >= 0) ? W[(size_t)(k0 + kk) * Nsrc + sc] : 0.f; if (kscale) wv *= kscale[k0 + kk]; scr[kk * 33 + (lane & 31)] = wv; }
    asm volatile("s_waitcnt lgkmcnt(0)" ::: "memory");
    const int c = lane & 7;
#pragma unroll
    for (int j = 0; j < 4; ++j) { const int n = (lane >> 3) + 8 * j; const LAS float* s = scr + (8 * c) * 33 + n;
        u32x4 o; o.x = pk2(s[0 * 33], s[1 * 33]); o.y = pk2(s[2 * 33], s[3 * 33]); o.z = pk2(s[4 * 33], s[5 * 33]); o.w = pk2(s[6 * 33], s[7 * 33]);
        *(u32x4*)(WT + (size_t)(n0 + n) * ldw + koff + k0 + 8 * c) = o; }
    asm volatile("s_waitcnt lgkmcnt(0)" ::: "memory");
}
__device__ __forceinline__ void norm_row_bf16(const float* xrow, const float* g, bf16_t* orow, int lane) {
    const f32x4* xr = (const f32x4*)xrow + lane; f32x4 v[8]; float s = 0.f;
#pragma unroll
    for (int j = 0; j < 8; ++j) { v[j] = xr[64 * j]; s += (v[j].x * v[j].x + v[j].y * v[j].y) + (v[j].z * v[j].z + v[j].w * v[j].w); }
    const float rstd = rsqrtf(wave_sum(s, lane) * (1.f / 2048.f) + EPS);
    const f32x4* gr = (const f32x4*)g + lane; u32x2* o8 = (u32x2*)orow + lane;
#pragma unroll
    for (int j = 0; j < 8; ++j) { const f32x4 gg = gr[64 * j]; u32x2 w; w.x = pk2(v[j].x * rstd * gg.x, v[j].y * rstd * gg.y); w.y = pk2(v[j].z * rstd * gg.z, v[j].w * rstd * gg.w); o8[64 * j] = w; }
}
__device__ __forceinline__ void norm_row_f32(float* xrow, const float* g, int lane) {
    f32x4* xr = (f32x4*)xrow + lane; f32x4 v[8]; float s = 0.f;
#pragma unroll
    for (int j = 0; j < 8; ++j) { v[j] = xr[64 * j]; s += (v[j].x * v[j].x + v[j].y * v[j].y) + (v[j].z * v[j].z + v[j].w * v[j].w); }
    const float rstd = rsqrtf(wave_sum(s, lane) * (1.f / 2048.f) + EPS);
    const f32x4* gr = (const f32x4*)g + lane;
#pragma unroll
    for (int j = 0; j < 8; ++j) { const f32x4 gg = gr[64 * j]; xr[64 * j] = v[j] * rstd * gg; }
}


#define XB_TMO      128
#define XB_XCNT(j)  (256  + 64 * (j))
#define XB_XSUB(j)  (1280 + 64 * (j))
#define XB_XGEN(j)  (2304 + 64 * (j))
#define XB_TOP      3328
#define XB_TOPGEN   3392
#define XCD_BAR_WORDS 3456
#define XB_SPIN_CAP (1u << 18)
__device__ __forceinline__ unsigned xb_ld(unsigned* p)              { return __hip_atomic_load(p, __ATOMIC_RELAXED, __HIP_MEMORY_SCOPE_AGENT); }
__device__ __forceinline__ unsigned xb_add(unsigned* p, unsigned v) { return __hip_atomic_fetch_add(p, v, __ATOMIC_RELAXED, __HIP_MEMORY_SCOPE_AGENT); }
__device__ __forceinline__ unsigned xb_xcc_id() { return (unsigned)__builtin_amdgcn_s_getreg((3 << 11) | 20) & 0xFu; }
#define XB_SPIN(cond, bar) do { unsigned _sp = 0; while (cond) { __builtin_amdgcn_s_sleep(1); \
    if ((++_sp & 255u) == 0u) { if (xb_ld(&(bar)[XB_TMO])) break; if (_sp > XB_SPIN_CAP) { atomicAdd(&(bar)[XB_TMO], 1u); break; } } } } while (0)
struct XcdBarrier { unsigned* bar; unsigned x; volatile LAS unsigned* st; };
__device__ __forceinline__ void xcd_barrier_complete(unsigned* bar, unsigned x, unsigned& nloc, unsigned& nx) {
    const unsigned G = gridDim.x * gridDim.y * gridDim.z;
    unsigned sum, cnt, mine, sp = 0u;
    for (;;) {
        sum = 0u; cnt = 0u; mine = 0u;
#pragma unroll
        for (unsigned j = 0; j < 16; ++j) { const unsigned c = xb_ld(&bar[XB_XCNT(j)]); sum += c; cnt += (c > 0u) ? 1u : 0u; mine = (j == x) ? c : mine; }
        if (sum == G) break;
        __builtin_amdgcn_s_sleep(1);
        if ((++sp & 255u) == 0u) { if (xb_ld(&bar[XB_TMO])) break; if (sp > XB_SPIN_CAP) { atomicAdd(&bar[XB_TMO], 1u); break; } }
    }
    nloc = mine > 0u ? mine : 1u; nx = cnt > 0u ? cnt : 1u;
}
__device__ __forceinline__ void xcd_barrier(const XcdBarrier& b, const bool leader_thread) {
    asm volatile("s_waitcnt vmcnt(0)" ::: "memory");
    __syncthreads();
    if (leader_thread) {
        unsigned* bar = b.bar;
        __builtin_amdgcn_s_waitcnt(0);
        unsigned nloc = b.st[0], nx = b.st[1];
        if (nloc == 0u) { xcd_barrier_complete(bar, b.x, nloc, nx); b.st[0] = nloc; b.st[1] = nx; }
        const unsigned old = xb_add(&bar[XB_XSUB(b.x)], 1u);
        const unsigned gen = old / nloc;
        if (old + 1u == (gen + 1u) * nloc) {
            __builtin_amdgcn_fence(__ATOMIC_RELEASE, "agent");
            asm volatile("s_waitcnt vmcnt(0)" ::: "memory");
            const unsigned og = xb_add(&bar[XB_TOP], 1u);
            const unsigned tg = og / nx;
            if (og + 1u == (tg + 1u) * nx) xb_add(&bar[XB_TOPGEN], 1u);
            else XB_SPIN(xb_ld(&bar[XB_TOPGEN]) == tg, bar);
            __builtin_amdgcn_fence(__ATOMIC_ACQUIRE, "agent");
            xb_add(&bar[XB_XGEN(b.x)], 1u);
            asm volatile("s_waitcnt vmcnt(0)" ::: "memory");
        } else {
            XB_SPIN(xb_ld(&bar[XB_XGEN(b.x)]) == gen, bar);
            __builtin_amdgcn_fence(__ATOMIC_ACQUIRE, "agent");
            asm volatile("s_waitcnt vmcnt(0)" ::: "memory");
        }
    }
    __syncthreads();
}

__global__ void __launch_bounds__(512, 2) fwd_megakernel(Params P) {
    extern __shared__ __attribute__((aligned(16))) unsigned char lds[];
    cg::grid_group grid = cg::this_grid();
    const int G = gridDim.x, bx = blockIdx.x, NGW = G * 8;
    const int wv_s = __builtin_amdgcn_readfirstlane((int)threadIdx.x >> 6);
    XcdBarrier xbar;
    {   volatile LAS unsigned* st = (volatile LAS unsigned*)((LAS unsigned char*)lds + 131072);
        if (threadIdx.x < 2) st[threadIdx.x] = 0u;
        __syncthreads();
        xbar.bar = (unsigned*)(P.ws + WS_BAR); xbar.x = xb_xcc_id(); xbar.st = st;
        if (threadIdx.x == 0) (void)xb_add(&xbar.bar[XB_XCNT(xbar.x)], 1u); }
#define GSYNC() xcd_barrier(xbar, opaque_tid(wv_s) == 0)
#define OPQ() const int tid_ = opaque_tid(wv_s); const int tid = tid_, lane = tid & 63, wave = __builtin_amdgcn_readfirstlane(tid >> 6), gw = bx * 8 + wave; (void)tid; (void)lane; (void)gw; WSP()
    LAS unsigned char* ldsl = (LAS unsigned char*)lds;
#define WSP() unsigned char* ws = P.ws; asm volatile("" : "+s"(ws))
#define ROPE ((const f32x2*)(ws + WS_ROPE))
#define BIAS ((float*)(ws + WS_BIAS))
#define WIN ((bf16_t*)(ws + WS_WIN))
#define WUQ ((bf16_t*)(ws + WS_WUQ))
#define WUKV ((bf16_t*)(ws + WS_WUKV))
#define WMKV ((bf16_t*)(ws + WS_WMKV))
#define WBCAT ((bf16_t*)(ws + WS_WBM))
#define WBD ((bf16_t*)(ws + WS_WBD))
#define WBX ((bf16_t*)(ws + WS_WBX))
#define WOUT ((bf16_t*)(ws + WS_WOUT))
#define WUP ((bf16_t*)(ws + WS_WUP))
#define WDN ((bf16_t*)(ws + WS_WDN))
#define MEMN ((bf16_t*)(ws + WS_MEMN))
#define MEMKV ((bf16_t*)(ws + WS_MEMKV))
#define H ((bf16_t*)(ws + WS_H))
#define PROJ ((bf16_t*)(ws + WS_PROJ))
#define UPACT ((bf16_t*)(ws + WS_PROJ))
#define CQ ((bf16_t*)(ws + WS_CQ))
#define CKV ((bf16_t*)(ws + WS_CKV))
#define KPE ((bf16_t*)(ws + WS_KPE))
#define QB ((bf16_t*)(ws + WS_Q))
#define KVB ((bf16_t*)(ws + WS_KV))
#define OCAT ((bf16_t*)(ws + WS_OMLA))
#define ODG ((float*)(ws + WS_ODG))
#define LSEB ((float*)(ws + WS_LSE))
#define ODIL ((bf16_t*)(ws + WS_ODIL))
#define OMEM ((bf16_t*)(ws + WS_OMEM))
#define TMP ((float*)(ws + WS_TMP))
#define MERG ((bf16_t*)(ws + WS_MERG))
#define SSQ ((float*)(ws + WS_SSQ))
#define SSQ2 ((float*)(ws + WS_SSQ2))
#define MLP ((float*)(ws + WS_MLP))
#define MLSE ((float*)(ws + WS_MLSE))
#define HN1 ((bf16_t*)(ws + WS_HN1))
#define HX ((bf16_t*)(ws + WS_HX))
#define SSQ3 ((float*)(ws + WS_SSQ3))
#define PCNT ((unsigned*)(ws + WS_PCNT))

    {
        OPQ();
        LAS float* scr = (LAS float*)(ldsl + wave * 16384);
        constexpr int I0 = 32 * (NPROJ / 32), I1 = 8 * (NQ / 32), I2 = 8 * (NKV / 32), I3 = 32 * 64, I4 = 24 * 64, I5 = 8 * 64, I6 = 16 * 64, I7 = 32 * 64, I8 = 32 * 256, I9 = 128 * 64;
        constexpr int NITEMS = I0 + I1 + I2 + I3 + I4 + I5 + I6 + I7 + I8 + I9;
        for (int it = gw; it < NITEMS; it += NGW) {
            int r = it;
            if (r < I0) { transpose_item(P.in[6], 2048, 12864, NPROJ, WIN, 0, scr, r, lane); continue; } r -= I0;
            if (r < I1) { transpose_item(P.in[8], 512, NQ, NQ, WUQ, 1, scr, r, lane, P.in[7]); continue; } r -= I1;
            if (r < I2) { transpose_item(P.in[10], 512, NKV, NKV, WUKV, 2, scr, r, lane, P.in[9]); continue; } r -= I2;
            if (r < I3) { transpose_item(P.in[12], 2048, 2048, 2048, WMKV, 2, scr, r, lane); continue; } r -= I3;
            if (r < I4) { transpose_item(P.in[13], 1536, 2048, 2048, WBCAT, 2, scr, r, lane, nullptr, 3072, 0); continue; } r -= I4;
            if (r < I5) { transpose_item(P.in[14], 512, 2048, 2048, WBCAT, 2, scr, r, lane, nullptr, 3072, 1536); continue; } r -= I5;
            if (r < I6) { transpose_item(P.in[15], 1024, 2048, 2048, WBCAT, 2, scr, r, lane, nullptr, 3072, 2048); continue; } r -= I6;
            if (r < I7) { transpose_item(P.in[16], 2048, 2048, 2048, WOUT, 2, scr, r, lane); continue; } r -= I7;
            if (r < I8) { transpose_item(P.in[18], 2048, 8192, 8192, WUP, 2, scr, r, lane, P.in[17]); continue; } r -= I8;
            transpose_item(P.in[19], 8192, 2048, 2048, WDN, 2, scr, r, lane);
        }
        for (int idx = bx * 512 + tid; idx < 8192 * 32; idx += G * 512) {
            const int pos = idx >> 5, i = idx & 31; const float ang = (float)pos * P.inv[i];
            float t = ang * 0.15915494309189535f; t = t - floorf(t);
            const float rr = (t > 0.5f ? t - 1.f : t) * 6.283185307179586f;
            ((f32x2*)(ws + WS_ROPE))[idx] = (f32x2){__cosf(rr), __sinf(rr)};
        }
        for (int idx = bx * 512 + tid; idx < 12 * 129; idx += G * 512) {
            const int gh = idx / 129, k = idx % 129, g = gh >> 2;
            BIAS[idx] = P.in[4][(int)P.bkt[g][k] * 12 + gh] * 11.313708498984761f;
        }
        for (int m = gw; m < MC; m += NGW) { norm_row_bf16(P.in[0] + (size_t)m * DM, P.in[5], H + (size_t)m * DM, lane); if (lane < 2) SSQ[m * 2 + lane] = 0.f; }
        for (int m = gw; m < NMEMROWS; m += NGW) {
            const float* src = (m < 512) ? P.in[2] + (size_t)m * DM : P.in[3] + (size_t)(m - 512) * DM;
            norm_row_bf16(src, P.in[11], MEMN + (size_t)m * DM, lane);
        }
    }
    grid.sync();

    for (int ch = 0; ch < NCHUNK; ++ch) {
        const float* xin = (ch < 2) ? P.in[0] + (size_t)ch * MC * DM : P.in[1] + (size_t)(ch - 2) * MC * DM;
        float* xout = P.out + (size_t)ch * MC * DM;
        const int S = (ch < 2) ? 8192 : 4096;
        if ((PH & 8) && ch == 0) { WSP(); pg8::Gemm g{MEMN, WMKV, NMEMROWS, 2048, 2048, 2048}; pg8::StaticOrder So; So.init(NMEMROWS, 2048, G, G - 1 - bx);
            pg8::EpiStore<0, false> E{MEMKV, 2048, nullptr, 0, 0.f}; pg8::gemm_phase(ldsl, g, So, E, wv_s); }
        if (PH & 8) { WSP(); pg8::Gemm g{(ch & 1) ? HN1 : H, WIN, MC, NPROJ, 2048, 2048}; pg8::StaticOrder So; So.init(MC, NPROJ, G, bx);
          pg8::EpiProj E{PROJ, SSQ, KPE, ROPE, S - 1}; pg8::gemm_phase(ldsl, g, So, E, wv_s); }
        if (ch + 1 < NCHUNK) {
            const int nfull = (MC / 256) * (NPROJ / 256) - 6 * G, nfill = G - nfull;
            if (nfull >= 0 && nfill > 0 && bx >= nfull) { OPQ();
                const float* xn = (ch + 1 < 2) ? P.in[0] + (size_t)(ch + 1) * MC * DM : P.in[1] + (size_t)(ch - 1) * MC * DM; bf16_t* hn = ((ch + 1) & 1) ? HN1 : H;
                for (int m = (bx - nfull) * 8 + wave; m < MC; m += nfill * 8) norm_row_bf16(xn + (size_t)m * DM, P.in[5], hn + (size_t)m * DM, lane); }
            else if (nfull < 0 || nfill <= 0) { OPQ();
                const float* xn = (ch + 1 < 2) ? P.in[0] + (size_t)(ch + 1) * MC * DM : P.in[1] + (size_t)(ch - 1) * MC * DM; bf16_t* hn = ((ch + 1) & 1) ? HN1 : H;
                for (int m = gw; m < MC; m += NGW) norm_row_bf16(xn + (size_t)m * DM, P.in[5], hn + (size_t)m * DM, lane); } }
        GSYNC();
        if (PH & 16) { WSP(); pg8::Gemm g{PROJ + OFF_CQ, WUQ, MC, NQ, 512, NPROJ}; pg8::StaticOrder So; So.init(MC, NQ, G, bx);
          pg8::EpiQRope E{QB, ROPE, S - 1, SSQ}; pg8::gemm_phase(ldsl, g, So, E, wv_s); }
        if (PH & 32) { WSP(); pg8::Gemm g{PROJ + OFF_CKV, WUKV, MC, NKV, 512, NPROJ}; pg8::StaticOrder So; So.init(MC, NKV, G, (bx + 128) % G);
          pg8::EpiStore<0, true> E{KVB, NKV, SSQ + 1, 2, 1.f / 512.f}; pg8::gemm_phase(ldsl, g, So, E, wv_s); }
        GSYNC();
        for (int rep_ = 0; rep_ < ((DBL & 1) ? 2 : 1); ++rep_)
        for (int u = bx; u < 1152; u += G) {
            OPQ();
            if ((PH & 1) && u < 256) {
                const int h = u & 7, qb = u >> 3, rowq = qb * 256, seqbase = (rowq / S) * S;
                att::attn_unit<64, true, false, false>(QB + (size_t)rowq * NQ + h * 192, NQ, KVB + (size_t)seqbase * NKV + h * 256, KVB + (size_t)seqbase * NKV + h * 256 + 128, NKV,
                    KPE + (size_t)seqbase * 64, 64, S / 64, 0.07216878364870322f, OCAT + (size_t)rowq * 3072 + h * 128, 3072, nullptr, 0, nullptr, 0, 0, 0, nullptr, (char*)lds, wv_s);
            } else if ((PH & 1) && u >= 256 && u < 512) {
                const int v = u - 256, half = v & 1, h4 = (v & 7) >> 1, h = 8 + h4, qb = v >> 3, rowq = qb * 256, seqbase = (rowq / S) * S, kr0 = seqbase + half * (S / 2);
                att::attn_unit<64, true, false, true>(QB + (size_t)rowq * NQ + h * 192, NQ, KVB + (size_t)kr0 * NKV + h * 256, KVB + (size_t)kr0 * NKV + h * 256 + 128, NKV,
                    KPE + (size_t)kr0 * 64, 64, S / 128, 0.07216878364870322f, nullptr, 0, MLP + ((size_t)half * MC + rowq) * 512 + h4 * 128, 512,
                    MLSE + ((size_t)half * MC + rowq) * 4 + h4, 4, 0, 0, nullptr, (char*)lds, wv_s);
            } else if ((PH & 2) && u >= 512 && u < 896) {
                const int v = u - 512, g = v >> 7, w = v & 127, hh = w >> 5, x = w & 31;
                const int per = S / 256, sq = x / per, y = x % per, r = (g == 0) ? 1 : (g == 1 ? 4 : 16), nblk = per / r, c = y / nblk, qb = y % nblk;
                const int seqbase = sq * S, ssub = S / r, q0 = qb * 256;
                float* bl = (float*)(lds + LDS_BIAS_OFF);
                if (tid < 129) bl[tid] = BIAS[(g * 4 + hh) * 129 + tid];
                __syncthreads();
                const size_t tok0 = (size_t)seqbase + c;
                const bf16_t* kb = PROJ + tok0 * NPROJ + OFF_DIL + 1536 + g * 512 + hh * 128;
                att::attn_unit<0, false, true, true>(PROJ + (tok0 + (size_t)r * q0) * NPROJ + OFF_DIL + g * 512 + hh * 128, (long)r * NPROJ, kb, kb + 1536, (long)r * NPROJ,
                    nullptr, 0, 6, 0.08838834764831845f, nullptr, 0, ODG + ((size_t)g * MC + tok0 + (size_t)r * q0) * 512 + hh * 128, (long)r * 512,
                    LSEB + ((size_t)g * MC + tok0 + (size_t)r * q0) * 4 + hh, (long)r * 4, q0, ssub, bl, (char*)lds, wv_s);
            } else if ((PH & 4) && u >= 896) {
                const int v = u - 896, vh = v & 1, w = v >> 1, h = w >> 5, qb = w & 31, rowq = qb * 256;
                const int bg = (ch < 2) ? ch : 2 + (ch - 2) * 2 + rowq / 4096;
                const bf16_t* kb = MEMKV + (size_t)bg * 256 * 2048 + h * 256;
                att::attn_unit<128, false, false, false>(PROJ + (size_t)rowq * NPROJ + OFF_XQ + h * 256, NPROJ, kb, kb + 1024 + vh * 128, 2048, kb + 128, 2048, 4, 0.0625f,
                    OCAT + (size_t)rowq * 3072 + 2048 + h * 256 + vh * 128, 3072, nullptr, 0, nullptr, 0, 0, 0, nullptr, (char*)lds, wv_s);
            }
        }
        GSYNC();
        { OPQ();
        for (int m = gw; m < MC; m += NGW) {
            const int hh = lane >> 4; float l[3], wgt[3];
            if (lane < 2) SSQ[m * 2 + lane] = 0.f; if (lane == 2) SSQ2[m] = 0.f; if (lane == 3) SSQ3[m] = 0.f; if (lane == 4 && m < 32) PCNT[64 * m] = 0u;
#pragma unroll
            for (int g = 0; g < 3; ++g) l[g] = LSEB[((size_t)g * MC + m) * 4 + hh];
            const float mx = fmaxf(l[0], fmaxf(l[1], l[2])); float sum = 0.f;
#pragma unroll
            for (int g = 0; g < 3; ++g) { wgt[g] = __expf(l[g] - mx); sum += wgt[g]; }
            const float inv = 1.f / sum; f32x4 a0 = {0.f, 0.f, 0.f, 0.f}, a1 = {0.f, 0.f, 0.f, 0.f};
#pragma unroll
            for (int g = 0; g < 3; ++g) { const f32x4* op = (const f32x4*)(ODG + ((size_t)g * MC + m) * 512) + 2 * lane; a0 += op[0] * (wgt[g] * inv); a1 += op[1] * (wgt[g] * inv); }
            u32x4 o; o.x = pk2(a0.x, a0.y); o.y = pk2(a0.z, a0.w); o.z = pk2(a1.x, a1.y); o.w = pk2(a1.z, a1.w);
            *((u32x4*)(OCAT + (size_t)m * 3072 + 1536) + lane) = o;
            {
                const float l0 = MLSE[((size_t)0 * MC + m) * 4 + hh], l1 = MLSE[((size_t)1 * MC + m) * 4 + hh]; const float mx2 = fmaxf(l0, l1);
                const float w0 = __expf(l0 - mx2), w1 = __expf(l1 - mx2), iv = 1.f / (w0 + w1);
                const f32x4* p0 = (const f32x4*)(MLP + ((size_t)0 * MC + m) * 512) + 2 * lane; const f32x4* p1 = (const f32x4*)(MLP + ((size_t)1 * MC + m) * 512) + 2 * lane;
                const f32x4 b0 = p0[0] * (w0 * iv) + p1[0] * (w1 * iv), b1 = p0[1] * (w0 * iv) + p1[1] * (w1 * iv);
                u32x4 o2; o2.x = pk2(b0.x, b0.y); o2.y = pk2(b0.z, b0.w); o2.z = pk2(b1.x, b1.y); o2.w = pk2(b1.z, b1.w);
                *((u32x4*)(OCAT + (size_t)m * 3072 + 1024) + lane) = o2; }
        } }
        GSYNC();
        if (PH & 64) { WSP(); pg8::Gemm g{OCAT, WBCAT, MC, 2048, 3072, 3072}; pg8::StaticOrder So; So.init(MC, 2048, G, bx);
          pg8::EpiBranch E{PROJ + OFF_GATE, MERG}; pg8::gemm_phase(ldsl, g, So, E, wv_s); }
        GSYNC();
        if (PH & 512) { WSP(); pg8::Gemm g{MERG, WOUT, MC, 2048, 2048, 2048}; pg8::StaticOrder So; So.init(MC, 2048, G, bx);
          pg8::EpiResid<true> E{xin, xout, HX, SSQ2}; pg8::gemm_phase(ldsl, g, So, E, wv_s); }
        GSYNC();
        for (int rep_ = 0; rep_ < ((DBL & 2) ? 2 : 1); ++rep_)
        if (PH & 1024) { WSP(); pg8::Gemm g{HX, WUP, MC, DFF, 2048, 2048}; pg8::StaticOrder So; So.init(MC, DFF, G, bx);
          pg8::EpiStore<1, true> E{UPACT, DFF, SSQ2, 1, 1.f / 2048.f}; pg8::gemm_phase(ldsl, g, So, E, wv_s); }
        GSYNC();
        if (G == 256) {
            WSP(); pg8::Gemm g{UPACT, WDN, MC, 2048, DFF, DFF}; pg8::StaticOrder So; So.init(MC, 2048, G, bx);
            pg8::EpiFinal E{xout, xout, P.in[20], SSQ3, PCNT}; pg8::gemm_phase(ldsl, g, So, E, wv_s);
            GSYNC();
        } else {
            { WSP(); pg8::Gemm g{UPACT, WDN, MC, 2048, DFF, DFF}; pg8::StaticOrder So; So.init(MC, 2048, G, bx);
              pg8::EpiResid<false> E{xout, xout, nullptr, nullptr}; pg8::gemm_phase(ldsl, g, So, E, wv_s); }
            GSYNC();
            { OPQ(); for (int m = gw; m < MC; m += NGW) norm_row_f32(xout + (size_t)m * DM, P.in[20], lane); }
            GSYNC();
        }
    }
}

static int t5_bucket_host(int rel) {
    const int nb = 16; int ret = (rel > 0) ? nb : 0; const int n = rel < 0 ? -rel : rel; const int max_exact = nb / 2;
    int large = max_exact + (int)(std::log((double)(n > 1 ? n : 1) / max_exact) / std::log(1024.0 / max_exact) * (nb - max_exact));
    if (large > nb - 1) large = nb - 1;
    return ret + (n < max_exact ? n : large);
}
extern "C" void kernel_launch(void* const* d_in, const int* in_sizes, int n_in, void* d_out, int out_size, void* d_ws, size_t ws_size, hipStream_t stream) {
    static int grid = 0;
    if (grid == 0) {
        if (n_in != 21 || ws_size < WS_END) { fprintf(stderr, "kernel_launch: n_in %d ws %zu (need %zu)\n", n_in, ws_size, (size_t)WS_END); grid = -1; return; }
        int dev = 0, cus = 0, per_cu = 0;
        hipGetDevice(&dev); hipDeviceGetAttribute(&cus, hipDeviceAttributeMultiprocessorCount, dev);
        hipFuncSetAttribute((const void*)fwd_megakernel, hipFuncAttributeMaxDynamicSharedMemorySize, LDS_BYTES);
        hipOccupancyMaxActiveBlocksPerMultiprocessor(&per_cu, (const void*)fwd_megakernel, 512, LDS_BYTES);
        if (per_cu < 1) per_cu = 1;
        grid = cus * 1;
        (void)hipGetLastError();
    }
    if (grid < 0) return;
    Params p{};
    for (int i = 0; i < 21; ++i) p.in[i] = (const float*)d_in[i];
    p.out = (float*)d_out; p.ws = (unsigned char*)d_ws;
    for (int i = 0; i < 32; ++i) p.inv[i] = 1.0f / powf(10000.0f, (float)i / 32.0f);
    const int dil[3] = {1, 4, 16};
    for (int g = 0; g < 3; ++g) for (int k = 0; k < 129; ++k) p.bkt[g][k] = (unsigned char)t5_bucket_host((k - 64) * dil[g]);
    (void)hipMemsetAsync((char*)d_ws + WS_BAR, 0, 16384, stream);
    void* args[] = {&p};
    hipError_t e = hipLaunchCooperativeKernel((const void*)fwd_megakernel, dim3(grid), dim3(512), args, LDS_BYTES, stream);
    if (e != hipSuccess) fprintf(stderr, "cooperative launch failed: %s (grid %d)\n", hipGetErrorString(e), grid);
}
```

```cpp
#include <hip/hip_runtime.h>
#include <hip/hip_cooperative_groups.h>
#include <cstdio>
#include <cstdint>
#include <cmath>
namespace cg = cooperative_groups;
#ifndef PH
#define PH 0xffff
#endif
#ifndef DBL
#define DBL 0
#endif

#define LAS __attribute__((address_space(3)))
#define GAS __attribute__((address_space(1)))
typedef unsigned short bf16_t;
typedef short bf16x8 __attribute__((ext_vector_type(8)));
typedef short s16x4 __attribute__((ext_vector_type(4)));
typedef float f32x4 __attribute__((ext_vector_type(4)));
typedef float f32x2 __attribute__((ext_vector_type(2)));
typedef float f32x16 __attribute__((ext_vector_type(16)));
typedef unsigned u32x4 __attribute__((ext_vector_type(4)));
typedef unsigned u32x2 __attribute__((ext_vector_type(2)));

__device__ __forceinline__ float shx(float v, int lane, int mask) { return __int_as_float(__builtin_amdgcn_ds_bpermute((lane ^ mask) << 2, __float_as_int(v))); }
__device__ __forceinline__ int opaque_tid(int wv) { int l; asm volatile("v_mbcnt_lo_u32_b32 %0, -1, 0\n\tv_mbcnt_hi_u32_b32 %0, -1, %0" : "=v"(l)); return wv * 64 + l; }
constexpr int DM = 2048, MC = 8192, NCHUNK = 6, DFF = 8192;
constexpr int NPROJ = 13056;
constexpr int OFF_CQ = 0, OFF_CKV = 512, OFF_KR = 1024, OFF_DIL = 1280, OFF_XQ = 5888, OFF_GATE = 6912;
constexpr int NQ = 2304, NKV = 3072;
constexpr int NMEMROWS = 2560;
constexpr float EPS = 1e-6f;

constexpr size_t WS_CTL  = 0;
constexpr size_t WS_ROPE = 4096;
constexpr size_t WS_BIAS = WS_ROPE + (size_t)8192 * 32 * 8;
constexpr size_t WS_WIN  = WS_BIAS + 8192;
constexpr size_t WS_WUQ  = WS_WIN  + (size_t)NPROJ * 2048 * 2;
constexpr size_t WS_WUKV = WS_WUQ  + (size_t)NQ * 512 * 2;
constexpr size_t WS_WMKV = WS_WUKV + (size_t)NKV * 512 * 2;
constexpr size_t WS_WBM  = WS_WMKV + (size_t)2048 * 2048 * 2;
constexpr size_t WS_WBD  = WS_WBM  + (size_t)2048 * 1536 * 2;
constexpr size_t WS_WBX  = WS_WBD  + (size_t)2048 * 512 * 2;
constexpr size_t WS_WOUT = WS_WBX  + (size_t)2048 * 1024 * 2;
constexpr size_t WS_WUP  = WS_WOUT + (size_t)2048 * 2048 * 2;
constexpr size_t WS_WDN  = WS_WUP  + (size_t)8192 * 2048 * 2;
constexpr size_t WS_MEMN = WS_WDN  + (size_t)2048 * 8192 * 2;
constexpr size_t WS_MEMKV= WS_MEMN + (size_t)NMEMROWS * 2048 * 2;
constexpr size_t WS_H    = WS_MEMKV+ (size_t)NMEMROWS * 2048 * 2;
constexpr size_t WS_PROJ = WS_H    + (size_t)MC * 2048 * 2;
constexpr size_t WS_CQ   = WS_PROJ + (size_t)MC * NPROJ * 2;
constexpr size_t WS_CKV  = WS_CQ   + (size_t)MC * 512 * 2;
constexpr size_t WS_KPE  = WS_CKV  + (size_t)MC * 512 * 2;
constexpr size_t WS_Q    = WS_KPE  + (size_t)MC * 64 * 2;
constexpr size_t WS_KV   = WS_Q    + (size_t)MC * NQ * 2;
constexpr size_t WS_OMLA = WS_KV   + (size_t)MC * NKV * 2;
constexpr size_t WS_ODG  = WS_OMLA + (size_t)MC * 3072 * 2;
constexpr size_t WS_LSE  = WS_ODG  + (size_t)3 * MC * 512 * 4;
constexpr size_t WS_ODIL = WS_LSE  + (size_t)3 * MC * 4 * 4;
constexpr size_t WS_OMEM = WS_ODIL + (size_t)MC * 512 * 2;
constexpr size_t WS_TMP  = WS_OMEM + (size_t)MC * 1024 * 2;
constexpr size_t WS_MERG = WS_TMP  + (size_t)MC * 2048 * 4;
constexpr size_t WS_SSQ  = WS_MERG + (size_t)MC * 2048 * 2;
constexpr size_t WS_SSQ2 = WS_SSQ  + (size_t)MC * 2 * 4;
constexpr size_t WS_MLP  = WS_SSQ2 + (size_t)MC * 4;
constexpr size_t WS_MLSE = WS_MLP  + (size_t)2 * MC * 512 * 4;
constexpr size_t WS_HN1  = WS_MLSE + (size_t)2 * MC * 4 * 4;
constexpr size_t WS_HX   = WS_HN1  + (size_t)MC * 2048 * 2;
constexpr size_t WS_SSQ3 = WS_HX   + (size_t)MC * 2048 * 2;
constexpr size_t WS_PCNT = WS_SSQ3 + (size_t)MC * 4;
constexpr size_t WS_BAR  = WS_PCNT + 32 * 64 * 4;
constexpr size_t WS_END  = WS_BAR + 16384;

constexpr int LDS_BYTES = 131072 + 1024;
constexpr int LDS_BIAS_OFF = 126976;

struct Params {
    const float* in[21]; float* out; unsigned char* ws;
    float inv[32];
    unsigned char bkt[3][132];
    int pad;
};

namespace pg8 {
constexpr int BM = 256, BK = 64, HALF = 128, HTB = HALF * BK * 2, STAGE_BYTES = 8 * HTB, NXCD = 8, WGM = 8;
__host__ __device__ __forceinline__ int lds_byte(int r, int c) { const int st = (r >> 4) * 2 + (c >> 5), rr = r & 15, cc = c & 31, ob = rr * 64 + cc * 2; return st * 1024 + (ob ^ (((ob >> 9) & 1) << 5)); }
__host__ __device__ __forceinline__ void stage_rc(int b, int& R, int& C) { const int st = b / 1024, sb = b % 1024, swz = sb ^ (((sb >> 9) & 1) << 5); R = (st >> 1) * 16 + swz / 64; C = (st & 1) * 32 + (swz % 64) / 2; }
__host__ __device__ __forceinline__ int perm32(int rho) { const int n = rho >> 4, i = rho & 15; return 8 * (i >> 2) + 4 * n + (i & 3); }
struct Unit { int pm, pn; };
struct Gemm { const bf16_t* A; const bf16_t* Bt; int M, N, K, lda; };
struct StaticOrder {
    int nM, nN, nwg, G, c;
    __host__ __device__ void init(int M, int N, int G_, int c_) { nM = M / BM; nN = N / BM; nwg = nM * nN; G = G_; c = c_; }
    __host__ __device__ bool next(int i, Unit& u) const {
        const long L = (long)i * G + c; if (L >= nwg) return false;
        int wgid = (int)L; { const int q = nwg / NXCD, r = nwg % NXCD, xcd = wgid % NXCD, off = wgid / NXCD; wgid = (xcd < r ? xcd * (q + 1) : r * (q + 1) + (xcd - r) * q) + off; }
        const int nig = WGM * nN, gid = wgid / nig, fm = gid * WGM, gsz = (nM - fm) < WGM ? (nM - fm) : WGM;
        u.pm = fm + ((wgid % nig) % gsz); u.pn = (wgid % nig) / gsz; return true;
    }
};
__device__ __forceinline__ unsigned cvt_pk_bf16(float lo, float hi) { unsigned r; asm volatile("v_cvt_pk_bf16_f32 %0, %1, %2" : "=v"(r) : "v"(lo), "v"(hi)); return r; }
__device__ __forceinline__ u32x4 pack8(f32x4 v0, f32x4 v1) { u32x4 w; w.x = cvt_pk_bf16(v0[0], v0[1]); w.y = cvt_pk_bf16(v0[2], v0[3]); w.z = cvt_pk_bf16(v1[0], v1[1]); w.w = cvt_pk_bf16(v1[2], v1[3]); return w; }
__device__ __forceinline__ float bf2f(unsigned short h) { return __uint_as_float(((unsigned)h) << 16); }

__device__ __forceinline__ void st16(bf16_t* p, u32x4 v) { *(GAS u32x4*)p = v; }
__device__ __forceinline__ void stf4(float* p, f32x4 v) { *(GAS f32x4*)p = v; }
__device__ __forceinline__ f32x4 ldf4(const float* p) { return *(const GAS f32x4*)p; }
__device__ __forceinline__ float sq8(f32x4 a, f32x4 b) { return (a[0] * a[0] + a[1] * a[1]) + (a[2] * a[2] + a[3] * a[3]) + (b[0] * b[0] + b[1] * b[1]) + (b[2] * b[2] + b[3] * b[3]); }
template <int ACT  , bool RS> struct EpiStore {
    static constexpr bool PERM = true, HOOK = false;
    bf16_t* O; int ldc; const float* rs; int rss; float invdim;
    __device__ __forceinline__ void operator()(const f32x4 (&acc)[2][2][4][2], const Unit& u, int wr, int wc, int fr, int fq) const {
        const int row0 = u.pm * BM + wr * 64 + fr, col0 = u.pn * BM + wc * 32 + 8 * fq;
#pragma unroll
        for (int ai = 0; ai < 2; ++ai)
#pragma unroll
            for (int m = 0; m < 4; ++m) { const int row = row0 + ai * HALF + m * 16; bf16_t* rowp = O + (size_t)row * ldc + col0;
                float sc = 1.f; if (RS) sc = rsqrtf(*(const GAS float*)(rs + (size_t)row * rss) * invdim + EPS);
#pragma unroll
                for (int bj = 0; bj < 2; ++bj) { f32x4 v0 = acc[ai][bj][m][0], v1 = acc[ai][bj][m][1];
                    if (RS) { v0 *= sc; v1 *= sc; }
                    if (ACT == 1) {
#pragma unroll
                        for (int e = 0; e < 4; ++e) { float a = fmaxf(v0[e], 0.f), b = fmaxf(v1[e], 0.f); v0[e] = a * a; v1[e] = b * b; } }
                    st16(rowp + bj * HALF, pack8(v0, v1)); } }
    }
};
struct EpiProj {
    static constexpr bool PERM = true, HOOK = false;
    bf16_t* O; float* ssq; bf16_t* kpe; const f32x2* rope; int posmask;
    __device__ __forceinline__ void operator()(const f32x4 (&acc)[2][2][4][2], const Unit& u, int wr, int wc, int fr, int fq) const {
        const int row0 = u.pm * BM + wr * 64 + fr, col0 = u.pn * BM + wc * 32 + 8 * fq;
        if (u.pn == 4) {
            if (wc < 2) {
                const int p = wc * 32 + 8 * fq, j = p >> 3;
#pragma unroll
                for (int ai = 0; ai < 2; ++ai)
#pragma unroll
                    for (int m = 0; m < 4; ++m) { const int row = row0 + ai * HALF + m * 16; const int pos = row & posmask;
                        const f32x4 v0 = acc[ai][0][m][0], v1 = acc[ai][0][m][1]; f32x4 o1, o2; const f32x2* rp = rope + (size_t)pos * 32 + 4 * j;
#pragma unroll
                        for (int e = 0; e < 4; ++e) { const f32x2 cs = *(const GAS f32x2*)(rp + e); o1[e] = v0[e] * cs.x - v1[e] * cs.y; o2[e] = v1[e] * cs.x + v0[e] * cs.y; }
                        st16(kpe + (size_t)row * 64 + p, pack8(o1, o2)); }
            }
            return;
        }
#pragma unroll
        for (int ai = 0; ai < 2; ++ai)
#pragma unroll
            for (int m = 0; m < 4; ++m) { const int row = row0 + ai * HALF + m * 16; bf16_t* rowp = O + (size_t)row * NPROJ + col0;
                st16(rowp, pack8(acc[ai][0][m][0], acc[ai][0][m][1])); st16(rowp + HALF, pack8(acc[ai][1][m][0], acc[ai][1][m][1]));
                if (u.pn < 4) { float s = sq8(acc[ai][0][m][0], acc[ai][0][m][1]) + sq8(acc[ai][1][m][0], acc[ai][1][m][1]);
                    { const int ln_ = fq * 16 + fr; s += shx(s, ln_, 16); s += shx(s, ln_, 32); }
                    if (fq == 0) __hip_atomic_fetch_add(ssq + (size_t)row * 2 + (u.pn >> 1), s, __ATOMIC_RELAXED, __HIP_MEMORY_SCOPE_AGENT); } }
    }
};
struct EpiQRope {
    static constexpr bool PERM = true, HOOK = false;
    bf16_t* Q; const f32x2* rope; int posmask; const float* ssq;
    __device__ __forceinline__ void operator()(const f32x4 (&acc)[2][2][4][2], const Unit& u, int wr, int wc, int fr, int fq) const {
        const int row0 = u.pm * BM + wr * 64 + fr, col0 = u.pn * BM + wc * 32 + 8 * fq;
#pragma unroll
        for (int ai = 0; ai < 2; ++ai)
#pragma unroll
            for (int m = 0; m < 4; ++m) { const int row = row0 + ai * HALF + m * 16; const int pos = row & posmask;
                const float sc = rsqrtf(*(const GAS float*)(ssq + (size_t)row * 2) * (1.f / 512.f) + EPS);
#pragma unroll
                for (int bj = 0; bj < 2; ++bj) { const int c = col0 + bj * HALF; const f32x4 v0 = acc[ai][bj][m][0] * sc, v1 = acc[ai][bj][m][1] * sc;
                    if (u.pn < 6) { const int h = c >> 7, d = c & 127; st16(Q + (size_t)row * NQ + h * 192 + d, pack8(v0, v1)); }
                    else { const int cc = c - 1536, h = cc >> 6, p = cc & 63, j = p >> 3; f32x4 o1, o2;
                        const f32x2* rp = rope + (size_t)pos * 32 + 4 * j;
#pragma unroll
                        for (int e = 0; e < 4; ++e) { const f32x2 cs = *(const GAS f32x2*)(rp + e); o1[e] = v0[e] * cs.x - v1[e] * cs.y; o2[e] = v1[e] * cs.x + v0[e] * cs.y; }
                        st16(Q + (size_t)row * NQ + h * 192 + 128 + p, pack8(o1, o2)); } } }
    }
};
template <int MODE  > struct EpiGate {
    static constexpr bool PERM = true, HOOK = false;
    const bf16_t* gate; float* tmp; bf16_t* merged;
    __device__ __forceinline__ void operator()(const f32x4 (&acc)[2][2][4][2], const Unit& u, int wr, int wc, int fr, int fq) const {
        const int row0 = u.pm * BM + wr * 64 + fr, col0 = u.pn * BM + wc * 32 + 8 * fq;
#pragma unroll
        for (int ai = 0; ai < 2; ++ai)
#pragma unroll
            for (int m = 0; m < 4; ++m) { const int row = row0 + ai * HALF + m * 16;
#pragma unroll
                for (int bj = 0; bj < 2; ++bj) { const int c = col0 + bj * HALF;
                    const u32x4 gw = *(const GAS u32x4*)(gate + (size_t)row * NPROJ + c);
                    f32x4 v0 = acc[ai][bj][m][0], v1 = acc[ai][bj][m][1];
#pragma unroll
                    for (int e = 0; e < 4; ++e) {
                        const unsigned w0 = gw[e >> 1], w1 = gw[2 + (e >> 1)];
                        const float g0 = __uint_as_float((e & 1) ? (w0 & 0xffff0000u) : (w0 << 16)), g1 = __uint_as_float((e & 1) ? (w1 & 0xffff0000u) : (w1 << 16));
                        v0[e] *= 1.f / (1.f + __expf(-g0)); v1[e] *= 1.f / (1.f + __expf(-g1)); }
                    float* tp = tmp + (size_t)row * DM + c;
                    if (MODE == 0) { stf4(tp, v0); stf4(tp + 4, v1); }
                    else { v0 += ldf4(tp); v1 += ldf4(tp + 4);
                        if (MODE == 1) { stf4(tp, v0); stf4(tp + 4, v1); }
                        else st16(merged + (size_t)row * DM + c, pack8(v0, v1)); } } }
    }
};
struct EpiBranch {
    static constexpr bool PERM = true, HOOK = true;
    const bf16_t* gate; bf16_t* merged;
    static __device__ __forceinline__ float gsel(const u32x4& w, int i) { const unsigned x = w[i >> 1]; return __uint_as_float((i & 1) ? (x & 0xffff0000u) : (x << 16)); }
    __device__ __forceinline__ void hook(f32x4 (&acc)[2][2][4][2], const Unit& u, int seg, int wr, int wc, int fr, int fq) const {
        const int row0 = u.pm * BM + wr * 64 + fr, col0 = u.pn * BM + wc * 32 + 8 * fq;
        int zero = 0;
#pragma unroll
        for (int ai = 0; ai < 2; ++ai)
#pragma unroll
            for (int m = 0; m < 4; ++m) { const bf16_t* gp = gate + (size_t)(row0 + ai * HALF + m * 16 + zero) * NPROJ + seg * 2048 + col0;
#pragma unroll
                for (int bj = 0; bj < 2; ++bj) { const u32x4 ga = *(const GAS u32x4*)(gp + bj * HALF), gb = *(const GAS u32x4*)(gp + 2048 + bj * HALF);
#pragma unroll
                    for (int e = 0; e < 4; ++e) {
                        acc[ai][bj][m][0][e] *= (1.f + __expf(-gsel(gb, e))) * __builtin_amdgcn_rcpf(1.f + __expf(-gsel(ga, e)));
                        acc[ai][bj][m][1][e] *= (1.f + __expf(-gsel(gb, 4 + e))) * __builtin_amdgcn_rcpf(1.f + __expf(-gsel(ga, 4 + e))); } }
                asm volatile("" : "+v"(zero), "+v"(acc[ai][0][m][0]), "+v"(acc[ai][1][m][1])); }
    }
    __device__ __forceinline__ void operator()(const f32x4 (&acc)[2][2][4][2], const Unit& u, int wr, int wc, int fr, int fq) const {
        const int row0 = u.pm * BM + wr * 64 + fr, col0 = u.pn * BM + wc * 32 + 8 * fq;
#pragma unroll
        for (int ai = 0; ai < 2; ++ai)
#pragma unroll
            for (int m = 0; m < 4; ++m) { const int row = row0 + ai * HALF + m * 16; const bf16_t* gp = gate + (size_t)row * NPROJ + 4096 + col0;
#pragma unroll
                for (int bj = 0; bj < 2; ++bj) { const u32x4 gw = *(const GAS u32x4*)(gp + bj * HALF); f32x4 v0 = acc[ai][bj][m][0], v1 = acc[ai][bj][m][1];
#pragma unroll
                    for (int e = 0; e < 4; ++e) { v0[e] *= __builtin_amdgcn_rcpf(1.f + __expf(-gsel(gw, e))); v1[e] *= __builtin_amdgcn_rcpf(1.f + __expf(-gsel(gw, 4 + e))); }
                    st16(merged + (size_t)row * DM + col0 + bj * HALF, pack8(v0, v1)); } }
    }
};
template <bool NRM> struct EpiResid {
    static constexpr bool PERM = true, HOOK = false;
    const float* base; float* out; bf16_t* hb; float* ssq2;
    __device__ __forceinline__ void operator()(const f32x4 (&acc)[2][2][4][2], const Unit& u, int wr, int wc, int fr, int fq) const {
        const int row0 = u.pm * BM + wr * 64 + fr, col0 = u.pn * BM + wc * 32 + 8 * fq;
#pragma unroll
        for (int ai = 0; ai < 2; ++ai)
#pragma unroll
            for (int m = 0; m < 4; ++m) { const int row = row0 + ai * HALF + m * 16; const size_t off = (size_t)row * DM + col0; float s = 0.f;
#pragma unroll
                for (int bj = 0; bj < 2; ++bj) { const f32x4 o0 = ldf4(base + off + bj * HALF) + acc[ai][bj][m][0], o1 = ldf4(base + off + bj * HALF + 4) + acc[ai][bj][m][1];
                    stf4(out + off + bj * HALF, o0); stf4(out + off + bj * HALF + 4, o1);
                    if (NRM) { st16(hb + off + bj * HALF, pack8(o0, o1)); s += sq8(o0, o1); } }
                if (NRM) { { const int ln_ = fq * 16 + fr; s += shx(s, ln_, 16); s += shx(s, ln_, 32); }
                    if (fq == 0) __hip_atomic_fetch_add(ssq2 + row, s, __ATOMIC_RELAXED, __HIP_MEMORY_SCOPE_AGENT); } }
    }
};

struct EpiFinal {
    static constexpr bool PERM = true, HOOK = false;
    const float* base; float* out; const float* gfin; float* ssq3; unsigned* pcnt;
    __device__ __forceinline__ void operator()(f32x4 (&acc)[2][2][4][2], const Unit& u, int wr, int wc, int fr, int fq) const {
        const int row0 = u.pm * BM + wr * 64 + fr, col0 = u.pn * BM + wc * 32 + 8 * fq; const int ln_ = fq * 16 + fr;
#pragma unroll
        for (int ai = 0; ai < 2; ++ai)
#pragma unroll
            for (int m = 0; m < 4; ++m) { const int row = row0 + ai * HALF + m * 16; const size_t off = (size_t)row * DM + col0; float s = 0.f;
#pragma unroll
                for (int bj = 0; bj < 2; ++bj) { acc[ai][bj][m][0] += ldf4(base + off + bj * HALF); acc[ai][bj][m][1] += ldf4(base + off + bj * HALF + 4); s += sq8(acc[ai][bj][m][0], acc[ai][bj][m][1]); }
                s += shx(s, ln_, 16); s += shx(s, ln_, 32);
                if (fq == 0) __hip_atomic_fetch_add(ssq3 + row, s, __ATOMIC_RELAXED, __HIP_MEMORY_SCOPE_AGENT); }
        asm volatile("s_waitcnt vmcnt(0)" ::: "memory");
        unsigned* cw = pcnt + 64 * u.pm;
        if (ln_ == 0) __hip_atomic_fetch_add(cw, 1u, __ATOMIC_RELAXED, __HIP_MEMORY_SCOPE_AGENT);
        { unsigned sp = 0; while ((unsigned)__builtin_amdgcn_readfirstlane(__hip_atomic_load(cw, __ATOMIC_RELAXED, __HIP_MEMORY_SCOPE_AGENT)) < 64u) { __builtin_amdgcn_s_sleep(2); if (++sp > (1u << 22)) break; } }
        __builtin_amdgcn_fence(__ATOMIC_ACQUIRE, "agent");
        f32x4 g0[2], g1[2];
#pragma unroll
        for (int bj = 0; bj < 2; ++bj) { g0[bj] = ldf4(gfin + col0 + bj * HALF); g1[bj] = ldf4(gfin + col0 + bj * HALF + 4); }
#pragma unroll
        for (int ai = 0; ai < 2; ++ai)
#pragma unroll
            for (int m = 0; m < 4; ++m) { const int row = row0 + ai * HALF + m * 16; const size_t off = (size_t)row * DM + col0;
                const float rstd = rsqrtf(__hip_atomic_load(ssq3 + row, __ATOMIC_RELAXED, __HIP_MEMORY_SCOPE_AGENT) * (1.f / 2048.f) + EPS);
#pragma unroll
                for (int bj = 0; bj < 2; ++bj) { stf4(out + off + bj * HALF, acc[ai][bj][m][0] * rstd * g0[bj]); stf4(out + off + bj * HALF + 4, acc[ai][bj][m][1] * rstd * g1[bj]); } }
    }
};

template <class Epi>
__device__ __forceinline__ void gemm_phase(LAS unsigned char* lds, const Gemm g, const StaticOrder& S, const Epi& E, const int wv) {
    const int tid_ = opaque_tid(wv);
    const int tid = tid_, wid = __builtin_amdgcn_readfirstlane(tid >> 6), lane = tid & 63, wr = wid >> 2, wc = wid & 3, fr = lane & 15, fq = lane >> 4;
    const int K = g.K, nt = K / BK;
    unsigned voffA[2], voffB[2];
#pragma unroll
    for (int i = 0; i < 2; ++i) { int R, C; stage_rc(tid * 16 + i * 8192, R, C); const int Rb = Epi::PERM ? ((R & ~31) + perm32(R & 31)) : R;
        voffA[i] = (unsigned)(R * g.lda + C) * 2u; voffB[i] = (unsigned)(Rb * K + C) * 2u; }
    const size_t kstep = (size_t)(BK * 2);
    const size_t hstep = (size_t)HALF * K * 2;
    const size_t tstep = 2 * hstep;
    const size_t hstepA = (size_t)HALF * g.lda * 2, tstepA = 2 * hstepA;
    const unsigned ldsw = (unsigned)wid * 1024u;
    const int aoff = lds_byte(wr * 64 + fr, fq * 8), boff = lds_byte(wc * 32 + fr, fq * 8);
#define PG8_SA(b, h) (((b) * 2 + (h)) * HTB)
#define PG8_SB(b, h) ((4 + (b) * 2 + (h)) * HTB)
#define PG8_STAGE(bufoff, gbase, voff) do { _Pragma("unroll") for (int _i = 0; _i < 2; ++_i) \
        __builtin_amdgcn_global_load_lds((const unsigned*)((const char*)(gbase) + (voff)[_i]), (LAS unsigned*)(lds + (bufoff) + ldsw + _i * 8192), 16, 0, 0); } while (0)
#define PG8_LDA(dst, b, h) do { _Pragma("unroll") for (int m = 0; m < 4; ++m) _Pragma("unroll") for (int k = 0; k < 2; ++k) dst[m][k] = *(const LAS bf16x8*)(lds + PG8_SA(b, h) + aoff + m * 2048 + k * 1024); } while (0)
#define PG8_LDB(dst, b, h) do { _Pragma("unroll") for (int n = 0; n < 2; ++n) _Pragma("unroll") for (int k = 0; k < 2; ++k) dst[n][k] = *(const LAS bf16x8*)(lds + PG8_SB(b, h) + boff + n * 2048 + k * 1024); } while (0)
#define PG8_MMA(ai, bj, At, Bt) do { __builtin_amdgcn_s_setprio(1); _Pragma("unroll") for (int m = 0; m < 4; ++m) _Pragma("unroll") for (int n = 0; n < 2; ++n) _Pragma("unroll") for (int k = 0; k < 2; ++k) \
        acc[ai][bj][m][n] = __builtin_amdgcn_mfma_f32_16x16x32_bf16(Bt[n][k], At[m][k], acc[ai][bj][m][n], 0, 0, 0); __builtin_amdgcn_s_setprio(0); } while (0)
#define PG8_WAIT_V(n) asm volatile("s_waitcnt vmcnt(" #n ")" ::: "memory")
#define PG8_WAIT_L(n) asm volatile("s_waitcnt lgkmcnt(" #n ")" ::: "memory")
#define PG8_BAR __builtin_amdgcn_s_barrier()
#define PG8_SCHED __builtin_amdgcn_sched_barrier(0)
    Unit cur, nxt; int ui = 0;
    if (!S.next(0, cur)) return;
    f32x4 acc[2][2][4][2];
#pragma unroll
    for (int a = 0; a < 2; ++a)
#pragma unroll
        for (int b = 0; b < 2; ++b)
#pragma unroll
            for (int m = 0; m < 4; ++m)
#pragma unroll
                for (int n = 0; n < 2; ++n) acc[a][b][m][n] = (f32x4){0.f, 0.f, 0.f, 0.f};
    bf16x8 At[4][2], B0[2][2], B1[2][2];
    const char* cA = (const char*)g.A + (size_t)cur.pm * tstepA; const char* cB = (const char*)g.Bt + (size_t)cur.pn * tstep;
    PG8_STAGE(PG8_SB(0, 0), cB, voffB); PG8_STAGE(PG8_SB(0, 1), cB + hstep, voffB); PG8_STAGE(PG8_SA(0, 0), cA, voffA); PG8_STAGE(PG8_SA(0, 1), cA + hstepA, voffA);
    if (wr == 1) PG8_BAR;
    PG8_WAIT_V(2); PG8_BAR;
    PG8_STAGE(PG8_SB(1, 0), cB + kstep, voffB); PG8_STAGE(PG8_SA(1, 0), cA + kstep, voffA); PG8_STAGE(PG8_SB(1, 1), cB + hstep + kstep, voffB);
    PG8_WAIT_V(6); PG8_BAR;
    for (;;) {
        const bool has_next = S.next(ui + 1, nxt);
        const char* nA = has_next ? (const char*)g.A + (size_t)nxt.pm * tstepA : cA; const char* nB = has_next ? (const char*)g.Bt + (size_t)nxt.pn * tstep : cB;
#define PG8_KITER(t) do { \
            const bool last = (t == nt - 2); \
            const char* a1 = cA + (size_t)(t + 1) * kstep; \
            const char* a2 = last ? nA : cA + (size_t)(t + 2) * kstep; const char* b2 = last ? nB : cB + (size_t)(t + 2) * kstep; \
            const char* a3 = a2 + kstep; const char* b3 = b2 + kstep; \
            PG8_LDB(B0, 0, 0); PG8_LDB(B1, 0, 1); PG8_SCHED; PG8_LDA(At, 0, 0); PG8_STAGE(PG8_SA(1, 1), a1 + hstepA, voffA); \
            PG8_WAIT_V(8); PG8_WAIT_L(0); PG8_BAR; PG8_MMA(0, 0, At, B0); PG8_MMA(0, 1, At, B1); PG8_BAR; PG8_SCHED; \
            PG8_LDA(At, 0, 1); PG8_STAGE(PG8_SB(0, 0), b2, voffB); PG8_STAGE(PG8_SB(0, 1), b2 + hstep, voffB); PG8_STAGE(PG8_SA(0, 0), a2, voffA); \
            PG8_WAIT_V(8); PG8_WAIT_L(0); PG8_BAR; PG8_MMA(1, 0, At, B0); PG8_MMA(1, 1, At, B1); PG8_BAR; PG8_SCHED; \
            PG8_LDB(B0, 1, 0); PG8_LDB(B1, 1, 1); PG8_SCHED; PG8_LDA(At, 1, 0); PG8_STAGE(PG8_SA(0, 1), a2 + hstepA, voffA); \
            PG8_WAIT_V(8); PG8_WAIT_L(0); PG8_BAR; PG8_MMA(0, 0, At, B0); PG8_MMA(0, 1, At, B1); PG8_BAR; PG8_SCHED; \
            PG8_LDA(At, 1, 1); PG8_STAGE(PG8_SB(1, 0), b3, voffB); PG8_STAGE(PG8_SB(1, 1), b3 + hstep, voffB); PG8_STAGE(PG8_SA(1, 0), a3, voffA); \
            PG8_WAIT_V(8); PG8_WAIT_L(0); PG8_BAR; PG8_MMA(1, 0, At, B0); PG8_MMA(1, 1, At, B1); PG8_BAR; PG8_SCHED; \
        } while (0)
        if constexpr (Epi::HOOK) {
            int t = 0;
#pragma nounroll
            for (int seg = 0; seg < 3; ++seg) { const int te = (seg == 0) ? 24 : (seg == 1 ? 32 : nt);
                for (; t < te; t += 2) PG8_KITER(t);
                if (seg < 2) E.hook(acc, cur, seg, wr, wc, fr, fq); }
        } else {
            for (int t = 0; t < nt; t += 2) PG8_KITER(t);
        }
        if (wr == 0) PG8_BAR;
        E(acc, cur, wr, wc, fr, fq);
        if (!has_next) break;
#pragma unroll
        for (int a = 0; a < 2; ++a)
#pragma unroll
            for (int b = 0; b < 2; ++b)
#pragma unroll
                for (int m = 0; m < 4; ++m)
#pragma unroll
                    for (int n = 0; n < 2; ++n) acc[a][b][m][n] = (f32x4){0.f, 0.f, 0.f, 0.f};
        cur = nxt; cA = nA; cB = nB; ++ui;
        if (wr == 1) PG8_BAR;
    }
    PG8_WAIT_V(0);
    PG8_BAR;
#undef PG8_SA
#undef PG8_SB
#undef PG8_STAGE
#undef PG8_LDA
#undef PG8_LDB
#undef PG8_MMA
#undef PG8_WAIT_V
#undef PG8_WAIT_L
#undef PG8_BAR
#undef PG8_SCHED
#undef PG8_KITER
}
}

namespace att {
#define KSWZ(row, colB) ((row) * 256 + ((colB) ^ (((row) & 7) << 4)))
#define XSWZ(row, colB) ((row) * 128 + ((colB) ^ ((((row) >> 1) & 7) << 4)))
#define SBAR() __builtin_amdgcn_sched_barrier(0)
__device__ __forceinline__ int crow(int r, int hi) { return (r & 3) + 8 * (r >> 2) + 4 * hi; }
__device__ __forceinline__ unsigned cvtpk(float lo, float hi) { unsigned r; asm volatile("v_cvt_pk_bf16_f32 %0, %1, %2" : "=v"(r) : "v"(lo), "v"(hi)); return r; }
__device__ __forceinline__ bf16x8 ld8(const bf16_t* p) { return *(const GAS bf16x8*)p; }

__device__ __forceinline__ void partialSM(f32x16& p0, f32x16& p1, float& m_reg, float& mn, float& alpha, const float C, const float thr) {
    float pmax = p0[0];
#pragma unroll
    for (int r = 1; r < 16; ++r) pmax = fmaxf(pmax, p0[r]);
#pragma unroll
    for (int r = 0; r < 16; ++r) pmax = fmaxf(pmax, p1[r]);
    { auto rr = __builtin_amdgcn_permlane32_swap(__float_as_uint(pmax), __float_as_uint(pmax), false, false);
      pmax = fmaxf(__uint_as_float(rr[0]), __uint_as_float(rr[1])); }
    if (__builtin_expect(__all(pmax - m_reg <= thr), 1)) { mn = m_reg; alpha = 1.f; }
    else { mn = fmaxf(m_reg, pmax); alpha = __builtin_amdgcn_exp2f((m_reg - mn) * C); m_reg = mn; }
    const float mnC = -mn * C;
#pragma unroll
    for (int r = 0; r < 16; ++r) p0[r] = fmaf(p0[r], C, mnC);
#pragma unroll
    for (int r = 0; r < 16; ++r) p1[r] = fmaf(p1[r], C, mnC);
#pragma unroll
    for (int r = 0; r < 16; ++r) p0[r] = __builtin_amdgcn_exp2f(p0[r]);
}
__device__ __forceinline__ void finishSM(f32x16& p0, f32x16& p1, float alpha, float& l_reg, bf16x8& pa0, bf16x8& pa1, bf16x8& pa2, bf16x8& pa3) {
#pragma unroll
    for (int r = 0; r < 16; ++r) p1[r] = __builtin_amdgcn_exp2f(p1[r]);
    float ps = 0;
#pragma unroll
    for (int r = 0; r < 16; ++r) ps += p0[r];
#pragma unroll
    for (int r = 0; r < 16; ++r) ps += p1[r];
    { auto rr = __builtin_amdgcn_permlane32_swap(__float_as_uint(ps), __float_as_uint(ps), false, false);
      ps = __uint_as_float(rr[0]) + __uint_as_float(rr[1]); }
    l_reg = l_reg * alpha + ps;
#define PK4(P, BASE, OUT) do { unsigned a0 = cvtpk(P[BASE + 0], P[BASE + 1]), a1 = cvtpk(P[BASE + 2], P[BASE + 3]);   \
    unsigned b0 = cvtpk(P[BASE + 4], P[BASE + 5]), b1 = cvtpk(P[BASE + 6], P[BASE + 7]);                              \
    auto r0 = __builtin_amdgcn_permlane32_swap(a0, b0, false, false); auto r1 = __builtin_amdgcn_permlane32_swap(a1, b1, false, false); \
    u32x4 w = {r0[0], r1[0], r0[1], r1[1]}; OUT = *reinterpret_cast<bf16x8*>(&w); } while (0)
    PK4(p0, 0, pa0); PK4(p0, 8, pa1); PK4(p1, 0, pa2); PK4(p1, 8, pa3);
#undef PK4
}
__device__ __forceinline__ int v_st(int k, int c) { const int kk = (k & ~0xC) | ((k & 4) << 1) | ((k & 8) >> 1); return ((kk >> 3) * 4 + (c >> 5)) * 512 + ((kk & 7) * 32 + (c & 31)) * 2; }
__device__ __forceinline__ int v_rd_base(int lane) { return ((lane & 3) << 3) | (((lane >> 2) & 3) << 6) | (((lane >> 4) & 1) << 5) | (((lane >> 5) & 1) << 8); }
constexpr int v_rd_off(int d0, int ks, int half) { return d0 * 512 + ks * 4096 + half * 2048; }
template <int OFF> __device__ __forceinline__ s16x4 tr_read(int vb) {
    s16x4 r; asm volatile("ds_read_b64_tr_b16 %0, %1 offset:%2" : "=&v"(r) : "v"(vb), "i"(OFF) : "memory"); return r;
}
template <int D0> __device__ __forceinline__ void pv_one(f32x16& od, int vb, bf16x8 pa0, bf16x8 pa1, bf16x8 pa2, bf16x8 pa3) {
    const s16x4 l0 = tr_read<v_rd_off(D0, 0, 0)>(vb), h0 = tr_read<v_rd_off(D0, 0, 1)>(vb), l1 = tr_read<v_rd_off(D0, 1, 0)>(vb), h1 = tr_read<v_rd_off(D0, 1, 1)>(vb);
    const s16x4 l2 = tr_read<v_rd_off(D0, 2, 0)>(vb), h2 = tr_read<v_rd_off(D0, 2, 1)>(vb), l3 = tr_read<v_rd_off(D0, 3, 0)>(vb), h3 = tr_read<v_rd_off(D0, 3, 1)>(vb);
    asm volatile("s_waitcnt lgkmcnt(0)" ::: "memory"); SBAR();
#define PK(L, H) (bf16x8){L[0], L[1], L[2], L[3], H[0], H[1], H[2], H[3]}
    od = __builtin_amdgcn_mfma_f32_32x32x16_bf16(pa0, PK(l0, h0), od, 0, 0, 0);
    od = __builtin_amdgcn_mfma_f32_32x32x16_bf16(pa1, PK(l1, h1), od, 0, 0, 0);
    od = __builtin_amdgcn_mfma_f32_32x32x16_bf16(pa2, PK(l2, h2), od, 0, 0, 0);
    od = __builtin_amdgcn_mfma_f32_32x32x16_bf16(pa3, PK(l3, h3), od, 0, 0, 0);
#undef PK
}
__device__ __forceinline__ void pv_d0(f32x16* o, int vb, bf16x8 pa0, bf16x8 pa1, bf16x8 pa2, bf16x8 pa3) {
    pv_one<0>(o[0], vb, pa0, pa1, pa2, pa3); pv_one<1>(o[1], vb, pa0, pa1, pa2, pa3); pv_one<2>(o[2], vb, pa0, pa1, pa2, pa3); pv_one<3>(o[3], vb, pa0, pa1, pa2, pa3);
}

template <int RX, bool HOLDX, bool DIL, bool F32OUT>
__device__ __forceinline__ void attn_unit(const bf16_t* __restrict__ Qb, long ldq,
                                          const bf16_t* __restrict__ Kh, const bf16_t* __restrict__ Vh, long ldk,
                                          const bf16_t* __restrict__ Kx, long ldkx,
                                          const int NT, const float SCALE,
                                          bf16_t* Ob, long ldo, float* Of, long ldof, float* Lse, long ldl,
                                          const int q0, const int ssub, const float* biasL, char* lds, const int wv) {
    constexpr int NX = RX / 16, NQH = 8 + (HOLDX ? NX : 0);
    constexpr int SHM_V = 64 * 128 * 2, SHM_K = 64 * 128 * 2, SHM_X = 64 * (RX ? RX : 8) * 2;
    const int tid_ = opaque_tid(wv);
    const int tid = tid_, wid = tid >> 6, lane = tid & 63, r32 = lane & 31, hi = lane >> 5;
    char* V_lds = lds; char* K_lds = lds + 2 * SHM_V; char* X_lds = lds + 2 * SHM_V + 2 * SHM_K;
    float* ws = (float*)(lds + 2 * SHM_V + 2 * SHM_K + 2 * SHM_X) + wid * 64; float* li_l = ws; float* al_l = ws + 32;
    const float C = SCALE * 1.4426950408889634f, thr = 8.f / SCALE;
    float m_reg = DIL ? -1e29f : -1e30f, l_reg = 0; f32x16 o[4] = {}; bf16x8 qr[NQH];
    const bf16_t* Qw = Qb + (long)(wid * 32 + r32) * ldq + hi * 8;
#pragma unroll
    for (int d0 = 0; d0 < NQH; ++d0) qr[d0] = ld8(Qw + d0 * 16);
    const int sr = tid >> 4, sc = (tid & 15) * 8, vst0 = v_st(sr, sc), vst1 = v_st(32 + sr, sc);
    const int xr = tid >> 3, xc = (tid & 7) * 8;
    const int vb0 = (int)(uintptr_t)V_lds + v_rd_base(lane);
    const int kbase = DIL ? q0 - 64 : 0;
    bf16x8 vs0, vs1, ks0, ks1, xs0, xs1;
#define ROWK(k) (DIL ? (long)min(max((k), 0), ssub - 1) : (long)(k))
#define SLOAD(k0) do { const long ra_ = ROWK(kbase + (k0) + sr), rb_ = ROWK(kbase + (k0) + 32 + sr); \
        vs0 = ld8(Vh + ra_ * ldk + sc); vs1 = ld8(Vh + rb_ * ldk + sc); ks0 = ld8(Kh + ra_ * ldk + sc); ks1 = ld8(Kh + rb_ * ldk + sc); \
        if constexpr (RX == 64) { xs0 = ld8(Kx + (long)((k0) + xr) * ldkx + xc); } \
        if constexpr (RX == 128) { xs0 = ld8(Kx + ra_ * ldkx + sc); xs1 = ld8(Kx + rb_ * ldkx + sc); } } while (0)
#define SWRITE(b) do { *(bf16x8*)(V_lds + (b) * SHM_V + vst0) = vs0; *(bf16x8*)(V_lds + (b) * SHM_V + vst1) = vs1; const int kc = sc * 2; \
        *(bf16x8*)(K_lds + (b) * SHM_K + KSWZ(sr, kc)) = ks0; *(bf16x8*)(K_lds + (b) * SHM_K + KSWZ(32 + sr, kc)) = ks1; \
        if constexpr (RX == 64) { *(bf16x8*)(X_lds + (b) * SHM_X + XSWZ(xr, xc * 2)) = xs0; } \
        if constexpr (RX == 128) { *(bf16x8*)(X_lds + (b) * SHM_X + KSWZ(sr, kc)) = xs0; *(bf16x8*)(X_lds + (b) * SHM_X + KSWZ(32 + sr, kc)) = xs1; } } while (0)
#define SWAIT() asm volatile("s_waitcnt vmcnt(0)" ::: "memory")
#define RESC(a) do { if (__any((a) < 1.f)) { if (hi == 0) al_l[r32] = (a); asm volatile("s_waitcnt lgkmcnt(0)" ::: "memory"); \
        _Pragma("unroll") for (int d = 0; d < 4; ++d) _Pragma("unroll") for (int r = 0; r < 16; ++r) o[d][r] *= al_l[crow(r, hi)]; } } while (0)
#define QKT(P0, P1, b) do { P0 = f32x16{}; P1 = f32x16{}; const char* Kb_ = K_lds + (b) * SHM_K; const char* Xb_ = X_lds + (b) * SHM_X; \
        _Pragma("unroll") for (int d0 = 0; d0 < 8; ++d0) { const int cb = (d0 * 16 + hi * 8) * 2; \
            const bf16x8 b0 = *reinterpret_cast<const bf16x8*>(Kb_ + KSWZ(r32, cb)); const bf16x8 b1 = *reinterpret_cast<const bf16x8*>(Kb_ + KSWZ(32 + r32, cb)); \
            P0 = __builtin_amdgcn_mfma_f32_32x32x16_bf16(b0, qr[d0], P0, 0, 0, 0); P1 = __builtin_amdgcn_mfma_f32_32x32x16_bf16(b1, qr[d0], P1, 0, 0, 0); } \
        _Pragma("unroll") for (int x = 0; x < NX; ++x) { const int cb = (x * 16 + hi * 8) * 2; bf16x8 b0, b1; \
            if constexpr (RX == 64) { b0 = *reinterpret_cast<const bf16x8*>(Xb_ + XSWZ(r32, cb)); b1 = *reinterpret_cast<const bf16x8*>(Xb_ + XSWZ(32 + r32, cb)); } \
            else { b0 = *reinterpret_cast<const bf16x8*>(Xb_ + KSWZ(r32, cb)); b1 = *reinterpret_cast<const bf16x8*>(Xb_ + KSWZ(32 + r32, cb)); } \
            bf16x8 qx; if ((8 + x) < NQH) qx = qr[(8 + x) < NQH ? (8 + x) : 0]; else qx = ld8(Qw + (8 + x) * 16); \
            P0 = __builtin_amdgcn_mfma_f32_32x32x16_bf16(b0, qx, P0, 0, 0, 0); P1 = __builtin_amdgcn_mfma_f32_32x32x16_bf16(b1, qx, P1, 0, 0, 0); } } while (0)
#define MASK(P0, P1, t) do { if constexpr (DIL) { const int qq_ = q0 + wid * 32 + r32; const int kt_ = q0 - 64 + (t) * 64 + 4 * hi; \
        _Pragma("unroll") for (int r = 0; r < 16; ++r) { const int kk_ = kt_ + (r & 3) + 8 * (r >> 2); const int rel_ = kk_ - qq_; \
            { const bool ok_ = (rel_ >= -64) & (rel_ <= 64) & (kk_ >= 0) & (kk_ < ssub); const float b_ = biasL[min(max(rel_ + 64, 0), 128)]; P0[r] = ok_ ? P0[r] + b_ : -1e30f; } \
            { const int k2_ = kk_ + 32, r2_ = rel_ + 32; const bool ok_ = (r2_ >= -64) & (r2_ <= 64) & (k2_ >= 0) & (k2_ < ssub); const float b_ = biasL[min(max(r2_ + 64, 0), 128)]; P1[r] = ok_ ? P1[r] + b_ : -1e30f; } } } } while (0)
    f32x16 pA0, pA1, pB0, pB1; float mnA, mnB, alA, alB; bf16x8 pa0, pa1, pa2, pa3;
    const int tlo = __builtin_amdgcn_readfirstlane(wid >> 1);
#define ACT(t) (!DIL || ((t) >= tlo && (t) <= tlo + 2))
#define QKM(P0, P1, b, t) do { if (ACT(t)) { QKT(P0, P1, b); MASK(P0, P1, t); } else { _Pragma("unroll") for (int r = 0; r < 16; ++r) { P0[r] = -1e30f; P1[r] = -1e30f; } } } while (0)
#define PVA(t, vb) do { if (ACT(t)) pv_d0(o, vb, pa0, pa1, pa2, pa3); } while (0)
    SLOAD(0); SWAIT(); SWRITE(0); __syncthreads();
    QKM(pA0, pA1, 0, 0); partialSM(pA0, pA1, m_reg, mnA, alA, C, thr);
    SLOAD(64);
    SWAIT(); SWRITE(1); __syncthreads();
    for (int j = 1; j + 1 < NT; j += 2) {
        SBAR(); QKM(pB0, pB1, 1, j);
        finishSM(pA0, pA1, alA, l_reg, pa0, pa1, pa2, pa3); SBAR();
        SLOAD((j + 1) * 64); SBAR();
        PVA(j - 1, vb0); partialSM(pB0, pB1, m_reg, mnB, alB, C, thr);
        __syncthreads(); SWAIT(); SWRITE(0);
        RESC(alB); __syncthreads();
        SBAR(); QKM(pA0, pA1, 0, j + 1);
        finishSM(pB0, pB1, alB, l_reg, pa0, pa1, pa2, pa3); SBAR();
        SLOAD((j + 2) * 64); SBAR();
        PVA(j, vb0 + SHM_V); partialSM(pA0, pA1, m_reg, mnA, alA, C, thr);
        __syncthreads(); SWAIT(); SWRITE(1);
        RESC(alA); __syncthreads();
    }
    SBAR(); QKM(pB0, pB1, 1, NT - 1);
    finishSM(pA0, pA1, alA, l_reg, pa0, pa1, pa2, pa3); SBAR();
    PVA(NT - 2, vb0); partialSM(pB0, pB1, m_reg, mnB, alB, C, thr);
    __syncthreads(); RESC(alB);
    finishSM(pB0, pB1, alB, l_reg, pa0, pa1, pa2, pa3); SBAR();
    PVA(NT - 1, vb0 + SHM_V);
    if (hi == 0) li_l[r32] = l_reg; asm volatile("s_waitcnt lgkmcnt(0)" ::: "memory");
    float rli[16];
#pragma unroll
    for (int r = 0; r < 16; ++r) rli[r] = __builtin_amdgcn_rcpf(li_l[crow(r, hi)]);
    if constexpr (F32OUT) {
        float* Ow = Of + (long)(wid * 32) * ldof;
#pragma unroll
        for (int r = 0; r < 16; ++r) { const int orow = crow(r, hi);
#pragma unroll
            for (int d0 = 0; d0 < 4; ++d0) *(GAS float*)(Ow + (long)orow * ldof + d0 * 32 + r32) = o[d0][r] * rli[r]; }
        if (hi == 0) *(GAS float*)(Lse + (long)(wid * 32 + r32) * ldl) = m_reg * SCALE + __logf(l_reg);
    } else {
        bf16_t* Ow = Ob + (long)(wid * 32) * ldo;
#pragma unroll
        for (int r = 0; r < 16; ++r) { const int orow = crow(r, hi);
#pragma unroll
            for (int d0 = 0; d0 < 4; ++d0) *(GAS bf16_t*)(Ow + (long)orow * ldo + d0 * 32 + r32) = (bf16_t)(cvtpk(o[d0][r] * rli[r], 0.f) & 0xffffu); }
    }
    __syncthreads();
#undef ROWK
#undef SLOAD
#undef SWRITE
#undef SWAIT
#undef RESC
#undef QKT
#undef MASK
#undef ACT
#undef QKM
#undef PVA
}
}

__device__ __forceinline__ float wave_sum(float v, int lane) {
#pragma unroll
    for (int o = 1; o < 64; o <<= 1) v += shx(v, lane, o);
    return v;
}
__device__ __forceinline__ unsigned f2bf(float f) { unsigned u = __float_as_uint(f); return (u + 0x7fffu + ((u >> 16) & 1u)) >> 16; }
__device__ __forceinline__ unsigned pk2(float lo, float hi) { return f2bf(lo) | (f2bf(hi) << 16); }
__device__ __forceinline__ float bfbits2f(unsigned h) { return __uint_as_float(h << 16); }

__device__ __forceinline__ int src_col(int mat, int n) {
    if (mat == 0) { if (n >= 1024 && n < 1088) { const int p = n - 1024, j = p >> 3, e = p & 7; return 1024 + ((e < 4) ? (4 * j + e) : (32 + 4 * j + (e - 4))); }
        return n < 1088 ? n : (n < 1280 ? -1 : n - 192); }
    if (mat == 1) { if (n < 1536) { return (n >> 7) * 192 + (n & 127); }
        const int cc = n - 1536, h = cc >> 6, p = cc & 63, j = p >> 3, e = p & 7; const int orig = (e < 4) ? (4 * j + e) : (32 + 4 * j + (e - 4)); return h * 192 + 128 + orig; }
    return n;
}
__device__ __forceinline__ void transpose_item(const float* W, int K, int Nsrc, int Ndst, bf16_t* WT, int mat, LAS float* scr, int item, int lane, const float* kscale = nullptr, int ldw = 0, int koff = 0) {
    if (ldw == 0) ldw = K;
    const int nblk = Ndst / 32, kb = item / nblk, nb = item % nblk, k0 = 64 * kb, n0 = 32 * nb;
    const int sc = src_col(mat, n0 + (lane & 31));
#pragma unroll 8
    for (int i = 0; i < 32; ++i) { const int kk = 2 * i + (lane >> 5); float wv = (sc >= 0) ? W[(size_t)(k0 + kk) * Nsrc + sc] : 0.f; if (kscale) wv *= kscale[k0 + kk]; scr[kk * 33 + (lane & 31)] = wv; }
    asm volatile("s_waitcnt lgkmcnt(0)" ::: "memory");
    const int c = lane & 7;
#pragma unroll
    for (int j = 0; j < 4; ++j) { const int n = (lane >> 3) + 8 * j; const LAS float* s = scr + (8 * c) * 33 + n;
        u32x4 o; o.x = pk2(s[0 * 33], s[1 * 33]); o.y = pk2(s[2 * 33], s[3 * 33]); o.z = pk2(s[4 * 33], s[5 * 33]); o.w = pk2(s[6 * 33], s[7 * 33]);
        *(u32x4*)(WT + (size_t)(n0 + n) * ldw + koff + k0 + 8 * c) = o; }
    asm volatile("s_waitcnt lgkmcnt(0)" ::: "memory");
}
__device__ __forceinline__ void norm_row_bf16(const float* xrow, const float* g, bf16_t* orow, int lane) {
    const f32x4* xr = (const f32x4*)xrow + lane; f32x4 v[8]; float s = 0.f;
#pragma unroll
    for (int j = 0; j < 8; ++j) { v[j] = xr[64 * j]; s += (v[j].x * v[j].x + v[j].y * v[j].y) + (v[j].z * v[j].z + v[j].w * v[j].w); }
    const float rstd = rsqrtf(wave_sum(s, lane) * (1.f / 2048.f) + EPS);
    const f32x4* gr = (const f32x4*)g + lane; u32x2* o8 = (u32x2*)orow + lane;
#pragma unroll
    for (int j = 0; j < 8; ++j) { const f32x4 gg = gr[64 * j]; u32x2 w; w.x = pk2(v[j].x * rstd * gg.x, v[j].y * rstd * gg.y); w.y = pk2(v[j].z * rstd * gg.z, v[j].w * rstd * gg.w); o8[64 * j] = w; }
}
__device__ __forceinline__ void norm_row_f32(float* xrow, const float* g, int lane) {
    f32x4* xr = (f32x4*)xrow + lane; f32x4 v[8]; float s = 0.f;
#pragma unroll
    for (int j = 0; j < 8; ++j) { v[j] = xr[64 * j]; s += (v[j].x * v[j].x + v[j].y * v[j].y) + (v[j].z * v[j].z + v[j].w * v[j].w); }
    const float rstd = rsqrtf(wave_sum(s, lane) * (1.f / 2048.f) + EPS);
    const f32x4* gr = (const f32x4*)g + lane;
#pragma unroll
    for (int j = 0; j < 8; ++j) { const f32x4 gg = gr[64 * j]; xr[64 * j] = v[j] * rstd * gg; }
}


#define XB_TMO      128
#define XB_XCNT(j)  (256  + 64 * (j))
#define XB_XSUB(j)  (1280 + 64 * (j))
#define XB_XGEN(j)  (2304 + 64 * (j))
#define XB_TOP      3328
#define XB_TOPGEN   3392
#define XCD_BAR_WORDS 3456
#define XB_SPIN_CAP (1u << 18)
__device__ __forceinline__ unsigned xb_ld(unsigned* p)              { return __hip_atomic_load(p, __ATOMIC_RELAXED, __HIP_MEMORY_SCOPE_AGENT); }
__device__ __forceinline__ unsigned xb_add(unsigned* p, unsigned v) { return __hip_atomic_fetch_add(p, v, __ATOMIC_RELAXED, __HIP_MEMORY_SCOPE_AGENT); }
__device__ __forceinline__ unsigned xb_xcc_id() { return (unsigned)__builtin_amdgcn_s_getreg((3 << 11) | 20) & 0xFu; }
#define XB_SPIN(cond, bar) do { unsigned _sp = 0; while (cond) { __builtin_amdgcn_s_sleep(1); \
    if ((++_sp & 255u) == 0u) { if (xb_ld(&(bar)[XB_TMO])) break; if (_sp > XB_SPIN_CAP) { atomicAdd(&(bar)[XB_TMO], 1u); break; } } } } while (0)
struct XcdBarrier { unsigned* bar; unsigned x; volatile LAS unsigned* st; };
__device__ __forceinline__ void xcd_barrier_complete(unsigned* bar, unsigned x, unsigned& nloc, unsigned& nx) {
    const unsigned G = gridDim.x * gridDim.y * gridDim.z;
    unsigned sum, cnt, mine, sp = 0u;
    for (;;) {
        sum = 0u; cnt = 0u; mine = 0u;
#pragma unroll
        for (unsigned j = 0; j < 16; ++j) { const unsigned c = xb_ld(&bar[XB_XCNT(j)]); sum += c; cnt += (c > 0u) ? 1u : 0u; mine = (j == x) ? c : mine; }
        if (sum == G) break;
        __builtin_amdgcn_s_sleep(1);
        if ((++sp & 255u) == 0u) { if (xb_ld(&bar[XB_TMO])) break; if (sp > XB_SPIN_CAP) { atomicAdd(&bar[XB_TMO], 1u); break; } }
    }
    nloc = mine > 0u ? mine : 1u; nx = cnt > 0u ? cnt : 1u;
}
__device__ __forceinline__ void xcd_barrier(const XcdBarrier& b, const bool leader_thread) {
    asm volatile("s_waitcnt vmcnt(0)" ::: "memory");
    __syncthreads();
    if (leader_thread) {
        unsigned* bar = b.bar;
        __builtin_amdgcn_s_waitcnt(0);
        unsigned nloc = b.st[0], nx = b.st[1];
        if (nloc == 0u) { xcd_barrier_complete(bar, b.x, nloc, nx); b.st[0] = nloc; b.st[1] = nx; }
        const unsigned old = xb_add(&bar[XB_XSUB(b.x)], 1u);
        const unsigned gen = old / nloc;
        if (old + 1u == (gen + 1u) * nloc) {
            __builtin_amdgcn_fence(__ATOMIC_RELEASE, "agent");
            asm volatile("s_waitcnt vmcnt(0)" ::: "memory");
            const unsigned og = xb_add(&bar[XB_TOP], 1u);
            const unsigned tg = og / nx;
            if (og + 1u == (tg + 1u) * nx) xb_add(&bar[XB_TOPGEN], 1u);
            else XB_SPIN(xb_ld(&bar[XB_TOPGEN]) == tg, bar);
            __builtin_amdgcn_fence(__ATOMIC_ACQUIRE, "agent");
            xb_add(&bar[XB_XGEN(b.x)], 1u);
            asm volatile("s_waitcnt vmcnt(0)" ::: "memory");
        } else {
            XB_SPIN(xb_ld(&bar[XB_XGEN(b.x)]) == gen, bar);
            __builtin_amdgcn_fence(__ATOMIC_ACQUIRE, "agent");
            asm volatile("s_waitcnt vmcnt(0)" ::: "memory");
        }
    }
    __syncthreads();
}

__global__ void __launch_bounds__(512, 2) fwd_megakernel(Params P) {
    extern __shared__ __attribute__((aligned(16))) unsigned char lds[];
    cg::grid_group grid = cg::this_grid();
    const int G = gridDim.x, bx = blockIdx.x, NGW = G * 8;
    const int wv_s = __builtin_amdgcn_readfirstlane((int)threadIdx.x >> 6);
    XcdBarrier xbar;
    {   volatile LAS unsigned* st = (volatile LAS unsigned*)((LAS unsigned char*)lds + 131072);
        if (threadIdx.x < 2) st[threadIdx.x] = 0u;
        __syncthreads();
        xbar.bar = (unsigned*)(P.ws + WS_BAR); xbar.x = xb_xcc_id(); xbar.st = st;
        if (threadIdx.x == 0) (void)xb_add(&xbar.bar[XB_XCNT(xbar.x)], 1u); }
#define GSYNC() xcd_barrier(xbar, opaque_tid(wv_s) == 0)
#define OPQ() const int tid_ = opaque_tid(wv_s); const int tid = tid_, lane = tid & 63, wave = __builtin_amdgcn_readfirstlane(tid >> 6), gw = bx * 8 + wave; (void)tid; (void)lane; (void)gw; WSP()
    LAS unsigned char* ldsl = (LAS unsigned char*)lds;
#define WSP() unsigned char* ws = P.ws; asm volatile("" : "+s"(ws))
#define ROPE ((const f32x2*)(ws + WS_ROPE))
#define BIAS ((float*)(ws + WS_BIAS))
#define WIN ((bf16_t*)(ws + WS_WIN))
#define WUQ ((bf16_t*)(ws + WS_WUQ))
#define WUKV ((bf16_t*)(ws + WS_WUKV))
#define WMKV ((bf16_t*)(ws + WS_WMKV))
#define WBCAT ((bf16_t*)(ws + WS_WBM))
#define WBD ((bf16_t*)(ws + WS_WBD))
#define WBX ((bf16_t*)(ws + WS_WBX))
#define WOUT ((bf16_t*)(ws + WS_WOUT))
#define WUP ((bf16_t*)(ws + WS_WUP))
#define WDN ((bf16_t*)(ws + WS_WDN))
#define MEMN ((bf16_t*)(ws + WS_MEMN))
#define MEMKV ((bf16_t*)(ws + WS_MEMKV))
#define H ((bf16_t*)(ws + WS_H))
#define PROJ ((bf16_t*)(ws + WS_PROJ))
#define UPACT ((bf16_t*)(ws + WS_PROJ))
#define CQ ((bf16_t*)(ws + WS_CQ))
#define CKV ((bf16_t*)(ws + WS_CKV))
#define KPE ((bf16_t*)(ws + WS_KPE))
#define QB ((bf16_t*)(ws + WS_Q))
#define KVB ((bf16_t*)(ws + WS_KV))
#define OCAT ((bf16_t*)(ws + WS_OMLA))
#define ODG ((float*)(ws + WS_ODG))
#define LSEB ((float*)(ws + WS_LSE))
#define ODIL ((bf16_t*)(ws + WS_ODIL))
#define OMEM ((bf16_t*)(ws + WS_OMEM))
#define TMP ((float*)(ws + WS_TMP))
#define MERG ((bf16_t*)(ws + WS_MERG))
#define SSQ ((float*)(ws + WS_SSQ))
#define SSQ2 ((float*)(ws + WS_SSQ2))
#define MLP ((float*)(ws + WS_MLP))
#define MLSE ((float*)(ws + WS_MLSE))
#define HN1 ((bf16_t*)(ws + WS_HN1))
#define HX ((bf16_t*)(ws + WS_HX))
#define SSQ3 ((float*)(ws + WS_SSQ3))
#define PCNT ((unsigned*)(ws + WS_PCNT))

    {
        OPQ();
        LAS float* scr = (LAS float*)(ldsl + wave * 16384);
        constexpr int I0 = 32 * (NPROJ / 32), I1 = 8 * (NQ / 32), I2 = 8 * (NKV / 32), I3 = 32 * 64, I4 = 24 * 64, I5 = 8 * 64, I6 = 16 * 64, I7 = 32 * 64, I8 = 32 * 256, I9 = 128 * 64;
        constexpr int NITEMS = I0 + I1 + I2 + I3 + I4 + I5 + I6 + I7 + I8 + I9;
        for (int it = gw; it < NITEMS; it += NGW) {
            int r = it;
            if (r < I0) { transpose_item(P.in[6], 2048, 12864, NPROJ, WIN, 0, scr, r, lane); continue; } r -= I0;
            if (r < I1) { transpose_item(P.in[8], 512, NQ, NQ, WUQ, 1, scr, r, lane, P.in[7]); continue; } r -= I1;
            if (r < I2) { transpose_item(P.in[10], 512, NKV, NKV, WUKV, 2, scr, r, lane, P.in[9]); continue; } r -= I2;
            if (r < I3) { transpose_item(P.in[12], 2048, 2048, 2048, WMKV, 2, scr, r, lane); continue; } r -= I3;
            if (r < I4) { transpose_item(P.in[13], 1536, 2048, 2048, WBCAT, 2, scr, r, lane, nullptr, 3072, 0); continue; } r -= I4;
            if (r < I5) { transpose_item(P.in[14], 512, 2048, 2048, WBCAT, 2, scr, r, lane, nullptr, 3072, 1536); continue; } r -= I5;
            if (r < I6) { transpose_item(P.in[15], 1024, 2048, 2048, WBCAT, 2, scr, r, lane, nullptr, 3072, 2048); continue; } r -= I6;
            if (r < I7) { transpose_item(P.in[16], 2048, 2048, 2048, WOUT, 2, scr, r, lane); continue; } r -= I7;
            if (r < I8) { transpose_item(P.in[18], 2048, 8192, 8192, WUP, 2, scr, r, lane, P.in[17]); continue; } r -= I8;
            transpose_item(P.in[19], 8192, 2048, 2048, WDN, 2, scr, r, lane);
        }
        for (int idx = bx * 512 + tid; idx < 8192 * 32; idx += G * 512) {
            const int pos = idx >> 5, i = idx & 31; const float ang = (float)pos * P.inv[i];
            float t = ang * 0.15915494309189535f; t = t - floorf(t);
            const float rr = (t > 0.5f ? t - 1.f : t) * 6.283185307179586f;
            ((f32x2*)(ws + WS_ROPE))[idx] = (f32x2){__cosf(rr), __sinf(rr)};
        }
        for (int idx = bx * 512 + tid; idx < 12 * 129; idx += G * 512) {
            const int gh = idx / 129, k = idx % 129, g = gh >> 2;
            BIAS[idx] = P.in[4][(int)P.bkt[g][k] * 12 + gh] * 11.313708498984761f;
        }
        for (int m = gw; m < MC; m += NGW) { norm_row_bf16(P.in[0] + (size_t)m * DM, P.in[5], H + (size_t)m * DM, lane); if (lane < 2) SSQ[m * 2 + lane] = 0.f; }
        for (int m = gw; m < NMEMROWS; m += NGW) {
            const float* src = (m < 512) ? P.in[2] + (size_t)m * DM : P.in[3] + (size_t)(m - 512) * DM;
            norm_row_bf16(src, P.in[11], MEMN + (size_t)m * DM, lane);
        }
    }
    grid.sync();

    for (int ch = 0; ch < NCHUNK; ++ch) {
        const float* xin = (ch < 2) ? P.in[0] + (size_t)ch * MC * DM : P.in[1] + (size_t)(ch - 2) * MC * DM;
        float* xout = P.out + (size_t)ch * MC * DM;
        const int S = (ch < 2) ? 8192 : 4096;
        if ((PH & 8) && ch == 0) { WSP(); pg8::Gemm g{MEMN, WMKV, NMEMROWS, 2048, 2048, 2048}; pg8::StaticOrder So; So.init(NMEMROWS, 2048, G, G - 1 - bx);
            pg8::EpiStore<0, false> E{MEMKV, 2048, nullptr, 0, 0.f}; pg8::gemm_phase(ldsl, g, So, E, wv_s); }
        if (PH & 8) { WSP(); pg8::Gemm g{(ch & 1) ? HN1 : H, WIN, MC, NPROJ, 2048, 2048}; pg8::StaticOrder So; So.init(MC, NPROJ, G, bx);
          pg8::EpiProj E{PROJ, SSQ, KPE, ROPE, S - 1}; pg8::gemm_phase(ldsl, g, So, E, wv_s); }
        if (ch + 1 < NCHUNK) {
            const int nfull = (MC / 256) * (NPROJ / 256) - 6 * G, nfill = G - nfull;
            if (nfull >= 0 && nfill > 0 && bx >= nfull) { OPQ();
                const float* xn = (ch + 1 < 2) ? P.in[0] + (size_t)(ch + 1) * MC * DM : P.in[1] + (size_t)(ch - 1) * MC * DM; bf16_t* hn = ((ch + 1) & 1) ? HN1 : H;
                for (int m = (bx - nfull) * 8 + wave; m < MC; m += nfill * 8) norm_row_bf16(xn + (size_t)m * DM, P.in[5], hn + (size_t)m * DM, lane); }
            else if (nfull < 0 || nfill <= 0) { OPQ();
                const float* xn = (ch + 1 < 2) ? P.in[0] + (size_t)(ch + 1) * MC * DM : P.in[1] + (size_t)(ch - 1) * MC * DM; bf16_t* hn = ((ch + 1) & 1) ? HN1 : H;
                for (int m = gw; m < MC; m += NGW) norm_row_bf16(xn + (size_t)m * DM, P.in[5], hn + (size_t)m * DM, lane); } }
        GSYNC();
        if (PH & 16) { WSP(); pg8::Gemm g{PROJ + OFF_CQ, WUQ, MC, NQ, 512, NPROJ}; pg8::StaticOrder So; So.init(MC, NQ, G, bx);
          pg8::EpiQRope E{QB, ROPE, S - 1, SSQ}; pg8::gemm_phase(ldsl, g, So, E, wv_s); }
        if (PH & 32) { WSP(); pg8::Gemm g{PROJ + OFF_CKV, WUKV, MC, NKV, 512, NPROJ}; pg8::StaticOrder So; So.init(MC, NKV, G, (bx + 128) % G);
          pg8::EpiStore<0, true> E{KVB, NKV, SSQ + 1, 2, 1.f / 512.f}; pg8::gemm_phase(ldsl, g, So, E, wv_s); }
        GSYNC();
        for (int it_ = 0; it_ * G < 1152; ++it_) {
            int u = bx + it_ * G;
            if (G == 256 && it_ == 4) { if (bx < 128) continue; u = 1024 + bx - 128; }
            if (u >= 1152) continue;
            OPQ();
            if ((PH & 1) && u < 256) {
                const int h = u & 7, qb = u >> 3, rowq = qb * 256, seqbase = (rowq / S) * S;
                att::attn_unit<64, true, false, false>(QB + (size_t)rowq * NQ + h * 192, NQ, KVB + (size_t)seqbase * NKV + h * 256, KVB + (size_t)seqbase * NKV + h * 256 + 128, NKV,
                    KPE + (size_t)seqbase * 64, 64, S / 64, 0.07216878364870322f, OCAT + (size_t)rowq * 3072 + h * 128, 3072, nullptr, 0, nullptr, 0, 0, 0, nullptr, (char*)lds, wv_s);
            } else if ((PH & 1) && u >= 256 && u < 512) {
                const int v = u - 256, half = v & 1, h4 = (v & 7) >> 1, h = 8 + h4, qb = v >> 3, rowq = qb * 256, seqbase = (rowq / S) * S, kr0 = seqbase + half * (S / 2);
                att::attn_unit<64, true, false, true>(QB + (size_t)rowq * NQ + h * 192, NQ, KVB + (size_t)kr0 * NKV + h * 256, KVB + (size_t)kr0 * NKV + h * 256 + 128, NKV,
                    KPE + (size_t)kr0 * 64, 64, S / 128, 0.07216878364870322f, nullptr, 0, MLP + ((size_t)half * MC + rowq) * 512 + h4 * 128, 512,
                    MLSE + ((size_t)half * MC + rowq) * 4 + h4, 4, 0, 0, nullptr, (char*)lds, wv_s);
            } else if ((PH & 2) && u >= 512 && u < 896) {
                const int v = u - 512, g = v >> 7, w = v & 127, hh = w >> 5, x = w & 31;
                const int per = S / 256, sq = x / per, y = x % per, r = (g == 0) ? 1 : (g == 1 ? 4 : 16), nblk = per / r, c = y / nblk, qb = y % nblk;
                const int seqbase = sq * S, ssub = S / r, q0 = qb * 256;
                float* bl = (float*)(lds + LDS_BIAS_OFF);
                if (tid < 129) bl[tid] = BIAS[(g * 4 + hh) * 129 + tid];
                __syncthreads();
                const size_t tok0 = (size_t)seqbase + c;
                const bf16_t* kb = PROJ + tok0 * NPROJ + OFF_DIL + 1536 + g * 512 + hh * 128;
                att::attn_unit<0, false, true, true>(PROJ + (tok0 + (size_t)r * q0) * NPROJ + OFF_DIL + g * 512 + hh * 128, (long)r * NPROJ, kb, kb + 1536, (long)r * NPROJ,
                    nullptr, 0, 6, 0.08838834764831845f, nullptr, 0, ODG + ((size_t)g * MC + tok0 + (size_t)r * q0) * 512 + hh * 128, (long)r * 512,
                    LSEB + ((size_t)g * MC + tok0 + (size_t)r * q0) * 4 + hh, (long)r * 4, q0, ssub, bl, (char*)lds, wv_s);
            } else if ((PH & 4) && u >= 896) {
                const int v = u - 896, vh = v & 1, w = v >> 1, h = w >> 5, qb = w & 31, rowq = qb * 256;
                const int bg = (ch < 2) ? ch : 2 + (ch - 2) * 2 + rowq / 4096;
                const bf16_t* kb = MEMKV + (size_t)bg * 256 * 2048 + h * 256;
                att::attn_unit<128, false, false, false>(PROJ + (size_t)rowq * NPROJ + OFF_XQ + h * 256, NPROJ, kb, kb + 1024 + vh * 128, 2048, kb + 128, 2048, 4, 0.0625f,
                    OCAT + (size_t)rowq * 3072 + 2048 + h * 256 + vh * 128, 3072, nullptr, 0, nullptr, 0, 0, 0, nullptr, (char*)lds, wv_s);
            }
        }
        GSYNC();
        { OPQ();
        for (int m = gw; m < MC; m += NGW) {
            const int hh = lane >> 4; float l[3], wgt[3];
            if (lane < 2) SSQ[m * 2 + lane] = 0.f; if (lane == 2) SSQ2[m] = 0.f; if (lane == 3) SSQ3[m] = 0.f; if (lane == 4 && m < 32) PCNT[64 * m] = 0u;
#pragma unroll
            for (int g = 0; g < 3; ++g) l[g] = LSEB[((size_t)g * MC + m) * 4 + hh];
            const float mx = fmaxf(l[0], fmaxf(l[1], l[2])); float sum = 0.f;
#pragma unroll
            for (int g = 0; g < 3; ++g) { wgt[g] = __expf(l[g] - mx); sum += wgt[g]; }
            const float inv = 1.f / sum; f32x4 a0 = {0.f, 0.f, 0.f, 0.f}, a1 = {0.f, 0.f, 0.f, 0.f};
#pragma unroll
            for (int g = 0; g < 3; ++g) { const f32x4* op = (const f32x4*)(ODG + ((size_t)g * MC + m) * 512) + 2 * lane; a0 += op[0] * (wgt[g] * inv); a1 += op[1] * (wgt[g] * inv); }
            u32x4 o; o.x = pk2(a0.x, a0.y); o.y = pk2(a0.z, a0.w); o.z = pk2(a1.x, a1.y); o.w = pk2(a1.z, a1.w);
            *((u32x4*)(OCAT + (size_t)m * 3072 + 1536) + lane) = o;
            {
                const float l0 = MLSE[((size_t)0 * MC + m) * 4 + hh], l1 = MLSE[((size_t)1 * MC + m) * 4 + hh]; const float mx2 = fmaxf(l0, l1);
                const float w0 = __expf(l0 - mx2), w1 = __expf(l1 - mx2), iv = 1.f / (w0 + w1);
                const f32x4* p0 = (const f32x4*)(MLP + ((size_t)0 * MC + m) * 512) + 2 * lane; const f32x4* p1 = (const f32x4*)(MLP + ((size_t)1 * MC + m) * 512) + 2 * lane;
                const f32x4 b0 = p0[0] * (w0 * iv) + p1[0] * (w1 * iv), b1 = p0[1] * (w0 * iv) + p1[1] * (w1 * iv);
                u32x4 o2; o2.x = pk2(b0.x, b0.y); o2.y = pk2(b0.z, b0.w); o2.z = pk2(b1.x, b1.y); o2.w = pk2(b1.z, b1.w);
                *((u32x4*)(OCAT + (size_t)m * 3072 + 1024) + lane) = o2; }
        } }
        GSYNC();
        if (PH & 64) { WSP(); pg8::Gemm g{OCAT, WBCAT, MC, 2048, 3072, 3072}; pg8::StaticOrder So; So.init(MC, 2048, G, bx);
          pg8::EpiBranch E{PROJ + OFF_GATE, MERG}; pg8::gemm_phase(ldsl, g, So, E, wv_s); }
        GSYNC();
        if (PH & 512) { WSP(); pg8::Gemm g{MERG, WOUT, MC, 2048, 2048, 2048}; pg8::StaticOrder So; So.init(MC, 2048, G, bx);
          pg8::EpiResid<true> E{xin, xout, HX, SSQ2}; pg8::gemm_phase(ldsl, g, So, E, wv_s); }
        GSYNC();
        for (int rep_ = 0; rep_ < ((DBL & 2) ? 2 : 1); ++rep_)
        if (PH & 1024) { WSP(); pg8::Gemm g{HX, WUP, MC, DFF, 2048, 2048}; pg8::StaticOrder So; So.init(MC, DFF, G, bx);
          pg8::EpiStore<1, true> E{UPACT, DFF, SSQ2, 1, 1.f / 2048.f}; pg8::gemm_phase(ldsl, g, So, E, wv_s); }
        GSYNC();
        if (G == 256) {
            WSP(); pg8::Gemm g{UPACT, WDN, MC, 2048, DFF, DFF}; pg8::StaticOrder So; So.init(MC, 2048, G, bx);
            pg8::EpiFinal E{xout, xout, P.in[20], SSQ3, PCNT}; pg8::gemm_phase(ldsl, g, So, E, wv_s);
            GSYNC();
        } else {
            { WSP(); pg8::Gemm g{UPACT, WDN, MC, 2048, DFF, DFF}; pg8::StaticOrder So; So.init(MC, 2048, G, bx);
              pg8::EpiResid<false> E{xout, xout, nullptr, nullptr}; pg8::gemm_phase(ldsl, g, So, E, wv_s); }
            GSYNC();
            { OPQ(); for (int m = gw; m < MC; m += NGW) norm_row_f32(xout + (size_t)m * DM, P.in[20], lane); }
            GSYNC();
        }
    }
}

static int t5_bucket_host(int rel) {
    const int nb = 16; int ret = (rel > 0) ? nb : 0; const int n = rel < 0 ? -rel : rel; const int max_exact = nb / 2;
    int large = max_exact + (int)(std::log((double)(n > 1 ? n : 1) / max_exact) / std::log(1024.0 / max_exact) * (nb - max_exact));
    if (large > nb - 1) large = nb - 1;
    return ret + (n < max_exact ? n : large);
}
extern "C" void kernel_launch(void* const* d_in, const int* in_sizes, int n_in, void* d_out, int out_size, void* d_ws, size_t ws_size, hipStream_t stream) {
    static int grid = 0;
    if (grid == 0) {
        if (n_in != 21 || ws_size < WS_END) { fprintf(stderr, "kernel_launch: n_in %d ws %zu (need %zu)\n", n_in, ws_size, (size_t)WS_END); grid = -1; return; }
        int dev = 0, cus = 0, per_cu = 0;
        hipGetDevice(&dev); hipDeviceGetAttribute(&cus, hipDeviceAttributeMultiprocessorCount, dev);
        hipFuncSetAttribute((const void*)fwd_megakernel, hipFuncAttributeMaxDynamicSharedMemorySize, LDS_BYTES);
        hipOccupancyMaxActiveBlocksPerMultiprocessor(&per_cu, (const void*)fwd_megakernel, 512, LDS_BYTES);
        if (per_cu < 1) per_cu = 1;
        grid = cus * 1;
        (void)hipGetLastError();
    }
    if (grid < 0) return;
    Params p{};
    for (int i = 0; i < 21; ++i) p.in[i] = (const float*)d_in[i];
    p.out = (float*)d_out; p.ws = (unsigned char*)d_ws;
    for (int i = 0; i < 32; ++i) p.inv[i] = 1.0f / powf(10000.0f, (float)i / 32.0f);
    const int dil[3] = {1, 4, 16};
    for (int g = 0; g < 3; ++g) for (int k = 0; k < 129; ++k) p.bkt[g][k] = (unsigned char)t5_bucket_host((k - 64) * dil[g]);
    (void)hipMemsetAsync((char*)d_ws + WS_BAR, 0, 16384, stream);
    void* args[] = {&p};
    hipError_t e = hipLaunchCooperativeKernel((const void*)fwd_megakernel, dim3(grid), dim3(512), args, LDS_BYTES, stream);
    if (e != hipSuccess) fprintf(stderr, "cooperative launch failed: %s (grid %d)\n", hipGetErrorString(e), grid);
}
```

```cpp
#include <hip/hip_runtime.h>
#include <hip/hip_cooperative_groups.h>
#include <cstdio>
#include <cstdint>
#include <cmath>
namespace cg = cooperative_groups;
#ifndef PH
#define PH 0xffff
#endif
#ifndef DBL
#define DBL 0
#endif

#define LAS __attribute__((address_space(3)))
#define GAS __attribute__((address_space(1)))
typedef unsigned short bf16_t;
typedef short bf16x8 __attribute__((ext_vector_type(8)));
typedef short s16x4 __attribute__((ext_vector_type(4)));
typedef float f32x4 __attribute__((ext_vector_type(4)));
typedef float f32x2 __attribute__((ext_vector_type(2)));
typedef float f32x16 __attribute__((ext_vector_type(16)));
typedef unsigned u32x4 __attribute__((ext_vector_type(4)));
typedef unsigned u32x2 __attribute__((ext_vector_type(2)));

__device__ __forceinline__ float shx(float v, int lane, int mask) { return __int_as_float(__builtin_amdgcn_ds_bpermute((lane ^ mask) << 2, __float_as_int(v))); }
__device__ __forceinline__ int opaque_tid(int wv) { int l; asm volatile("v_mbcnt_lo_u32_b32 %0, -1, 0\n\tv_mbcnt_hi_u32_b32 %0, -1, %0" : "=v"(l)); return wv * 64 + l; }
constexpr int DM = 2048, MC = 8192, NCHUNK = 6, DFF = 8192;
constexpr int NPROJ = 13056;
constexpr int OFF_CQ = 0, OFF_CKV = 512, OFF_KR = 1024, OFF_DIL = 1280, OFF_XQ = 5888, OFF_GATE = 6912;
constexpr int NQ = 2304, NKV = 3072;
constexpr int NMEMROWS = 2560;
constexpr float EPS = 1e-6f;

constexpr size_t WS_CTL  = 0;
constexpr size_t WS_ROPE = 4096;
constexpr size_t WS_BIAS = WS_ROPE + (size_t)8192 * 32 * 8;
constexpr size_t WS_WIN  = WS_BIAS + 8192;
constexpr size_t WS_WUQ  = WS_WIN  + (size_t)NPROJ * 2048 * 2;
constexpr size_t WS_WUKV = WS_WUQ  + (size_t)NQ * 512 * 2;
constexpr size_t WS_WMKV = WS_WUKV + (size_t)NKV * 512 * 2;
constexpr size_t WS_WBM  = WS_WMKV + (size_t)2048 * 2048 * 2;
constexpr size_t WS_WBD  = WS_WBM  + (size_t)2048 * 1536 * 2;
constexpr size_t WS_WBX  = WS_WBD  + (size_t)2048 * 512 * 2;
constexpr size_t WS_WOUT = WS_WBX  + (size_t)2048 * 1024 * 2;
constexpr size_t WS_WUP  = WS_WOUT + (size_t)2048 * 2048 * 2;
constexpr size_t WS_WDN  = WS_WUP  + (size_t)8192 * 2048 * 2;
constexpr size_t WS_MEMN = WS_WDN  + (size_t)2048 * 8192 * 2;
constexpr size_t WS_MEMKV= WS_MEMN + (size_t)NMEMROWS * 2048 * 2;
constexpr size_t WS_H    = WS_MEMKV+ (size_t)NMEMROWS * 2048 * 2;
constexpr size_t WS_PROJ = WS_H    + (size_t)4 * MC * 2048 * 2;
constexpr size_t WS_KPE  = WS_PROJ + (size_t)2 * MC * NPROJ * 2;
constexpr size_t WS_Q    = WS_KPE  + (size_t)2 * MC * 64 * 2;
constexpr size_t WS_KV   = WS_Q    + (size_t)MC * NQ * 2;
constexpr size_t WS_OMLA = WS_KV   + (size_t)MC * NKV * 2;
constexpr size_t WS_ODG  = WS_OMLA + (size_t)MC * 3072 * 2;
constexpr size_t WS_LSE  = WS_ODG  + (size_t)3 * MC * 512 * 4;
constexpr size_t WS_MERG = WS_LSE  + (size_t)3 * MC * 4 * 4;
constexpr size_t WS_SSQ  = WS_MERG + (size_t)MC * 2048 * 2;
constexpr size_t WS_SSQ2 = WS_SSQ  + (size_t)2 * MC * 2 * 4;
constexpr size_t WS_MLP  = WS_SSQ2 + (size_t)MC * 4;
constexpr size_t WS_MLSE = WS_MLP  + (size_t)2 * MC * 512 * 4;
constexpr size_t WS_HX   = WS_MLSE + (size_t)2 * MC * 4 * 4;
constexpr size_t WS_SSQ3 = WS_HX   + (size_t)MC * 2048 * 2;
constexpr size_t WS_PCNT = WS_SSQ3 + (size_t)MC * 4;
constexpr size_t WS_BAR  = WS_PCNT + 32 * 64 * 4;
constexpr size_t WS_END  = WS_BAR + 16384;
static_assert(WS_END <= (size_t)1020 * 1024 * 1024, "workspace map must stay under 1 GiB");

constexpr int LDS_BYTES = 131072 + 1024;
constexpr int LDS_BIAS_OFF = 126976;

struct Params {
    const float* in[21]; float* out; unsigned char* ws;
    float inv[32];
    unsigned char bkt[3][132];
    int pad;
};

namespace pg8 {
constexpr int BM = 256, BK = 64, HALF = 128, HTB = HALF * BK * 2, STAGE_BYTES = 8 * HTB, NXCD = 8, WGM = 8;
__host__ __device__ __forceinline__ int lds_byte(int r, int c) { const int st = (r >> 4) * 2 + (c >> 5), rr = r & 15, cc = c & 31, ob = rr * 64 + cc * 2; return st * 1024 + (ob ^ (((ob >> 9) & 1) << 5)); }
__host__ __device__ __forceinline__ void stage_rc(int b, int& R, int& C) { const int st = b / 1024, sb = b % 1024, swz = sb ^ (((sb >> 9) & 1) << 5); R = (st >> 1) * 16 + swz / 64; C = (st & 1) * 32 + (swz % 64) / 2; }
__host__ __device__ __forceinline__ int perm32(int rho) { const int n = rho >> 4, i = rho & 15; return 8 * (i >> 2) + 4 * n + (i & 3); }
struct Unit { int pm, pn; };
struct Gemm { const bf16_t* A; const bf16_t* Bt; int M, N, K, lda; };
struct StaticOrder {
    int nM, nN, nwg, G, c;
    __host__ __device__ void init(int M, int N, int G_, int c_) { nM = M / BM; nN = N / BM; nwg = nM * nN; G = G_; c = c_; }
    __host__ __device__ bool next(int i, Unit& u) const {
        const long L = (long)i * G + c; if (L >= nwg) return false;
        int wgid = (int)L; { const int q = nwg / NXCD, r = nwg % NXCD, xcd = wgid % NXCD, off = wgid / NXCD; wgid = (xcd < r ? xcd * (q + 1) : r * (q + 1) + (xcd - r) * q) + off; }
        const int nig = WGM * nN, gid = wgid / nig, fm = gid * WGM, gsz = (nM - fm) < WGM ? (nM - fm) : WGM;
        u.pm = fm + ((wgid % nig) % gsz); u.pn = (wgid % nig) / gsz; return true;
    }
};
__device__ __forceinline__ unsigned cvt_pk_bf16(float lo, float hi) { unsigned r; asm volatile("v_cvt_pk_bf16_f32 %0, %1, %2" : "=v"(r) : "v"(lo), "v"(hi)); return r; }
__device__ __forceinline__ u32x4 pack8(f32x4 v0, f32x4 v1) { u32x4 w; w.x = cvt_pk_bf16(v0[0], v0[1]); w.y = cvt_pk_bf16(v0[2], v0[3]); w.z = cvt_pk_bf16(v1[0], v1[1]); w.w = cvt_pk_bf16(v1[2], v1[3]); return w; }
__device__ __forceinline__ float bf2f(unsigned short h) { return __uint_as_float(((unsigned)h) << 16); }

__device__ __forceinline__ void st16(bf16_t* p, u32x4 v) { *(GAS u32x4*)p = v; }
__device__ __forceinline__ void stf4(float* p, f32x4 v) { *(GAS f32x4*)p = v; }
__device__ __forceinline__ f32x4 ldf4(const float* p) { return *(const GAS f32x4*)p; }
__device__ __forceinline__ float sq8(f32x4 a, f32x4 b) { return (a[0] * a[0] + a[1] * a[1]) + (a[2] * a[2] + a[3] * a[3]) + (b[0] * b[0] + b[1] * b[1]) + (b[2] * b[2] + b[3] * b[3]); }
template <int ACT  , bool RS> struct EpiStore {
    static constexpr bool PERM = true, HOOK = false;
    bf16_t* O; int ldc; const float* rs; int rss; float invdim;
    __device__ __forceinline__ void operator()(const f32x4 (&acc)[2][2][4][2], const Unit& u, int wr, int wc, int fr, int fq) const {
        const int row0 = u.pm * BM + wr * 64 + fr, col0 = u.pn * BM + wc * 32 + 8 * fq;
#pragma unroll
        for (int ai = 0; ai < 2; ++ai)
#pragma unroll
            for (int m = 0; m < 4; ++m) { const int row = row0 + ai * HALF + m * 16; bf16_t* rowp = O + (size_t)row * ldc + col0;
                float sc = 1.f; if (RS) sc = rsqrtf(*(const GAS float*)(rs + (size_t)row * rss) * invdim + EPS);
#pragma unroll
                for (int bj = 0; bj < 2; ++bj) { f32x4 v0 = acc[ai][bj][m][0], v1 = acc[ai][bj][m][1];
                    if (RS) { v0 *= sc; v1 *= sc; }
                    if (ACT == 1) {
#pragma unroll
                        for (int e = 0; e < 4; ++e) { float a = fmaxf(v0[e], 0.f), b = fmaxf(v1[e], 0.f); v0[e] = a * a; v1[e] = b * b; } }
                    st16(rowp + bj * HALF, pack8(v0, v1)); } }
    }
};
struct EpiProj {
    static constexpr bool PERM = true, HOOK = false;
    bf16_t* O; float* ssq; bf16_t* kpe; const f32x2* rope; int posmask;
    __device__ __forceinline__ void operator()(const f32x4 (&acc)[2][2][4][2], const Unit& u, int wr, int wc, int fr, int fq) const {
        const int row0 = u.pm * BM + wr * 64 + fr, col0 = u.pn * BM + wc * 32 + 8 * fq;
        if (u.pn == 4) {
            if (wc < 2) {
                const int p = wc * 32 + 8 * fq, j = p >> 3;
#pragma unroll
                for (int ai = 0; ai < 2; ++ai)
#pragma unroll
                    for (int m = 0; m < 4; ++m) { const int row = row0 + ai * HALF + m * 16; const int pos = row & posmask;
                        const f32x4 v0 = acc[ai][0][m][0], v1 = acc[ai][0][m][1]; f32x4 o1, o2; const f32x2* rp = rope + (size_t)pos * 32 + 4 * j;
#pragma unroll
                        for (int e = 0; e < 4; ++e) { const f32x2 cs = *(const GAS f32x2*)(rp + e); o1[e] = v0[e] * cs.x - v1[e] * cs.y; o2[e] = v1[e] * cs.x + v0[e] * cs.y; }
                        st16(kpe + (size_t)row * 64 + p, pack8(o1, o2)); }
            }
            return;
        }
#pragma unroll
        for (int ai = 0; ai < 2; ++ai)
#pragma unroll
            for (int m = 0; m < 4; ++m) { const int row = row0 + ai * HALF + m * 16; bf16_t* rowp = O + (size_t)row * NPROJ + col0;
                st16(rowp, pack8(acc[ai][0][m][0], acc[ai][0][m][1])); st16(rowp + HALF, pack8(acc[ai][1][m][0], acc[ai][1][m][1]));
                if (u.pn < 4) { float s = sq8(acc[ai][0][m][0], acc[ai][0][m][1]) + sq8(acc[ai][1][m][0], acc[ai][1][m][1]);
                    { const int ln_ = fq * 16 + fr; s += shx(s, ln_, 16); s += shx(s, ln_, 32); }
                    if (fq == 0) __hip_atomic_fetch_add(ssq + (size_t)row * 2 + (u.pn >> 1), s, __ATOMIC_RELAXED, __HIP_MEMORY_SCOPE_AGENT); } }
    }
};
struct EpiQRope {
    static constexpr bool PERM = true, HOOK = false;
    bf16_t* Q; const f32x2* rope; int posmask; const float* ssq;
    __device__ __forceinline__ void operator()(const f32x4 (&acc)[2][2][4][2], const Unit& u, int wr, int wc, int fr, int fq) const {
        const int row0 = u.pm * BM + wr * 64 + fr, col0 = u.pn * BM + wc * 32 + 8 * fq;
#pragma unroll
        for (int ai = 0; ai < 2; ++ai)
#pragma unroll
            for (int m = 0; m < 4; ++m) { const int row = row0 + ai * HALF + m * 16; const int pos = row & posmask;
                const float sc = rsqrtf(*(const GAS float*)(ssq + (size_t)row * 2) * (1.f / 512.f) + EPS);
#pragma unroll
                for (int bj = 0; bj < 2; ++bj) { const int c = col0 + bj * HALF; const f32x4 v0 = acc[ai][bj][m][0] * sc, v1 = acc[ai][bj][m][1] * sc;
                    if (u.pn < 6) { const int h = c >> 7, d = c & 127; st16(Q + (size_t)row * NQ + h * 192 + d, pack8(v0, v1)); }
                    else { const int cc = c - 1536, h = cc >> 6, p = cc & 63, j = p >> 3; f32x4 o1, o2;
                        const f32x2* rp = rope + (size_t)pos * 32 + 4 * j;
#pragma unroll
                        for (int e = 0; e < 4; ++e) { const f32x2 cs = *(const GAS f32x2*)(rp + e); o1[e] = v0[e] * cs.x - v1[e] * cs.y; o2[e] = v1[e] * cs.x + v0[e] * cs.y; }
                        st16(Q + (size_t)row * NQ + h * 192 + 128 + p, pack8(o1, o2)); } } }
    }
};
template <int MODE  > struct EpiGate {
    static constexpr bool PERM = true, HOOK = false;
    const bf16_t* gate; float* tmp; bf16_t* merged;
    __device__ __forceinline__ void operator()(const f32x4 (&acc)[2][2][4][2], const Unit& u, int wr, int wc, int fr, int fq) const {
        const int row0 = u.pm * BM + wr * 64 + fr, col0 = u.pn * BM + wc * 32 + 8 * fq;
#pragma unroll
        for (int ai = 0; ai < 2; ++ai)
#pragma unroll
            for (int m = 0; m < 4; ++m) { const int row = row0 + ai * HALF + m * 16;
#pragma unroll
                for (int bj = 0; bj < 2; ++bj) { const int c = col0 + bj * HALF;
                    const u32x4 gw = *(const GAS u32x4*)(gate + (size_t)row * NPROJ + c);
                    f32x4 v0 = acc[ai][bj][m][0], v1 = acc[ai][bj][m][1];
#pragma unroll
                    for (int e = 0; e < 4; ++e) {
                        const unsigned w0 = gw[e >> 1], w1 = gw[2 + (e >> 1)];
                        const float g0 = __uint_as_float((e & 1) ? (w0 & 0xffff0000u) : (w0 << 16)), g1 = __uint_as_float((e & 1) ? (w1 & 0xffff0000u) : (w1 << 16));
                        v0[e] *= 1.f / (1.f + __expf(-g0)); v1[e] *= 1.f / (1.f + __expf(-g1)); }
                    float* tp = tmp + (size_t)row * DM + c;
                    if (MODE == 0) { stf4(tp, v0); stf4(tp + 4, v1); }
                    else { v0 += ldf4(tp); v1 += ldf4(tp + 4);
                        if (MODE == 1) { stf4(tp, v0); stf4(tp + 4, v1); }
                        else st16(merged + (size_t)row * DM + c, pack8(v0, v1)); } } }
    }
};
struct EpiBranch {
    static constexpr bool PERM = true, HOOK = true;
    const bf16_t* gate; bf16_t* merged;
    static __device__ __forceinline__ float gsel(const u32x4& w, int i) { const unsigned x = w[i >> 1]; return __uint_as_float((i & 1) ? (x & 0xffff0000u) : (x << 16)); }
    __device__ __forceinline__ void hook(f32x4 (&acc)[2][2][4][2], const Unit& u, int seg, int wr, int wc, int fr, int fq) const {
        const int row0 = u.pm * BM + wr * 64 + fr, col0 = u.pn * BM + wc * 32 + 8 * fq;
        int zero = 0;
#pragma unroll
        for (int ai = 0; ai < 2; ++ai)
#pragma unroll
            for (int m = 0; m < 4; ++m) { const bf16_t* gp = gate + (size_t)(row0 + ai * HALF + m * 16 + zero) * NPROJ + seg * 2048 + col0;
#pragma unroll
                for (int bj = 0; bj < 2; ++bj) { const u32x4 ga = *(const GAS u32x4*)(gp + bj * HALF), gb = *(const GAS u32x4*)(gp + 2048 + bj * HALF);
#pragma unroll
                    for (int e = 0; e < 4; ++e) {
                        acc[ai][bj][m][0][e] *= (1.f + __expf(-gsel(gb, e))) * __builtin_amdgcn_rcpf(1.f + __expf(-gsel(ga, e)));
                        acc[ai][bj][m][1][e] *= (1.f + __expf(-gsel(gb, 4 + e))) * __builtin_amdgcn_rcpf(1.f + __expf(-gsel(ga, 4 + e))); } }
                asm volatile("" : "+v"(zero), "+v"(acc[ai][0][m][0]), "+v"(acc[ai][1][m][1])); }
    }
    __device__ __forceinline__ void operator()(const f32x4 (&acc)[2][2][4][2], const Unit& u, int wr, int wc, int fr, int fq) const {
        const int row0 = u.pm * BM + wr * 64 + fr, col0 = u.pn * BM + wc * 32 + 8 * fq;
#pragma unroll
        for (int ai = 0; ai < 2; ++ai)
#pragma unroll
            for (int m = 0; m < 4; ++m) { const int row = row0 + ai * HALF + m * 16; const bf16_t* gp = gate + (size_t)row * NPROJ + 4096 + col0;
#pragma unroll
                for (int bj = 0; bj < 2; ++bj) { const u32x4 gw = *(const GAS u32x4*)(gp + bj * HALF); f32x4 v0 = acc[ai][bj][m][0], v1 = acc[ai][bj][m][1];
#pragma unroll
                    for (int e = 0; e < 4; ++e) { v0[e] *= __builtin_amdgcn_rcpf(1.f + __expf(-gsel(gw, e))); v1[e] *= __builtin_amdgcn_rcpf(1.f + __expf(-gsel(gw, 4 + e))); }
                    st16(merged + (size_t)row * DM + col0 + bj * HALF, pack8(v0, v1)); } }
    }
};
template <bool NRM> struct EpiResid {
    static constexpr bool PERM = true, HOOK = false;
    const float* base; float* out; bf16_t* hb; float* ssq2;
    __device__ __forceinline__ void operator()(const f32x4 (&acc)[2][2][4][2], const Unit& u, int wr, int wc, int fr, int fq) const {
        const int row0 = u.pm * BM + wr * 64 + fr, col0 = u.pn * BM + wc * 32 + 8 * fq;
#pragma unroll
        for (int ai = 0; ai < 2; ++ai)
#pragma unroll
            for (int m = 0; m < 4; ++m) { const int row = row0 + ai * HALF + m * 16; const size_t off = (size_t)row * DM + col0; float s = 0.f;
#pragma unroll
                for (int bj = 0; bj < 2; ++bj) { const f32x4 o0 = ldf4(base + off + bj * HALF) + acc[ai][bj][m][0], o1 = ldf4(base + off + bj * HALF + 4) + acc[ai][bj][m][1];
                    stf4(out + off + bj * HALF, o0); stf4(out + off + bj * HALF + 4, o1);
                    if (NRM) { st16(hb + off + bj * HALF, pack8(o0, o1)); s += sq8(o0, o1); } }
                if (NRM) { { const int ln_ = fq * 16 + fr; s += shx(s, ln_, 16); s += shx(s, ln_, 32); }
                    if (fq == 0) __hip_atomic_fetch_add(ssq2 + row, s, __ATOMIC_RELAXED, __HIP_MEMORY_SCOPE_AGENT); } }
    }
};

struct EpiFinal {
    static constexpr bool PERM = true, HOOK = false;
    const float* base; float* out; const float* gfin; float* ssq3; unsigned* pcnt;
    __device__ __forceinline__ void operator()(f32x4 (&acc)[2][2][4][2], const Unit& u, int wr, int wc, int fr, int fq) const {
        const int row0 = u.pm * BM + wr * 64 + fr, col0 = u.pn * BM + wc * 32 + 8 * fq; const int ln_ = fq * 16 + fr;
#pragma unroll
        for (int ai = 0; ai < 2; ++ai)
#pragma unroll
            for (int m = 0; m < 4; ++m) { const int row = row0 + ai * HALF + m * 16; const size_t off = (size_t)row * DM + col0; float s = 0.f;
#pragma unroll
                for (int bj = 0; bj < 2; ++bj) { acc[ai][bj][m][0] += ldf4(base + off + bj * HALF); acc[ai][bj][m][1] += ldf4(base + off + bj * HALF + 4); s += sq8(acc[ai][bj][m][0], acc[ai][bj][m][1]); }
                s += shx(s, ln_, 16); s += shx(s, ln_, 32);
                if (fq == 0) __hip_atomic_fetch_add(ssq3 + row, s, __ATOMIC_RELAXED, __HIP_MEMORY_SCOPE_AGENT); }
        asm volatile("s_waitcnt vmcnt(0)" ::: "memory");
        unsigned* cw = pcnt + 64 * u.pm;
        if (ln_ == 0) __hip_atomic_fetch_add(cw, 1u, __ATOMIC_RELAXED, __HIP_MEMORY_SCOPE_AGENT);
        { unsigned sp = 0; while ((unsigned)__builtin_amdgcn_readfirstlane(__hip_atomic_load(cw, __ATOMIC_RELAXED, __HIP_MEMORY_SCOPE_AGENT)) < 64u) { __builtin_amdgcn_s_sleep(2); if (++sp > (1u << 22)) break; } }
        __builtin_amdgcn_fence(__ATOMIC_ACQUIRE, "agent");
        f32x4 g0[2], g1[2];
#pragma unroll
        for (int bj = 0; bj < 2; ++bj) { g0[bj] = ldf4(gfin + col0 + bj * HALF); g1[bj] = ldf4(gfin + col0 + bj * HALF + 4); }
#pragma unroll
        for (int ai = 0; ai < 2; ++ai)
#pragma unroll
            for (int m = 0; m < 4; ++m) { const int row = row0 + ai * HALF + m * 16; const size_t off = (size_t)row * DM + col0;
                const float rstd = rsqrtf(__hip_atomic_load(ssq3 + row, __ATOMIC_RELAXED, __HIP_MEMORY_SCOPE_AGENT) * (1.f / 2048.f) + EPS);
#pragma unroll
                for (int bj = 0; bj < 2; ++bj) { stf4(out + off + bj * HALF, acc[ai][bj][m][0] * rstd * g0[bj]); stf4(out + off + bj * HALF + 4, acc[ai][bj][m][1] * rstd * g1[bj]); } }
    }
};

template <class Epi>
__device__ __forceinline__ void gemm_phase(LAS unsigned char* lds, const Gemm g, const StaticOrder& S, const Epi& E, const int wv) {
    const int tid_ = opaque_tid(wv);
    const int tid = tid_, wid = __builtin_amdgcn_readfirstlane(tid >> 6), lane = tid & 63, wr = wid >> 2, wc = wid & 3, fr = lane & 15, fq = lane >> 4;
    const int K = g.K, nt = K / BK;
    unsigned voffA[2], voffB[2];
#pragma unroll
    for (int i = 0; i < 2; ++i) { int R, C; stage_rc(tid * 16 + i * 8192, R, C); const int Rb = Epi::PERM ? ((R & ~31) + perm32(R & 31)) : R;
        voffA[i] = (unsigned)(R * g.lda + C) * 2u; voffB[i] = (unsigned)(Rb * K + C) * 2u; }
    const size_t kstep = (size_t)(BK * 2);
    const size_t hstep = (size_t)HALF * K * 2;
    const size_t tstep = 2 * hstep;
    const size_t hstepA = (size_t)HALF * g.lda * 2, tstepA = 2 * hstepA;
    const unsigned ldsw = (unsigned)wid * 1024u;
    const int aoff = lds_byte(wr * 64 + fr, fq * 8), boff = lds_byte(wc * 32 + fr, fq * 8);
#define PG8_SA(b, h) (((b) * 2 + (h)) * HTB)
#define PG8_SB(b, h) ((4 + (b) * 2 + (h)) * HTB)
#define PG8_STAGE(bufoff, gbase, voff) do { _Pragma("unroll") for (int _i = 0; _i < 2; ++_i) \
        __builtin_amdgcn_global_load_lds((const unsigned*)((const char*)(gbase) + (voff)[_i]), (LAS unsigned*)(lds + (bufoff) + ldsw + _i * 8192), 16, 0, 0); } while (0)
#define PG8_LDA(dst, b, h) do { _Pragma("unroll") for (int m = 0; m < 4; ++m) _Pragma("unroll") for (int k = 0; k < 2; ++k) dst[m][k] = *(const LAS bf16x8*)(lds + PG8_SA(b, h) + aoff + m * 2048 + k * 1024); } while (0)
#define PG8_LDB(dst, b, h) do { _Pragma("unroll") for (int n = 0; n < 2; ++n) _Pragma("unroll") for (int k = 0; k < 2; ++k) dst[n][k] = *(const LAS bf16x8*)(lds + PG8_SB(b, h) + boff + n * 2048 + k * 1024); } while (0)
#define PG8_MMA(ai, bj, At, Bt) do { __builtin_amdgcn_s_setprio(1); _Pragma("unroll") for (int m = 0; m < 4; ++m) _Pragma("unroll") for (int n = 0; n < 2; ++n) _Pragma("unroll") for (int k = 0; k < 2; ++k) \
        acc[ai][bj][m][n] = __builtin_amdgcn_mfma_f32_16x16x32_bf16(Bt[n][k], At[m][k], acc[ai][bj][m][n], 0, 0, 0); __builtin_amdgcn_s_setprio(0); } while (0)
#define PG8_WAIT_V(n) asm volatile("s_waitcnt vmcnt(" #n ")" ::: "memory")
#define PG8_WAIT_L(n) asm volatile("s_waitcnt lgkmcnt(" #n ")" ::: "memory")
#define PG8_BAR __builtin_amdgcn_s_barrier()
#define PG8_SCHED __builtin_amdgcn_sched_barrier(0)
    Unit cur, nxt; int ui = 0;
    if (!S.next(0, cur)) return;
    f32x4 acc[2][2][4][2];
#pragma unroll
    for (int a = 0; a < 2; ++a)
#pragma unroll
        for (int b = 0; b < 2; ++b)
#pragma unroll
            for (int m = 0; m < 4; ++m)
#pragma unroll
                for (int n = 0; n < 2; ++n) acc[a][b][m][n] = (f32x4){0.f, 0.f, 0.f, 0.f};
    bf16x8 At[4][2], B0[2][2], B1[2][2];
    const char* cA = (const char*)g.A + (size_t)cur.pm * tstepA; const char* cB = (const char*)g.Bt + (size_t)cur.pn * tstep;
    PG8_STAGE(PG8_SB(0, 0), cB, voffB); PG8_STAGE(PG8_SB(0, 1), cB + hstep, voffB); PG8_STAGE(PG8_SA(0, 0), cA, voffA); PG8_STAGE(PG8_SA(0, 1), cA + hstepA, voffA);
    if (wr == 1) PG8_BAR;
    PG8_WAIT_V(2); PG8_BAR;
    PG8_STAGE(PG8_SB(1, 0), cB + kstep, voffB); PG8_STAGE(PG8_SA(1, 0), cA + kstep, voffA); PG8_STAGE(PG8_SB(1, 1), cB + hstep + kstep, voffB);
    PG8_WAIT_V(6); PG8_BAR;
    for (;;) {
        const bool has_next = S.next(ui + 1, nxt);
        const char* nA = has_next ? (const char*)g.A + (size_t)nxt.pm * tstepA : cA; const char* nB = has_next ? (const char*)g.Bt + (size_t)nxt.pn * tstep : cB;
#define PG8_KITER(t) do { \
            const bool last = (t == nt - 2); \
            const char* a1 = cA + (size_t)(t + 1) * kstep; \
            const char* a2 = last ? nA : cA + (size_t)(t + 2) * kstep; const char* b2 = last ? nB : cB + (size_t)(t + 2) * kstep; \
            const char* a3 = a2 + kstep; const char* b3 = b2 + kstep; \
            PG8_LDB(B0, 0, 0); PG8_LDB(B1, 0, 1); PG8_SCHED; PG8_LDA(At, 0, 0); PG8_STAGE(PG8_SA(1, 1), a1 + hstepA, voffA); \
            PG8_WAIT_V(8); PG8_WAIT_L(0); PG8_BAR; PG8_MMA(0, 0, At, B0); PG8_MMA(0, 1, At, B1); PG8_BAR; PG8_SCHED; \
            PG8_LDA(At, 0, 1); PG8_STAGE(PG8_SB(0, 0), b2, voffB); PG8_STAGE(PG8_SB(0, 1), b2 + hstep, voffB); PG8_STAGE(PG8_SA(0, 0), a2, voffA); \
            PG8_WAIT_V(8); PG8_WAIT_L(0); PG8_BAR; PG8_MMA(1, 0, At, B0); PG8_MMA(1, 1, At, B1); PG8_BAR; PG8_SCHED; \
            PG8_LDB(B0, 1, 0); PG8_LDB(B1, 1, 1); PG8_SCHED; PG8_LDA(At, 1, 0); PG8_STAGE(PG8_SA(0, 1), a2 + hstepA, voffA); \
            PG8_WAIT_V(8); PG8_WAIT_L(0); PG8_BAR; PG8_MMA(0, 0, At, B0); PG8_MMA(0, 1, At, B1); PG8_BAR; PG8_SCHED; \
            PG8_LDA(At, 1, 1); PG8_STAGE(PG8_SB(1, 0), b3, voffB); PG8_STAGE(PG8_SB(1, 1), b3 + hstep, voffB); PG8_STAGE(PG8_SA(1, 0), a3, voffA); \
            PG8_WAIT_V(8); PG8_WAIT_L(0); PG8_BAR; PG8_MMA(1, 0, At, B0); PG8_MMA(1, 1, At, B1); PG8_BAR; PG8_SCHED; \
        } while (0)
        if constexpr (Epi::HOOK) {
            int t = 0;
#pragma nounroll
            for (int seg = 0; seg < 3; ++seg) { const int te = (seg == 0) ? 24 : (seg == 1 ? 32 : nt);
                for (; t < te; t += 2) PG8_KITER(t);
                if (seg < 2) E.hook(acc, cur, seg, wr, wc, fr, fq); }
        } else {
            for (int t = 0; t < nt; t += 2) PG8_KITER(t);
        }
        if (wr == 0) PG8_BAR;
        E(acc, cur, wr, wc, fr, fq);
        if (!has_next) break;
#pragma unroll
        for (int a = 0; a < 2; ++a)
#pragma unroll
            for (int b = 0; b < 2; ++b)
#pragma unroll
                for (int m = 0; m < 4; ++m)
#pragma unroll
                    for (int n = 0; n < 2; ++n) acc[a][b][m][n] = (f32x4){0.f, 0.f, 0.f, 0.f};
        cur = nxt; cA = nA; cB = nB; ++ui;
        if (wr == 1) PG8_BAR;
    }
    PG8_WAIT_V(0);
    PG8_BAR;
#undef PG8_SA
#undef PG8_SB
#undef PG8_STAGE
#undef PG8_LDA
#undef PG8_LDB
#undef PG8_MMA
#undef PG8_WAIT_V
#undef PG8_WAIT_L
#undef PG8_BAR
#undef PG8_SCHED
#undef PG8_KITER
}
}

namespace att {
#define KSWZ(row, colB) ((row) * 256 + ((colB) ^ (((row) & 7) << 4)))
#define XSWZ(row, colB) ((row) * 128 + ((colB) ^ ((((row) >> 1) & 7) << 4)))
#define SBAR() __builtin_amdgcn_sched_barrier(0)
__device__ __forceinline__ int crow(int r, int hi) { return (r & 3) + 8 * (r >> 2) + 4 * hi; }
__device__ __forceinline__ unsigned cvtpk(float lo, float hi) { unsigned r; asm volatile("v_cvt_pk_bf16_f32 %0, %1, %2" : "=v"(r) : "v"(lo), "v"(hi)); return r; }
__device__ __forceinline__ bf16x8 ld8(const bf16_t* p) { return *(const GAS bf16x8*)p; }

__device__ __forceinline__ void partialSM(f32x16& p0, f32x16& p1, float& m_reg, float& mn, float& alpha, const float C, const float thr) {
    float pmax = p0[0];
#pragma unroll
    for (int r = 1; r < 16; ++r) pmax = fmaxf(pmax, p0[r]);
#pragma unroll
    for (int r = 0; r < 16; ++r) pmax = fmaxf(pmax, p1[r]);
    { auto rr = __builtin_amdgcn_permlane32_swap(__float_as_uint(pmax), __float_as_uint(pmax), false, false);
      pmax = fmaxf(__uint_as_float(rr[0]), __uint_as_float(rr[1])); }
    if (__builtin_expect(__all(pmax - m_reg <= thr), 1)) { mn = m_reg; alpha = 1.f; }
    else { mn = fmaxf(m_reg, pmax); alpha = __builtin_amdgcn_exp2f((m_reg - mn) * C); m_reg = mn; }
    const float mnC = -mn * C;
#pragma unroll
    for (int r = 0; r < 16; ++r) p0[r] = fmaf(p0[r], C, mnC);
#pragma unroll
    for (int r = 0; r < 16; ++r) p1[r] = fmaf(p1[r], C, mnC);
#pragma unroll
    for (int r = 0; r < 16; ++r) p0[r] = __builtin_amdgcn_exp2f(p0[r]);
}
__device__ __forceinline__ void finishSM(f32x16& p0, f32x16& p1, float alpha, float& l_reg, bf16x8& pa0, bf16x8& pa1, bf16x8& pa2, bf16x8& pa3) {
#pragma unroll
    for (int r = 0; r < 16; ++r) p1[r] = __builtin_amdgcn_exp2f(p1[r]);
    float ps = 0;
#pragma unroll
    for (int r = 0; r < 16; ++r) ps += p0[r];
#pragma unroll
    for (int r = 0; r < 16; ++r) ps += p1[r];
    { auto rr = __builtin_amdgcn_permlane32_swap(__float_as_uint(ps), __float_as_uint(ps), false, false);
      ps = __uint_as_float(rr[0]) + __uint_as_float(rr[1]); }
    l_reg = l_reg * alpha + ps;
#define PK4(P, BASE, OUT) do { unsigned a0 = cvtpk(P[BASE + 0], P[BASE + 1]), a1 = cvtpk(P[BASE + 2], P[BASE + 3]);   \
    unsigned b0 = cvtpk(P[BASE + 4], P[BASE + 5]), b1 = cvtpk(P[BASE + 6], P[BASE + 7]);                              \
    auto r0 = __builtin_amdgcn_permlane32_swap(a0, b0, false, false); auto r1 = __builtin_amdgcn_permlane32_swap(a1, b1, false, false); \
    u32x4 w = {r0[0], r1[0], r0[1], r1[1]}; OUT = *reinterpret_cast<bf16x8*>(&w); } while (0)
    PK4(p0, 0, pa0); PK4(p0, 8, pa1); PK4(p1, 0, pa2); PK4(p1, 8, pa3);
#undef PK4
}
__device__ __forceinline__ int v_st(int k, int c) { const int kk = (k & ~0xC) | ((k & 4) << 1) | ((k & 8) >> 1); return ((kk >> 3) * 4 + (c >> 5)) * 512 + ((kk & 7) * 32 + (c & 31)) * 2; }
__device__ __forceinline__ int v_rd_base(int lane) { return ((lane & 3) << 3) | (((lane >> 2) & 3) << 6) | (((lane >> 4) & 1) << 5) | (((lane >> 5) & 1) << 8); }
constexpr int v_rd_off(int d0, int ks, int half) { return d0 * 512 + ks * 4096 + half * 2048; }
template <int OFF> __device__ __forceinline__ s16x4 tr_read(int vb) {
    s16x4 r; asm volatile("ds_read_b64_tr_b16 %0, %1 offset:%2" : "=&v"(r) : "v"(vb), "i"(OFF) : "memory"); return r;
}
template <int D0> __device__ __forceinline__ void pv_one(f32x16& od, int vb, bf16x8 pa0, bf16x8 pa1, bf16x8 pa2, bf16x8 pa3) {
    const s16x4 l0 = tr_read<v_rd_off(D0, 0, 0)>(vb), h0 = tr_read<v_rd_off(D0, 0, 1)>(vb), l1 = tr_read<v_rd_off(D0, 1, 0)>(vb), h1 = tr_read<v_rd_off(D0, 1, 1)>(vb);
    const s16x4 l2 = tr_read<v_rd_off(D0, 2, 0)>(vb), h2 = tr_read<v_rd_off(D0, 2, 1)>(vb), l3 = tr_read<v_rd_off(D0, 3, 0)>(vb), h3 = tr_read<v_rd_off(D0, 3, 1)>(vb);
    asm volatile("s_waitcnt lgkmcnt(0)" ::: "memory"); SBAR();
#define PK(L, H) (bf16x8){L[0], L[1], L[2], L[3], H[0], H[1], H[2], H[3]}
    od = __builtin_amdgcn_mfma_f32_32x32x16_bf16(pa0, PK(l0, h0), od, 0, 0, 0);
    od = __builtin_amdgcn_mfma_f32_32x32x16_bf16(pa1, PK(l1, h1), od, 0, 0, 0);
    od = __builtin_amdgcn_mfma_f32_32x32x16_bf16(pa2, PK(l2, h2), od, 0, 0, 0);
    od = __builtin_amdgcn_mfma_f32_32x32x16_bf16(pa3, PK(l3, h3), od, 0, 0, 0);
#undef PK
}
__device__ __forceinline__ void pv_d0(f32x16* o, int vb, bf16x8 pa0, bf16x8 pa1, bf16x8 pa2, bf16x8 pa3) {
    pv_one<0>(o[0], vb, pa0, pa1, pa2, pa3); pv_one<1>(o[1], vb, pa0, pa1, pa2, pa3); pv_one<2>(o[2], vb, pa0, pa1, pa2, pa3); pv_one<3>(o[3], vb, pa0, pa1, pa2, pa3);
}

template <int RX, bool HOLDX, bool DIL, bool F32OUT>
__device__ __forceinline__ void attn_unit(const bf16_t* __restrict__ Qb, long ldq,
                                          const bf16_t* __restrict__ Kh, const bf16_t* __restrict__ Vh, long ldk,
                                          const bf16_t* __restrict__ Kx, long ldkx,
                                          const int NT, const float SCALE,
                                          bf16_t* Ob, long ldo, float* Of, long ldof, float* Lse, long ldl,
                                          const int q0, const int ssub, const float* biasL, char* lds, const int wv) {
    constexpr int NX = RX / 16, NQH = 8 + (HOLDX ? NX : 0);
    constexpr int SHM_V = 64 * 128 * 2, SHM_K = 64 * 128 * 2, SHM_X = 64 * (RX ? RX : 8) * 2;
    const int tid_ = opaque_tid(wv);
    const int tid = tid_, wid = tid >> 6, lane = tid & 63, r32 = lane & 31, hi = lane >> 5;
    char* V_lds = lds; char* K_lds = lds + 2 * SHM_V; char* X_lds = lds + 2 * SHM_V + 2 * SHM_K;
    float* ws = (float*)(lds + 2 * SHM_V + 2 * SHM_K + 2 * SHM_X) + wid * 64; float* li_l = ws; float* al_l = ws + 32;
    const float C = SCALE * 1.4426950408889634f, thr = 8.f / SCALE;
    float m_reg = DIL ? -1e29f : -1e30f, l_reg = 0; f32x16 o[4] = {}; bf16x8 qr[NQH];
    const bf16_t* Qw = Qb + (long)(wid * 32 + r32) * ldq + hi * 8;
#pragma unroll
    for (int d0 = 0; d0 < NQH; ++d0) qr[d0] = ld8(Qw + d0 * 16);
    const int sr = tid >> 4, sc = (tid & 15) * 8, vst0 = v_st(sr, sc), vst1 = v_st(32 + sr, sc);
    const int xr = tid >> 3, xc = (tid & 7) * 8;
    const int vb0 = (int)(uintptr_t)V_lds + v_rd_base(lane);
    const int kbase = DIL ? q0 - 64 : 0;
    bf16x8 vs0, vs1, ks0, ks1, xs0, xs1;
#define ROWK(k) (DIL ? (long)min(max((k), 0), ssub - 1) : (long)(k))
#define SLOAD(k0) do { const long ra_ = ROWK(kbase + (k0) + sr), rb_ = ROWK(kbase + (k0) + 32 + sr); \
        vs0 = ld8(Vh + ra_ * ldk + sc); vs1 = ld8(Vh + rb_ * ldk + sc); ks0 = ld8(Kh + ra_ * ldk + sc); ks1 = ld8(Kh + rb_ * ldk + sc); \
        if constexpr (RX == 64) { xs0 = ld8(Kx + (long)((k0) + xr) * ldkx + xc); } \
        if constexpr (RX == 128) { xs0 = ld8(Kx + ra_ * ldkx + sc); xs1 = ld8(Kx + rb_ * ldkx + sc); } } while (0)
#define SWRITE(b) do { *(bf16x8*)(V_lds + (b) * SHM_V + vst0) = vs0; *(bf16x8*)(V_lds + (b) * SHM_V + vst1) = vs1; const int kc = sc * 2; \
        *(bf16x8*)(K_lds + (b) * SHM_K + KSWZ(sr, kc)) = ks0; *(bf16x8*)(K_lds + (b) * SHM_K + KSWZ(32 + sr, kc)) = ks1; \
        if constexpr (RX == 64) { *(bf16x8*)(X_lds + (b) * SHM_X + XSWZ(xr, xc * 2)) = xs0; } \
        if constexpr (RX == 128) { *(bf16x8*)(X_lds + (b) * SHM_X + KSWZ(sr, kc)) = xs0; *(bf16x8*)(X_lds + (b) * SHM_X + KSWZ(32 + sr, kc)) = xs1; } } while (0)
#define SWAIT() asm volatile("s_waitcnt vmcnt(0)" ::: "memory")
#define RESC(a) do { if (__any((a) < 1.f)) { if (hi == 0) al_l[r32] = (a); asm volatile("s_waitcnt lgkmcnt(0)" ::: "memory"); \
        _Pragma("unroll") for (int d = 0; d < 4; ++d) _Pragma("unroll") for (int r = 0; r < 16; ++r) o[d][r] *= al_l[crow(r, hi)]; } } while (0)
#define QKT(P0, P1, b) do { P0 = f32x16{}; P1 = f32x16{}; const char* Kb_ = K_lds + (b) * SHM_K; const char* Xb_ = X_lds + (b) * SHM_X; \
        _Pragma("unroll") for (int d0 = 0; d0 < 8; ++d0) { const int cb = (d0 * 16 + hi * 8) * 2; \
            const bf16x8 b0 = *reinterpret_cast<const bf16x8*>(Kb_ + KSWZ(r32, cb)); const bf16x8 b1 = *reinterpret_cast<const bf16x8*>(Kb_ + KSWZ(32 + r32, cb)); \
            P0 = __builtin_amdgcn_mfma_f32_32x32x16_bf16(b0, qr[d0], P0, 0, 0, 0); P1 = __builtin_amdgcn_mfma_f32_32x32x16_bf16(b1, qr[d0], P1, 0, 0, 0); } \
        _Pragma("unroll") for (int x = 0; x < NX; ++x) { const int cb = (x * 16 + hi * 8) * 2; bf16x8 b0, b1; \
            if constexpr (RX == 64) { b0 = *reinterpret_cast<const bf16x8*>(Xb_ + XSWZ(r32, cb)); b1 = *reinterpret_cast<const bf16x8*>(Xb_ + XSWZ(32 + r32, cb)); } \
            else { b0 = *reinterpret_cast<const bf16x8*>(Xb_ + KSWZ(r32, cb)); b1 = *reinterpret_cast<const bf16x8*>(Xb_ + KSWZ(32 + r32, cb)); } \
            bf16x8 qx; if ((8 + x) < NQH) qx = qr[(8 + x) < NQH ? (8 + x) : 0]; else qx = ld8(Qw + (8 + x) * 16); \
            P0 = __builtin_amdgcn_mfma_f32_32x32x16_bf16(b0, qx, P0, 0, 0, 0); P1 = __builtin_amdgcn_mfma_f32_32x32x16_bf16(b1, qx, P1, 0, 0, 0); } } while (0)
#define MASK(P0, P1, t) do { if constexpr (DIL) { const int qq_ = q0 + wid * 32 + r32; const int kt_ = q0 - 64 + (t) * 64 + 4 * hi; \
        _Pragma("unroll") for (int r = 0; r < 16; ++r) { const int kk_ = kt_ + (r & 3) + 8 * (r >> 2); const int rel_ = kk_ - qq_; \
            { const bool ok_ = (rel_ >= -64) & (rel_ <= 64) & (kk_ >= 0) & (kk_ < ssub); const float b_ = biasL[min(max(rel_ + 64, 0), 128)]; P0[r] = ok_ ? P0[r] + b_ : -1e30f; } \
            { const int k2_ = kk_ + 32, r2_ = rel_ + 32; const bool ok_ = (r2_ >= -64) & (r2_ <= 64) & (k2_ >= 0) & (k2_ < ssub); const float b_ = biasL[min(max(r2_ + 64, 0), 128)]; P1[r] = ok_ ? P1[r] + b_ : -1e30f; } } } } while (0)
    f32x16 pA0, pA1, pB0, pB1; float mnA, mnB, alA, alB; bf16x8 pa0, pa1, pa2, pa3;
    const int tlo = __builtin_amdgcn_readfirstlane(wid >> 1);
#define ACT(t) (!DIL || ((t) >= tlo && (t) <= tlo + 2))
#define QKM(P0, P1, b, t) do { if (ACT(t)) { QKT(P0, P1, b); MASK(P0, P1, t); } else { _Pragma("unroll") for (int r = 0; r < 16; ++r) { P0[r] = -1e30f; P1[r] = -1e30f; } } } while (0)
#define PVA(t, vb) do { if (ACT(t)) pv_d0(o, vb, pa0, pa1, pa2, pa3); } while (0)
    SLOAD(0); SWAIT(); SWRITE(0); __syncthreads();
    QKM(pA0, pA1, 0, 0); partialSM(pA0, pA1, m_reg, mnA, alA, C, thr);
    SLOAD(64);
    SWAIT(); SWRITE(1); __syncthreads();
    for (int j = 1; j + 1 < NT; j += 2) {
        SBAR(); QKM(pB0, pB1, 1, j);
        finishSM(pA0, pA1, alA, l_reg, pa0, pa1, pa2, pa3); SBAR();
        SLOAD((j + 1) * 64); SBAR();
        PVA(j - 1, vb0); partialSM(pB0, pB1, m_reg, mnB, alB, C, thr);
        __syncthreads(); SWAIT(); SWRITE(0);
        RESC(alB); __syncthreads();
        SBAR(); QKM(pA0, pA1, 0, j + 1);
        finishSM(pB0, pB1, alB, l_reg, pa0, pa1, pa2, pa3); SBAR();
        SLOAD((j + 2) * 64); SBAR();
        PVA(j, vb0 + SHM_V); partialSM(pA0, pA1, m_reg, mnA, alA, C, thr);
        __syncthreads(); SWAIT(); SWRITE(1);
        RESC(alA); __syncthreads();
    }
    SBAR(); QKM(pB0, pB1, 1, NT - 1);
    finishSM(pA0, pA1, alA, l_reg, pa0, pa1, pa2, pa3); SBAR();
    PVA(NT - 2, vb0); partialSM(pB0, pB1, m_reg, mnB, alB, C, thr);
    __syncthreads(); RESC(alB);
    finishSM(pB0, pB1, alB, l_reg, pa0, pa1, pa2, pa3); SBAR();
    PVA(NT - 1, vb0 + SHM_V);
    if (hi == 0) li_l[r32] = l_reg; asm volatile("s_waitcnt lgkmcnt(0)" ::: "memory");
    float rli[16];
#pragma unroll
    for (int r = 0; r < 16; ++r) rli[r] = __builtin_amdgcn_rcpf(li_l[crow(r, hi)]);
    if constexpr (F32OUT) {
        float* Ow = Of + (long)(wid * 32) * ldof;
#pragma unroll
        for (int r = 0; r < 16; ++r) { const int orow = crow(r, hi);
#pragma unroll
            for (int d0 = 0; d0 < 4; ++d0) *(GAS float*)(Ow + (long)orow * ldof + d0 * 32 + r32) = o[d0][r] * rli[r]; }
        if (hi == 0) *(GAS float*)(Lse + (long)(wid * 32 + r32) * ldl) = m_reg * SCALE + __logf(l_reg);
    } else {
        bf16_t* Ow = Ob + (long)(wid * 32) * ldo;
#pragma unroll
        for (int r = 0; r < 16; ++r) { const int orow = crow(r, hi);
#pragma unroll
            for (int d0 = 0; d0 < 4; ++d0) *(GAS bf16_t*)(Ow + (long)orow * ldo + d0 * 32 + r32) = (bf16_t)(cvtpk(o[d0][r] * rli[r], 0.f) & 0xffffu); }
    }
    __syncthreads();
#undef ROWK
#undef SLOAD
#undef SWRITE
#undef SWAIT
#undef RESC
#undef QKT
#undef MASK
#undef ACT
#undef QKM
#undef PVA
}
}

__device__ __forceinline__ float wave_sum(float v, int lane) {
#pragma unroll
    for (int o = 1; o < 64; o <<= 1) v += shx(v, lane, o);
    return v;
}
__device__ __forceinline__ unsigned f2bf(float f) { unsigned u = __float_as_uint(f); return (u + 0x7fffu + ((u >> 16) & 1u)) >> 16; }
__device__ __forceinline__ unsigned pk2(float lo, float hi) { return f2bf(lo) | (f2bf(hi) << 16); }
__device__ __forceinline__ float bfbits2f(unsigned h) { return __uint_as_float(h << 16); }

__device__ __forceinline__ int src_col(int mat, int n) {
    if (mat == 0) { if (n >= 1024 && n < 1088) { const int p = n - 1024, j = p >> 3, e = p & 7; return 1024 + ((e < 4) ? (4 * j + e) : (32 + 4 * j + (e - 4))); }
        return n < 1088 ? n : (n < 1280 ? -1 : n - 192); }
    if (mat == 1) { if (n < 1536) { return (n >> 7) * 192 + (n & 127); }
        const int cc = n - 1536, h = cc >> 6, p = cc & 63, j = p >> 3, e = p & 7; const int orig = (e < 4) ? (4 * j + e) : (32 + 4 * j + (e - 4)); return h * 192 + 128 + orig; }
    return n;
}
__device__ __forceinline__ void transpose_item(const float* W, int K, int Nsrc, int Ndst, bf16_t* WT, int mat, LAS float* scr, int item, int lane, const float* kscale = nullptr, int ldw = 0, int koff = 0) {
    if (ldw == 0) ldw = K;
    const int nblk = Ndst / 32, kb = item / nblk, nb = item % nblk, k0 = 64 * kb, n0 = 32 * nb;
    const int sc = src_col(mat, n0 + (lane & 31));
#pragma unroll 8
    for (int i = 0; i < 32; ++i) { const int kk = 2 * i + (lane >> 5); float wv = (sc >= 0) ? W[(size_t)(k0 + kk) * Nsrc + sc] : 0.f; if (kscale) wv *= kscale[k0 + kk]; scr[kk * 33 + (lane & 31)] = wv; }
    asm volatile("s_waitcnt lgkmcnt(0)" ::: "memory");
    const int c = lane & 7;
#pragma unroll
    for (int j = 0; j < 4; ++j) { const int n = (lane >> 3) + 8 * j; const LAS float* s = scr + (8 * c) * 33 + n;
        u32x4 o; o.x = pk2(s[0 * 33], s[1 * 33]); o.y = pk2(s[2 * 33], s[3 * 33]); o.z = pk2(s[4 * 33], s[5 * 33]); o.w = pk2(s[6 * 33], s[7 * 33]);
        *(u32x4*)(WT + (size_t)(n0 + n) * ldw + koff + k0 + 8 * c) = o; }
    asm volatile("s_waitcnt lgkmcnt(0)" ::: "memory");
}
__device__ __forceinline__ void norm_row_bf16(const float* xrow, const float* g, bf16_t* orow, int lane) {
    const f32x4* xr = (const f32x4*)xrow + lane; f32x4 v[8]; float s = 0.f;
#pragma unroll
    for (int j = 0; j < 8; ++j) { v[j] = xr[64 * j]; s += (v[j].x * v[j].x + v[j].y * v[j].y) + (v[j].z * v[j].z + v[j].w * v[j].w); }
    const float rstd = rsqrtf(wave_sum(s, lane) * (1.f / 2048.f) + EPS);
    const f32x4* gr = (const f32x4*)g + lane; u32x2* o8 = (u32x2*)orow + lane;
#pragma unroll
    for (int j = 0; j < 8; ++j) { const f32x4 gg = gr[64 * j]; u32x2 w; w.x = pk2(v[j].x * rstd * gg.x, v[j].y * rstd * gg.y); w.y = pk2(v[j].z * rstd * gg.z, v[j].w * rstd * gg.w); o8[64 * j] = w; }
}
__device__ __forceinline__ void norm_row_f32(float* xrow, const float* g, int lane) {
    f32x4* xr = (f32x4*)xrow + lane; f32x4 v[8]; float s = 0.f;
#pragma unroll
    for (int j = 0; j < 8; ++j) { v[j] = xr[64 * j]; s += (v[j].x * v[j].x + v[j].y * v[j].y) + (v[j].z * v[j].z + v[j].w * v[j].w); }
    const float rstd = rsqrtf(wave_sum(s, lane) * (1.f / 2048.f) + EPS);
    const f32x4* gr = (const f32x4*)g + lane;
#pragma unroll
    for (int j = 0; j < 8; ++j) { const f32x4 gg = gr[64 * j]; xr[64 * j] = v[j] * rstd * gg; }
}


#define XB_TMO      128
#define XB_XCNT(j)  (256  + 64 * (j))
#define XB_XSUB(j)  (1280 + 64 * (j))
#define XB_XGEN(j)  (2304 + 64 * (j))
#define XB_TOP      3328
#define XB_TOPGEN   3392
#define XCD_BAR_WORDS 3456
#define XB_SPIN_CAP (1u << 18)
__device__ __forceinline__ unsigned xb_ld(unsigned* p)              { return __hip_atomic_load(p, __ATOMIC_RELAXED, __HIP_MEMORY_SCOPE_AGENT); }
__device__ __forceinline__ unsigned xb_add(unsigned* p, unsigned v) { return __hip_atomic_fetch_add(p, v, __ATOMIC_RELAXED, __HIP_MEMORY_SCOPE_AGENT); }
__device__ __forceinline__ unsigned xb_xcc_id() { return (unsigned)__builtin_amdgcn_s_getreg((3 << 11) | 20) & 0xFu; }
#define XB_SPIN(cond, bar) do { unsigned _sp = 0; while (cond) { __builtin_amdgcn_s_sleep(1); \
    if ((++_sp & 255u) == 0u) { if (xb_ld(&(bar)[XB_TMO])) break; if (_sp > XB_SPIN_CAP) { atomicAdd(&(bar)[XB_TMO], 1u); break; } } } } while (0)
struct XcdBarrier { unsigned* bar; unsigned x; volatile LAS unsigned* st; };
__device__ __forceinline__ void xcd_barrier_complete(unsigned* bar, unsigned x, unsigned& nloc, unsigned& nx) {
    const unsigned G = gridDim.x * gridDim.y * gridDim.z;
    unsigned sum, cnt, mine, sp = 0u;
    for (;;) {
        sum = 0u; cnt = 0u; mine = 0u;
#pragma unroll
        for (unsigned j = 0; j < 16; ++j) { const unsigned c = xb_ld(&bar[XB_XCNT(j)]); sum += c; cnt += (c > 0u) ? 1u : 0u; mine = (j == x) ? c : mine; }
        if (sum == G) break;
        __builtin_amdgcn_s_sleep(1);
        if ((++sp & 255u) == 0u) { if (xb_ld(&bar[XB_TMO])) break; if (sp > XB_SPIN_CAP) { atomicAdd(&bar[XB_TMO], 1u); break; } }
    }
    nloc = mine > 0u ? mine : 1u; nx = cnt > 0u ? cnt : 1u;
}
__device__ __forceinline__ void xcd_barrier(const XcdBarrier& b, const bool leader_thread) {
    asm volatile("s_waitcnt vmcnt(0)" ::: "memory");
    __syncthreads();
    if (leader_thread) {
        unsigned* bar = b.bar;
        __builtin_amdgcn_s_waitcnt(0);
        unsigned nloc = b.st[0], nx = b.st[1];
        if (nloc == 0u) { xcd_barrier_complete(bar, b.x, nloc, nx); b.st[0] = nloc; b.st[1] = nx; }
        const unsigned old = xb_add(&bar[XB_XSUB(b.x)], 1u);
        const unsigned gen = old / nloc;
        if (old + 1u == (gen + 1u) * nloc) {
            __builtin_amdgcn_fence(__ATOMIC_RELEASE, "agent");
            asm volatile("s_waitcnt vmcnt(0)" ::: "memory");
            const unsigned og = xb_add(&bar[XB_TOP], 1u);
            const unsigned tg = og / nx;
            if (og + 1u == (tg + 1u) * nx) xb_add(&bar[XB_TOPGEN], 1u);
            else XB_SPIN(xb_ld(&bar[XB_TOPGEN]) == tg, bar);
            __builtin_amdgcn_fence(__ATOMIC_ACQUIRE, "agent");
            xb_add(&bar[XB_XGEN(b.x)], 1u);
            asm volatile("s_waitcnt vmcnt(0)" ::: "memory");
        } else {
            XB_SPIN(xb_ld(&bar[XB_XGEN(b.x)]) == gen, bar);
            __builtin_amdgcn_fence(__ATOMIC_ACQUIRE, "agent");
            asm volatile("s_waitcnt vmcnt(0)" ::: "memory");
        }
    }
    __syncthreads();
}

__global__ void __launch_bounds__(512, 2) fwd_megakernel(Params P) {
    extern __shared__ __attribute__((aligned(16))) unsigned char lds[];
    cg::grid_group grid = cg::this_grid();
    const int G = gridDim.x, bx = blockIdx.x, NGW = G * 8;
    const int wv_s = __builtin_amdgcn_readfirstlane((int)threadIdx.x >> 6);
    XcdBarrier xbar;
    {   volatile LAS unsigned* st = (volatile LAS unsigned*)((LAS unsigned char*)lds + 131072);
        if (threadIdx.x < 2) st[threadIdx.x] = 0u;
        __syncthreads();
        xbar.bar = (unsigned*)(P.ws + WS_BAR); xbar.x = xb_xcc_id(); xbar.st = st;
        if (threadIdx.x == 0) (void)xb_add(&xbar.bar[XB_XCNT(xbar.x)], 1u); }
#define GSYNC() xcd_barrier(xbar, opaque_tid(wv_s) == 0)
#define OPQ() const int tid_ = opaque_tid(wv_s); const int tid = tid_, lane = tid & 63, wave = __builtin_amdgcn_readfirstlane(tid >> 6), gw = bx * 8 + wave; (void)tid; (void)lane; (void)gw; WSP()
    LAS unsigned char* ldsl = (LAS unsigned char*)lds;
#define WSP() unsigned char* ws = P.ws; asm volatile("" : "+s"(ws))
#define ROPE ((const f32x2*)(ws + WS_ROPE))
#define BIAS ((float*)(ws + WS_BIAS))
#define WIN ((bf16_t*)(ws + WS_WIN))
#define WUQ ((bf16_t*)(ws + WS_WUQ))
#define WUKV ((bf16_t*)(ws + WS_WUKV))
#define WMKV ((bf16_t*)(ws + WS_WMKV))
#define WBCAT ((bf16_t*)(ws + WS_WBM))
#define WBD ((bf16_t*)(ws + WS_WBD))
#define WBX ((bf16_t*)(ws + WS_WBX))
#define WOUT ((bf16_t*)(ws + WS_WOUT))
#define WUP ((bf16_t*)(ws + WS_WUP))
#define WDN ((bf16_t*)(ws + WS_WDN))
#define MEMN ((bf16_t*)(ws + WS_MEMN))
#define MEMKV ((bf16_t*)(ws + WS_MEMKV))
#define HB(par, c2) ((bf16_t*)(ws + WS_H) + ((size_t)(par) * 2 + (c2)) * MC * 2048)
#define PROJ2 ((bf16_t*)(ws + WS_PROJ))
#define PROJ (PROJ2 + (size_t)cl * MC * NPROJ)
#define UPACT ((bf16_t*)(ws + WS_PROJ))
#define KPE2 ((bf16_t*)(ws + WS_KPE))
#define KPE (KPE2 + (size_t)cl * MC * 64)
#define QB ((bf16_t*)(ws + WS_Q))
#define KVB ((bf16_t*)(ws + WS_KV))
#define OCAT ((bf16_t*)(ws + WS_OMLA))
#define ODG ((float*)(ws + WS_ODG))
#define LSEB ((float*)(ws + WS_LSE))
#define MERG ((bf16_t*)(ws + WS_MERG))
#define SSQP ((float*)(ws + WS_SSQ))
#define SSQ (SSQP + (size_t)cl * MC * 2)
#define SSQ2 ((float*)(ws + WS_SSQ2))
#define MLP ((float*)(ws + WS_MLP))
#define MLSE ((float*)(ws + WS_MLSE))
#define HX ((bf16_t*)(ws + WS_HX))
#define SSQ3 ((float*)(ws + WS_SSQ3))
#define PCNT ((unsigned*)(ws + WS_PCNT))

    {
        OPQ();
        LAS float* scr = (LAS float*)(ldsl + wave * 16384);
        constexpr int I0 = 32 * (NPROJ / 32), I1 = 8 * (NQ / 32), I2 = 8 * (NKV / 32), I3 = 32 * 64, I4 = 24 * 64, I5 = 8 * 64, I6 = 16 * 64, I7 = 32 * 64, I8 = 32 * 256, I9 = 128 * 64;
        constexpr int NITEMS = I0 + I1 + I2 + I3 + I4 + I5 + I6 + I7 + I8 + I9;
        for (int it = gw; it < NITEMS; it += NGW) {
            int r = it;
            if (r < I0) { transpose_item(P.in[6], 2048, 12864, NPROJ, WIN, 0, scr, r, lane); continue; } r -= I0;
            if (r < I1) { transpose_item(P.in[8], 512, NQ, NQ, WUQ, 1, scr, r, lane, P.in[7]); continue; } r -= I1;
            if (r < I2) { transpose_item(P.in[10], 512, NKV, NKV, WUKV, 2, scr, r, lane, P.in[9]); continue; } r -= I2;
            if (r < I3) { transpose_item(P.in[12], 2048, 2048, 2048, WMKV, 2, scr, r, lane); continue; } r -= I3;
            if (r < I4) { transpose_item(P.in[13], 1536, 2048, 2048, WBCAT, 2, scr, r, lane, nullptr, 3072, 0); continue; } r -= I4;
            if (r < I5) { transpose_item(P.in[14], 512, 2048, 2048, WBCAT, 2, scr, r, lane, nullptr, 3072, 1536); continue; } r -= I5;
            if (r < I6) { transpose_item(P.in[15], 1024, 2048, 2048, WBCAT, 2, scr, r, lane, nullptr, 3072, 2048); continue; } r -= I6;
            if (r < I7) { transpose_item(P.in[16], 2048, 2048, 2048, WOUT, 2, scr, r, lane); continue; } r -= I7;
            if (r < I8) { transpose_item(P.in[18], 2048, 8192, 8192, WUP, 2, scr, r, lane, P.in[17]); continue; } r -= I8;
            transpose_item(P.in[19], 8192, 2048, 2048, WDN, 2, scr, r, lane);
        }
        for (int idx = bx * 512 + tid; idx < 8192 * 32; idx += G * 512) {
            const int pos = idx >> 5, i = idx & 31; const float ang = (float)pos * P.inv[i];
            float t = ang * 0.15915494309189535f; t = t - floorf(t);
            const float rr = (t > 0.5f ? t - 1.f : t) * 6.283185307179586f;
            ((f32x2*)(ws + WS_ROPE))[idx] = (f32x2){__cosf(rr), __sinf(rr)};
        }
        for (int idx = bx * 512 + tid; idx < 12 * 129; idx += G * 512) {
            const int gh = idx / 129, k = idx % 129, g = gh >> 2;
            BIAS[idx] = P.in[4][(int)P.bkt[g][k] * 12 + gh] * 11.313708498984761f;
        }
        for (int m = gw; m < 2 * MC; m += NGW) { norm_row_bf16(P.in[0] + (size_t)m * DM, P.in[5], HB(0, 0) + (size_t)m * DM, lane); if (lane < 2) SSQP[(size_t)m * 2 + lane] = 0.f; }
        for (int m = gw; m < NMEMROWS; m += NGW) {
            const float* src = (m < 512) ? P.in[2] + (size_t)m * DM : P.in[3] + (size_t)(m - 512) * DM;
            norm_row_bf16(src, P.in[11], MEMN + (size_t)m * DM, lane);
        }
    }
    grid.sync();

    for (int ch = 0; ch < NCHUNK; ++ch) {
        const float* xin = (ch < 2) ? P.in[0] + (size_t)ch * MC * DM : P.in[1] + (size_t)(ch - 2) * MC * DM;
        float* xout = P.out + (size_t)ch * MC * DM;
        const int S = (ch < 2) ? 8192 : 4096;
        const int cl = ch & 1, par = (ch >> 1) & 1;
        if ((PH & 8) && ch == 0) { WSP(); pg8::Gemm g{MEMN, WMKV, NMEMROWS, 2048, 2048, 2048}; pg8::StaticOrder So; So.init(NMEMROWS, 2048, G, G - 1 - bx);
            pg8::EpiStore<0, false> E{MEMKV, 2048, nullptr, 0, 0.f}; pg8::gemm_phase(ldsl, g, So, E, wv_s); }
        if (cl == 0) {
            const bool havenext = (ch + 2 < NCHUNK);
            if (havenext) { OPQ();
                const float* xn = P.in[1] + (size_t)(ch + 3 - 2) * MC * DM; bf16_t* hn = HB(par ^ 1, 1);
                for (int m = gw; m < MC; m += NGW) norm_row_bf16(xn + (size_t)m * DM, P.in[5], hn + (size_t)m * DM, lane); }
            if (PH & 8) { WSP(); pg8::Gemm g{HB(par, 0), WIN, 2 * MC, NPROJ, 2048, 2048}; pg8::StaticOrder So; So.init(2 * MC, NPROJ, G, bx);
              pg8::EpiProj E{PROJ2, SSQP, KPE2, ROPE, S - 1}; pg8::gemm_phase(ldsl, g, So, E, wv_s); }
            if (havenext) {
                const int nwg = (2 * MC / 256) * (NPROJ / 256), rem = nwg % G, nfill = (rem == 0) ? G : G - rem, b0 = (rem == 0) ? 0 : rem;
                if (bx >= b0) { OPQ();
                    const float* xn = P.in[1] + (size_t)(ch + 2 - 2) * MC * DM; bf16_t* hn = HB(par ^ 1, 0);
                    for (int m = (bx - b0) * 8 + wave; m < MC; m += nfill * 8) norm_row_bf16(xn + (size_t)m * DM, P.in[5], hn + (size_t)m * DM, lane); } }
            GSYNC();
        }
        if (PH & 16) { WSP(); pg8::Gemm g{PROJ + OFF_CQ, WUQ, MC, NQ, 512, NPROJ}; pg8::StaticOrder So; So.init(MC, NQ, G, bx);
          pg8::EpiQRope E{QB, ROPE, S - 1, SSQ}; pg8::gemm_phase(ldsl, g, So, E, wv_s); }
        if (PH & 32) { WSP(); pg8::Gemm g{PROJ + OFF_CKV, WUKV, MC, NKV, 512, NPROJ}; pg8::StaticOrder So; So.init(MC, NKV, G, (bx + 128) % G);
          pg8::EpiStore<0, true> E{KVB, NKV, SSQ + 1, 2, 1.f / 512.f}; pg8::gemm_phase(ldsl, g, So, E, wv_s); }
        GSYNC();
        for (int it_ = 0; it_ * G < 1152; ++it_) {
            int u = bx + it_ * G;
            if (G == 256 && it_ == 4) { if (bx < 128) continue; u = 1024 + bx - 128; }
            if (u >= 1152) continue;
            asm volatile("" : "+s"(u));
            OPQ();
            int S_ = (ch < 2) ? 8192 : 4096; asm volatile("" : "+s"(S_)); const int S = S_;
            if ((PH & 1) && u < 256) {
                const bf16_t* kpe_ = KPE; asm volatile("" : "+s"(kpe_));
                const int h = u & 7, qb = u >> 3, rowq = qb * 256, seqbase = (rowq / S) * S;
                att::attn_unit<64, true, false, false>(QB + (size_t)rowq * NQ + h * 192, NQ, KVB + (size_t)seqbase * NKV + h * 256, KVB + (size_t)seqbase * NKV + h * 256 + 128, NKV,
                    kpe_ + (size_t)seqbase * 64, 64, S / 64, 0.07216878364870322f, OCAT + (size_t)rowq * 3072 + h * 128, 3072, nullptr, 0, nullptr, 0, 0, 0, nullptr, (char*)lds, wv_s);
            } else if ((PH & 1) && u >= 256 && u < 512) {
                const bf16_t* kpe_ = KPE; asm volatile("" : "+s"(kpe_));
                const int v = u - 256, half = v & 1, h4 = (v & 7) >> 1, h = 8 + h4, qb = v >> 3, rowq = qb * 256, seqbase = (rowq / S) * S, kr0 = seqbase + half * (S / 2);
                att::attn_unit<64, true, false, true>(QB + (size_t)rowq * NQ + h * 192, NQ, KVB + (size_t)kr0 * NKV + h * 256, KVB + (size_t)kr0 * NKV + h * 256 + 128, NKV,
                    kpe_ + (size_t)kr0 * 64, 64, S / 128, 0.07216878364870322f, nullptr, 0, MLP + ((size_t)half * MC + rowq) * 512 + h4 * 128, 512,
                    MLSE + ((size_t)half * MC + rowq) * 4 + h4, 4, 0, 0, nullptr, (char*)lds, wv_s);
            } else if ((PH & 2) && u >= 512 && u < 896) {
                const int v = u - 512, g = v >> 7, w = v & 127, hh = w >> 5, x = w & 31;
                const int per = S / 256, sq = x / per, y = x % per, r = (g == 0) ? 1 : (g == 1 ? 4 : 16), nblk = per / r, c = y / nblk, qb = y % nblk;
                const int seqbase = sq * S, ssub = S / r, q0 = qb * 256;
                float* bl = (float*)(lds + LDS_BIAS_OFF);
                if (tid < 129) bl[tid] = BIAS[(g * 4 + hh) * 129 + tid];
                __syncthreads();
                const size_t tok0 = (size_t)seqbase + c;
                const bf16_t* kb = PROJ + tok0 * NPROJ + OFF_DIL + 1536 + g * 512 + hh * 128;
                att::attn_unit<0, false, true, true>(PROJ + (tok0 + (size_t)r * q0) * NPROJ + OFF_DIL + g * 512 + hh * 128, (long)r * NPROJ, kb, kb + 1536, (long)r * NPROJ,
                    nullptr, 0, 6, 0.08838834764831845f, nullptr, 0, ODG + ((size_t)g * MC + tok0 + (size_t)r * q0) * 512 + hh * 128, (long)r * 512,
                    LSEB + ((size_t)g * MC + tok0 + (size_t)r * q0) * 4 + hh, (long)r * 4, q0, ssub, bl, (char*)lds, wv_s);
            } else if ((PH & 4) && u >= 896) {
                const int v = u - 896, vh = v & 1, w = v >> 1, h = w >> 5, qb = w & 31, rowq = qb * 256;
                int chl = ch; asm volatile("" : "+s"(chl)); const int bg = (chl < 2) ? chl : 2 + (chl - 2) * 2 + rowq / 4096;
                const bf16_t* kb = MEMKV + (size_t)bg * 256 * 2048 + h * 256;
                att::attn_unit<128, false, false, false>(PROJ + (size_t)rowq * NPROJ + OFF_XQ + h * 256, NPROJ, kb, kb + 1024 + vh * 128, 2048, kb + 128, 2048, 4, 0.0625f,
                    OCAT + (size_t)rowq * 3072 + 2048 + h * 256 + vh * 128, 3072, nullptr, 0, nullptr, 0, 0, 0, nullptr, (char*)lds, wv_s);
            }
        }
        GSYNC();
        { OPQ();
        for (int m = gw; m < MC; m += NGW) {
            const int hh = lane >> 4; float l[3], wgt[3];
            if (cl == 1 && lane < 4) SSQP[(size_t)(lane >> 1) * MC * 2 + m * 2 + (lane & 1)] = 0.f; if (lane == 4) SSQ2[m] = 0.f; if (lane == 5) SSQ3[m] = 0.f; if (lane == 6 && m < 32) PCNT[64 * m] = 0u;
#pragma unroll
            for (int g = 0; g < 3; ++g) l[g] = LSEB[((size_t)g * MC + m) * 4 + hh];
            const float mx = fmaxf(l[0], fmaxf(l[1], l[2])); float sum = 0.f;
#pragma unroll
            for (int g = 0; g < 3; ++g) { wgt[g] = __expf(l[g] - mx); sum += wgt[g]; }
            const float inv = 1.f / sum; f32x4 a0 = {0.f, 0.f, 0.f, 0.f}, a1 = {0.f, 0.f, 0.f, 0.f};
#pragma unroll
            for (int g = 0; g < 3; ++g) { const f32x4* op = (const f32x4*)(ODG + ((size_t)g * MC + m) * 512) + 2 * lane; a0 += op[0] * (wgt[g] * inv); a1 += op[1] * (wgt[g] * inv); }
            u32x4 o; o.x = pk2(a0.x, a0.y); o.y = pk2(a0.z, a0.w); o.z = pk2(a1.x, a1.y); o.w = pk2(a1.z, a1.w);
            *((u32x4*)(OCAT + (size_t)m * 3072 + 1536) + lane) = o;
            {
                const float l0 = MLSE[((size_t)0 * MC + m) * 4 + hh], l1 = MLSE[((size_t)1 * MC + m) * 4 + hh]; const float mx2 = fmaxf(l0, l1);
                const float w0 = __expf(l0 - mx2), w1 = __expf(l1 - mx2), iv = 1.f / (w0 + w1);
                const f32x4* p0 = (const f32x4*)(MLP + ((size_t)0 * MC + m) * 512) + 2 * lane; const f32x4* p1 = (const f32x4*)(MLP + ((size_t)1 * MC + m) * 512) + 2 * lane;
                const f32x4 b0 = p0[0] * (w0 * iv) + p1[0] * (w1 * iv), b1 = p0[1] * (w0 * iv) + p1[1] * (w1 * iv);
                u32x4 o2; o2.x = pk2(b0.x, b0.y); o2.y = pk2(b0.z, b0.w); o2.z = pk2(b1.x, b1.y); o2.w = pk2(b1.z, b1.w);
                *((u32x4*)(OCAT + (size_t)m * 3072 + 1024) + lane) = o2; }
        } }
        GSYNC();
        if (PH & 64) { WSP(); pg8::Gemm g{OCAT, WBCAT, MC, 2048, 3072, 3072}; pg8::StaticOrder So; So.init(MC, 2048, G, bx);
          pg8::EpiBranch E{PROJ + OFF_GATE, MERG}; pg8::gemm_phase(ldsl, g, So, E, wv_s); }
        GSYNC();
        if (PH & 512) { WSP(); pg8::Gemm g{MERG, WOUT, MC, 2048, 2048, 2048}; pg8::StaticOrder So; So.init(MC, 2048, G, bx);
          pg8::EpiResid<true> E{xin, xout, HX, SSQ2}; pg8::gemm_phase(ldsl, g, So, E, wv_s); }
        GSYNC();
        for (int rep_ = 0; rep_ < ((DBL & 2) ? 2 : 1); ++rep_)
        if (PH & 1024) { WSP(); pg8::Gemm g{HX, WUP, MC, DFF, 2048, 2048}; pg8::StaticOrder So; So.init(MC, DFF, G, bx);
          pg8::EpiStore<1, true> E{UPACT, DFF, SSQ2, 1, 1.f / 2048.f}; pg8::gemm_phase(ldsl, g, So, E, wv_s); }
        GSYNC();
        if (G == 256) {
            WSP(); pg8::Gemm g{UPACT, WDN, MC, 2048, DFF, DFF}; pg8::StaticOrder So; So.init(MC, 2048, G, bx);
            pg8::EpiFinal E{xout, xout, P.in[20], SSQ3, PCNT}; pg8::gemm_phase(ldsl, g, So, E, wv_s);
            GSYNC();
        } else {
            { WSP(); pg8::Gemm g{UPACT, WDN, MC, 2048, DFF, DFF}; pg8::StaticOrder So; So.init(MC, 2048, G, bx);
              pg8::EpiResid<false> E{xout, xout, nullptr, nullptr}; pg8::gemm_phase(ldsl, g, So, E, wv_s); }
            GSYNC();
            { OPQ(); for (int m = gw; m < MC; m += NGW) norm_row_f32(xout + (size_t)m * DM, P.in[20], lane); }
            GSYNC();
        }
    }
}

static int t5_bucket_host(int rel) {
    const int nb = 16; int ret = (rel > 0) ? nb : 0; const int n = rel < 0 ? -rel : rel; const int max_exact = nb / 2;
    int large = max_exact + (int)(std::log((double)(n > 1 ? n : 1) / max_exact) / std::log(1024.0 / max_exact) * (nb - max_exact));
    if (large > nb - 1) large = nb - 1;
    return ret + (n < max_exact ? n : large);
}
extern "C" void kernel_launch(void* const* d_in, const int* in_sizes, int n_in, void* d_out, int out_size, void* d_ws, size_t ws_size, hipStream_t stream) {
    static int grid = 0;
    if (grid == 0) {
        if (n_in != 21 || ws_size < WS_END) { fprintf(stderr, "kernel_launch: n_in %d ws %zu (need %zu)\n", n_in, ws_size, (size_t)WS_END); grid = -1; return; }
        int dev = 0, cus = 0, per_cu = 0;
        hipGetDevice(&dev); hipDeviceGetAttribute(&cus, hipDeviceAttributeMultiprocessorCount, dev);
        hipFuncSetAttribute((const void*)fwd_megakernel, hipFuncAttributeMaxDynamicSharedMemorySize, LDS_BYTES);
        hipOccupancyMaxActiveBlocksPerMultiprocessor(&per_cu, (const void*)fwd_megakernel, 512, LDS_BYTES);
        if (per_cu < 1) per_cu = 1;
        grid = cus * 1;
        (void)hipGetLastError();
    }
    if (grid < 0) return;
    Params p{};
    for (int i = 0; i < 21; ++i) p.in[i] = (const float*)d_in[i];
    p.out = (float*)d_out; p.ws = (unsigned char*)d_ws;
    for (int i = 0; i < 32; ++i) p.inv[i] = 1.0f / powf(10000.0f, (float)i / 32.0f);
    const int dil[3] = {1, 4, 16};
    for (int g = 0; g < 3; ++g) for (int k = 0; k < 129; ++k) p.bkt[g][k] = (unsigned char)t5_bucket_host((k - 64) * dil[g]);
    (void)hipMemsetAsync((char*)d_ws + WS_BAR, 0, 16384, stream);
    void* args[] = {&p};
    hipError_t e = hipLaunchCooperativeKernel((const void*)fwd_megakernel, dim3(grid), dim3(512), args, LDS_BYTES, stream);
    if (e != hipSuccess) fprintf(stderr, "cooperative launch failed: %s (grid %d)\n", hipGetErrorString(e), grid);
}
```
